# Optimizing an MI355X kernel written in HIP

```python
import jax, jax.numpy as jnp
from jax import lax
import numpy as np

D_MODEL = 1024
BATCH = 8
SEQ = 4096
DEPTH = 4
DEC_BATCH = 32
DEC_SEQ = 16
PAST_LEN = 2048

CHUNK = 64
N_META = 16
A_HEADS = 8
A_HEAD_DIM = 64
A_WIDTH = A_HEADS * A_HEAD_DIM
DECAY_LORA = 64
ICLR_LORA = 64
B_HEADS = 8
QK_NOPE = 64
QK_ROPE = 32
QK_DIM = QK_NOPE + QK_ROPE
V_DIM = 64
B_WIDTH = B_HEADS * V_DIM
Q_LORA = 384
KV_LORA = 256
ROPE_THETA = 10000.0
Q_BLOCK = 128
NORM_EPS = 1e-6
GN_EPS = 64e-5
NEG_INF = -1e30
A_COLS = 4 * A_WIDTH + DECAY_LORA + ICLR_LORA
B_COLS = Q_LORA + KV_LORA + QK_ROPE + B_WIDTH
G_COLS = 2 * D_MODEL
IN_COLS = A_COLS + B_COLS + G_COLS

kernel_name = 'rwkv7_mla_parallel_streaming_encoder'


def rmsnorm(x, g, eps=NORM_EPS):
    xf = x.astype(jnp.float32)
    y = xf * lax.rsqrt(jnp.mean(xf * xf, axis=-1, keepdims=True) + eps)
    return (y * g.astype(jnp.float32)).astype(x.dtype)


def rope(x, t):
    inv = ROPE_THETA ** (-jnp.arange(0, QK_ROPE, 2, dtype=jnp.float32) / QK_ROPE)
    ang = t.astype(jnp.float32)[:, None] * inv[None, :]
    if x.ndim == 4:
        ang = ang[:, None, :]
    cos = jnp.cos(ang).astype(x.dtype)
    sin = jnp.sin(ang).astype(x.dtype)
    x1, x2 = x[..., :QK_ROPE // 2], x[..., QK_ROPE // 2:]
    return jnp.concatenate([x1 * cos - x2 * sin, x1 * sin + x2 * cos], axis=-1)


def rwkv_scan(s0, r, decay, k, v, kk, a):
    def step(S, inp):
        rt, wt, kt, vt, kkt, at = inp
        sa = jnp.einsum('bhvk,bhk->bhv', S, -kkt)
        S = S * wt[:, :, None, :] + sa[..., None] * (kkt * at)[:, :, None, :] + vt[..., None] * kt[:, :, None, :]
        return S, jnp.einsum('bhvk,bhk->bhv', S, rt)
    xs = (jnp.moveaxis(r, 1, 0), jnp.moveaxis(decay, 1, 0), jnp.moveaxis(k, 1, 0),
          jnp.moveaxis(v, 1, 0), jnp.moveaxis(kk, 1, 0), jnp.moveaxis(a, 1, 0))
    s_fin, ys = lax.scan(step, s0, xs)
    return jnp.moveaxis(ys, 0, 1), s_fin


def rwkv_branch(a_cols, shift_row, s0, p):
    B, L, _ = a_cols.shape
    f32 = jnp.float32
    prev = jnp.concatenate([shift_row.astype(a_cols.dtype), a_cols[:, :-1]], axis=1)
    xs = a_cols * p['shift_mix'][0] + prev * p['shift_mix'][1]
    r, k, v, gate, wl, al = jnp.split(
        xs, [A_WIDTH, 2 * A_WIDTH, 3 * A_WIDTH, 4 * A_WIDTH, 4 * A_WIDTH + DECAY_LORA], axis=-1)
    w = -jax.nn.softplus(-(p['rwkv_w0'] + jnp.tanh(wl) @ p['rwkv_w2']).astype(f32)) - 0.5
    decay = jnp.exp(-jnp.exp(w))
    a = jax.nn.sigmoid((p['rwkv_a0'] + al @ p['rwkv_a2']).astype(f32))
    hd = lambda u: u.astype(f32).reshape(B, L, A_HEADS, A_HEAD_DIM)
    kk = hd(k * p['rwkv_k_k'])
    kk = kk * lax.rsqrt(jnp.maximum(jnp.sum(kk * kk, axis=-1, keepdims=True), 1e-24))
    k_mod = k.astype(f32) * (1.0 + (a - 1.0) * p['rwkv_k_a'].astype(f32))
    rh, kh, vh, ah, dh = hd(r), hd(k_mod), hd(v), hd(a), hd(decay)
    y, s_fin = rwkv_scan(s0.astype(f32), rh, dh, kh, vh, kk, ah)
    mu = jnp.mean(y, axis=-1, keepdims=True)
    var = jnp.mean(jnp.square(y - mu), axis=-1, keepdims=True)
    yn = ((y - mu) * lax.rsqrt(var + GN_EPS)).reshape(B, L, A_WIDTH) * p['rwkv_ln_w'] + p['rwkv_ln_b']
    bonus = (jnp.sum(rh * kh * p['rwkv_r_k'].astype(f32), axis=-1, keepdims=True) * vh).reshape(B, L, A_WIDTH)
    out = ((yn + bonus) * jax.nn.silu(gate.astype(f32))).astype(a_cols.dtype)
    return out, s_fin.astype(s0.dtype)


def mla_project(b_cols, t, p):
    B, L, _ = b_cols.shape
    qc, ckv, kr, gate = jnp.split(b_cols, [Q_LORA, Q_LORA + KV_LORA, Q_LORA + KV_LORA + QK_ROPE], axis=-1)
    q = (rmsnorm(qc, p['mla_q_norm']) @ p['mla_w_uq']).reshape(B, L, B_HEADS, QK_DIM)
    q = jnp.concatenate([rmsnorm(q[..., :QK_NOPE], p['mla_qn_nope']),
                         rope(rmsnorm(q[..., QK_NOPE:], p['mla_qn_rope']), t)], axis=-1)
    latent = rmsnorm(ckv, p['mla_kv_norm'])
    krope = rope(rmsnorm(kr, p['mla_kn_rope']), t)
    return q, latent, krope, gate


def mla_expand(latent, krope, p):
    B, L, _ = latent.shape
    kv = (latent @ p['mla_w_ukv']).reshape(B, L, B_HEADS, QK_NOPE + V_DIM)
    k_nope = rmsnorm(kv[..., :QK_NOPE], p['mla_kn_nope'])
    k = jnp.concatenate([k_nope, jnp.broadcast_to(krope[:, :, None, :], (B, L, B_HEADS, QK_ROPE))], axis=-1)
    return k, kv[..., QK_NOPE:]


def attn_chunk_causal(q, k, v, chunk_id):
    B, L = q.shape[:2]
    nb = -(-L // Q_BLOCK)
    Lp = nb * Q_BLOCK
    qp = jnp.pad(q, ((0, 0), (0, Lp - L), (0, 0), (0, 0)))
    qcid = jnp.pad(chunk_id, (0, Lp - L), mode='edge')
    qb = jnp.moveaxis(qp.reshape(B, nb, Q_BLOCK, B_HEADS, QK_DIM), 1, 0)
    cb = qcid.reshape(nb, Q_BLOCK)
    scale = QK_DIM ** -0.5

    def block(args):
        qi, ci = args
        s = jnp.einsum('bqhd,bkhd->bhqk', qi, k).astype(jnp.float32) * scale
        mask = chunk_id[None, :] <= ci[:, None]
        s = jnp.where(mask[None, None], s, NEG_INF)
        pr = jax.nn.softmax(s, axis=-1).astype(v.dtype)
        return jnp.einsum('bhqk,bkhd->bqhd', pr, v)

    o = lax.map(block, (qb, cb))
    return jnp.moveaxis(o, 0, 1).reshape(B, Lp, B_HEADS, V_DIM)[:, :L]


def attn_full(q, k, v):
    s = jnp.einsum('bqhd,bkhd->bhqk', q, k).astype(jnp.float32) * (QK_DIM ** -0.5)
    pr = jax.nn.softmax(s, axis=-1).astype(v.dtype)
    return jnp.einsum('bhqk,bkhd->bqhd', pr, v)


def mixer_layer(x, p, t, shift_row, s0, past_latent=None, past_krope=None, chunk_id=None):
    B, L, _ = x.shape
    h = rmsnorm(x, p['norm_w'])
    z = h @ p['w_in']
    a_cols, b_cols, g_cols = jnp.split(z, [A_COLS, A_COLS + B_COLS], axis=-1)
    ya, s_fin = rwkv_branch(a_cols, shift_row, s0, p)
    q, latent, krope, gate_b = mla_project(b_cols, t, p)
    if past_latent is None:
        k, v = mla_expand(latent, krope, p)
        o = attn_chunk_causal(q, k, v, chunk_id)
    else:
        k, v = mla_expand(jnp.concatenate([past_latent, latent], axis=1),
                          jnp.concatenate([past_krope, krope], axis=1), p)
        o = attn_full(q, k, v)
    yb = o.reshape(B, L, B_WIDTH) * jax.nn.silu(gate_b)
    ga, gb = jnp.split(jax.nn.sigmoid(g_cols), 2, axis=-1)
    y = (ga * (ya @ p['w_branch_a']) + gb * (yb @ p['w_branch_b'])) @ p['w_out']
    return x + y, s_fin, a_cols[:, -1:], latent, krope


def setup_inputs(seed: int = 0) -> dict:
    key = jax.random.key(seed)
    ks = jax.random.split(key, 32)
    f32 = jnp.float32
    nrm = lambda k, shape, s: jax.random.normal(k, shape, f32) * s
    mu = jax.random.uniform(ks[5], (DEPTH, A_COLS), f32)
    return {
        'x_prompt': nrm(ks[0], (BATCH, SEQ, D_MODEL), 1.0),
        'x_sample': nrm(ks[1], (DEC_BATCH, DEC_SEQ, D_MODEL), 1.0),
        'state_rwkv': nrm(ks[2], (DEPTH, DEC_BATCH, A_HEADS, A_HEAD_DIM, A_HEAD_DIM), 0.3),
        'state_shift': nrm(ks[3], (DEPTH, DEC_BATCH, 1, A_COLS), 1.0),
        'cache_mla_latent': nrm(ks[4], (DEPTH, DEC_BATCH, PAST_LEN, KV_LORA), 1.0),
        'cache_mla_krope': nrm(ks[6], (DEPTH, DEC_BATCH, PAST_LEN, QK_ROPE), 1.0),
        'meta_tokens': nrm(ks[7], (N_META, D_MODEL), 1.0),
        'norm_w': 1.0 + nrm(ks[8], (DEPTH, D_MODEL), 0.02),
        'w_in': nrm(ks[9], (DEPTH, D_MODEL, IN_COLS), D_MODEL ** -0.5),
        'shift_mix': jnp.stack([1.0 - mu, mu], axis=1),
        'rwkv_w0': jax.random.uniform(ks[10], (DEPTH, A_WIDTH), f32, -6.0, 0.0),
        'rwkv_w2': nrm(ks[11], (DEPTH, DECAY_LORA, A_WIDTH), 0.5 * DECAY_LORA ** -0.5),
        'rwkv_a0': nrm(ks[12], (DEPTH, A_WIDTH), 0.1),
        'rwkv_a2': nrm(ks[13], (DEPTH, ICLR_LORA, A_WIDTH), 0.5 * ICLR_LORA ** -0.5),
        'rwkv_k_k': 0.85 + nrm(ks[14], (DEPTH, A_WIDTH), 0.05),
        'rwkv_k_a': 1.0 + nrm(ks[15], (DEPTH, A_WIDTH), 0.05),
        'rwkv_r_k': nrm(ks[16], (DEPTH, A_HEADS, A_HEAD_DIM), 0.1),
        'rwkv_ln_w': 1.0 + nrm(ks[17], (DEPTH, A_WIDTH), 0.02),
        'rwkv_ln_b': nrm(ks[18], (DEPTH, A_WIDTH), 0.02),
        'mla_q_norm': 1.0 + nrm(ks[19], (DEPTH, Q_LORA), 0.02),
        'mla_w_uq': nrm(ks[20], (DEPTH, Q_LORA, B_HEADS * QK_DIM), Q_LORA ** -0.5),
        'mla_kv_norm': 1.0 + nrm(ks[21], (DEPTH, KV_LORA), 0.02),
        'mla_w_ukv': nrm(ks[22], (DEPTH, KV_LORA, B_HEADS * (QK_NOPE + V_DIM)), KV_LORA ** -0.5),
        'mla_qn_nope': 1.0 + nrm(ks[23], (DEPTH, QK_NOPE), 0.02),
        'mla_kn_nope': 1.0 + nrm(ks[24], (DEPTH, QK_NOPE), 0.02),
        'mla_qn_rope': 1.0 + nrm(ks[25], (DEPTH, QK_ROPE), 0.02),
        'mla_kn_rope': 1.0 + nrm(ks[26], (DEPTH, QK_ROPE), 0.02),
        'w_branch_a': nrm(ks[27], (DEPTH, A_WIDTH, D_MODEL), A_WIDTH ** -0.5),
        'w_branch_b': nrm(ks[28], (DEPTH, B_WIDTH, D_MODEL), B_WIDTH ** -0.5),
        'w_out': nrm(ks[29], (DEPTH, D_MODEL, D_MODEL), D_MODEL ** -0.5),
    }


def reference(x_prompt, x_sample, state_rwkv, state_shift, cache_mla_latent, cache_mla_krope,
              meta_tokens, norm_w, w_in, shift_mix, rwkv_w0, rwkv_w2, rwkv_a0, rwkv_a2,
              rwkv_k_k, rwkv_k_a, rwkv_r_k, rwkv_ln_w, rwkv_ln_b, mla_q_norm, mla_w_uq,
              mla_kv_norm, mla_w_ukv, mla_qn_nope, mla_kn_nope, mla_qn_rope, mla_kn_rope,
              w_branch_a, w_branch_b, w_out):
    bp, seq = x_prompt.shape[:2]
    past = cache_mla_latent.shape[2]
    meta = jnp.broadcast_to(meta_tokens[None].astype(x_prompt.dtype), (bp, N_META, D_MODEL))
    xp = jnp.concatenate([meta, x_prompt], axis=1)
    t_p = jnp.arange(-N_META, seq, dtype=jnp.int32)
    cid = jnp.where(t_p < 0, -1, t_p // CHUNK)
    xs = x_sample
    t_s = past + jnp.arange(x_sample.shape[1], dtype=jnp.int32)
    sp_list, shp_list, latp_list, krp_list = [], [], [], []
    ss_list, shs_list, lats_list, krs_list = [], [], [], []
    for l in range(DEPTH):
        p = {'norm_w': norm_w[l], 'w_in': w_in[l], 'shift_mix': shift_mix[l],
             'rwkv_w0': rwkv_w0[l], 'rwkv_w2': rwkv_w2[l], 'rwkv_a0': rwkv_a0[l], 'rwkv_a2': rwkv_a2[l],
             'rwkv_k_k': rwkv_k_k[l], 'rwkv_k_a': rwkv_k_a[l], 'rwkv_r_k': rwkv_r_k[l],
             'rwkv_ln_w': rwkv_ln_w[l], 'rwkv_ln_b': rwkv_ln_b[l],
             'mla_q_norm': mla_q_norm[l], 'mla_w_uq': mla_w_uq[l], 'mla_kv_norm': mla_kv_norm[l],
             'mla_w_ukv': mla_w_ukv[l], 'mla_qn_nope': mla_qn_nope[l], 'mla_kn_nope': mla_kn_nope[l],
             'mla_qn_rope': mla_qn_rope[l], 'mla_kn_rope': mla_kn_rope[l],
             'w_branch_a': w_branch_a[l], 'w_branch_b': w_branch_b[l], 'w_out': w_out[l]}
        zero_row = jnp.zeros((bp, 1, A_COLS), xp.dtype)
        zero_state = jnp.zeros((bp, A_HEADS, A_HEAD_DIM, A_HEAD_DIM), jnp.float32)
        xp, s_p, sh_p, lat_p, kr_p = mixer_layer(xp, p, t_p, zero_row, zero_state, chunk_id=cid)
        xs, s_s, sh_s, lat_s, kr_s = mixer_layer(xs, p, t_s, state_shift[l], state_rwkv[l],
                                                 cache_mla_latent[l], cache_mla_krope[l])
        sp_list.append(s_p); shp_list.append(sh_p); latp_list.append(lat_p); krp_list.append(kr_p)
        ss_list.append(s_s); shs_list.append(sh_s); lats_list.append(lat_s); krs_list.append(kr_s)
    y_prompt = xp[:, N_META:]
    y_sample = xs
    state_rwkv_prompt = jnp.stack(sp_list)
    state_shift_prompt = jnp.stack(shp_list)
    cache_mla_latent_prompt = jnp.stack(latp_list)
    cache_mla_krope_prompt = jnp.stack(krp_list)
    state_rwkv_sample = jnp.stack(ss_list)
    state_shift_sample = jnp.stack(shs_list)
    cache_mla_latent_new = jnp.stack(lats_list)
    cache_mla_krope_new = jnp.stack(krs_list)
    return (y_prompt, y_sample, state_rwkv_prompt, state_shift_prompt, cache_mla_latent_prompt,
            cache_mla_krope_prompt, state_rwkv_sample, state_shift_sample, cache_mla_latent_new,
            cache_mla_krope_new)
```

```cpp
#include <hip/hip_runtime.h>
#include <hip/hip_cooperative_groups.h>
#include <stdint.h>
#include <cstdio>
namespace cg = cooperative_groups;

#ifndef PROBE_MODE
#define PROBE_MODE 0
#endif
#ifndef PROBE_PHASE
#define PROBE_PHASE -1
#endif
#ifndef MULTI_LAUNCH
#define MULTI_LAUNCH 0
#endif

typedef unsigned short u16;
typedef __attribute__((ext_vector_type(4))) unsigned u32x4;
typedef __attribute__((ext_vector_type(2))) unsigned u32x2;
typedef __attribute__((ext_vector_type(8))) short bf16x8;
typedef __attribute__((ext_vector_type(4))) float f32x4;
typedef __attribute__((ext_vector_type(2))) float f32x2;
typedef __attribute__((ext_vector_type(2))) __bf16 bf16x2v;
#define DI __device__ __forceinline__
#define LAS __attribute__((address_space(3)))

constexpr int LP = 4112, TP = 8 * LP, TS = 512, T = TP + TS;
constexpr int SK = 2064;
constexpr int ZC = 5408;
constexpr int C_R = 0, C_K = 512, C_V = 1024, C_G = 1536, C_WL = 2048, C_QC = 2176, C_CKV = 2560, C_KR = 2816,
              C_GB = 2848, C_GA1 = 3360, C_GB1 = 4384;
constexpr int NPH = 25;

enum { I_XP = 0, I_XS, I_SRWKV, I_SSHIFT, I_CLAT, I_CKR, I_META, I_NORMW, I_WIN, I_MIX, I_W0, I_W2, I_A0, I_A2, I_KK, I_KA,
       I_RK, I_LNW, I_LNB, I_QNORM, I_WUQ, I_KVNORM, I_WUKV, I_QNN, I_KNN, I_QNR, I_KNR, I_WA, I_WB, I_WOUT };

constexpr size_t O_YP = 0;
constexpr size_t O_YS = O_YP + (size_t)8 * 4096 * 1024;
constexpr size_t O_SRP = O_YS + (size_t)512 * 1024;
constexpr size_t O_SHP = O_SRP + (size_t)4 * 8 * 8 * 64 * 64;
constexpr size_t O_LATP = O_SHP + (size_t)4 * 8 * 2176;
constexpr size_t O_KRP = O_LATP + (size_t)4 * 8 * LP * 256;
constexpr size_t O_SRS = O_KRP + (size_t)4 * 8 * LP * 32;
constexpr size_t O_SHS = O_SRS + (size_t)4 * 32 * 8 * 64 * 64;
constexpr size_t O_LATN = O_SHS + (size_t)4 * 32 * 2176;
constexpr size_t O_KRN = O_LATN + (size_t)4 * 32 * 16 * 256;

constexpr size_t al256(size_t x) { return (x + 255) & ~(size_t)255; }
constexpr size_t WS_WIN = 0;
constexpr size_t WS_W2 = al256(WS_WIN + (size_t)4 * 5504 * 1024 * 2);
constexpr size_t WS_A2 = al256(WS_W2 + (size_t)4 * 512 * 64 * 2);
constexpr size_t WS_WUQ = al256(WS_A2 + (size_t)4 * 512 * 64 * 2);
constexpr size_t WS_WKVF = al256(WS_WUQ + (size_t)4 * 768 * 384 * 2);
constexpr size_t WS_WKVP = al256(WS_WKVF + (size_t)4 * 1024 * 256 * 2);
constexpr size_t WS_WA = al256(WS_WKVP + (size_t)4 * 1024 * 256 * 2);
constexpr size_t WS_WB = al256(WS_WA + (size_t)4 * 1024 * 512 * 2);
constexpr size_t WS_WOUT = al256(WS_WB + (size_t)4 * 1024 * 512 * 2);
constexpr size_t WS_XMETA = al256(WS_WOUT + (size_t)4 * 1024 * 1024 * 2);
constexpr size_t WS_CTR = al256(WS_XMETA + (size_t)128 * 1024 * 4);
constexpr size_t WS_Z = al256(WS_CTR + 1024);
constexpr size_t WS_DEC = al256(WS_Z + (size_t)T * ZC * 2);
constexpr size_t WS_R = al256(WS_DEC + (size_t)T * 512 * 4);
constexpr size_t WS_KM = al256(WS_R + (size_t)T * 512 * 2);
constexpr size_t WS_V = al256(WS_KM + (size_t)T * 512 * 2);
constexpr size_t WS_NKK = al256(WS_V + (size_t)T * 512 * 2);
constexpr size_t WS_KKA = al256(WS_NKK + (size_t)T * 512 * 2);
constexpr size_t WS_Y = al256(WS_KKA + (size_t)T * 512 * 2);
constexpr size_t WS_Q = al256(WS_Y + (size_t)T * 512 * 4);
constexpr size_t WS_KP = al256(WS_Q + (size_t)T * 768 * 2);
constexpr size_t WS_VTP = al256(WS_KP + (size_t)TP * 512 * 2);
constexpr size_t WS_KRP = al256(WS_VTP + (size_t)TP * 512 * 2);
constexpr size_t WS_KS = al256(WS_KRP + (size_t)TP * 32 * 2);
constexpr size_t WS_VTS = al256(WS_KS + (size_t)32 * SK * 512 * 2);
constexpr size_t WS_KRS = al256(WS_VTS + (size_t)32 * SK * 512 * 2 + 4096);
constexpr size_t WS_YB = al256(WS_KRS + (size_t)32 * SK * 32 * 2);
constexpr size_t WS_LATB = al256(WS_YB + (size_t)T * 512 * 2);
constexpr size_t WS_BAR = al256(WS_LATB + (size_t)65536 * 256 * 2);
constexpr size_t WS_TAB = al256(WS_BAR + 16384);
constexpr size_t WS_SSX = al256(WS_TAB + 512);
constexpr size_t WS_SSQ = al256(WS_SSX + (size_t)T * 16 * 4);
constexpr size_t WS_SSKV = al256(WS_SSQ + (size_t)T * 8 * 4);
constexpr size_t WS_CUE = al256(WS_SSKV + (size_t)T * 4 * 4);
constexpr size_t WS_END = al256(WS_CUE + (size_t)8 * 4096 * 4);
constexpr size_t WS_U = WS_DEC;
constexpr size_t WS_YA = WS_Q;
constexpr size_t WS_XB = WS_Y;

struct Params {
  const float* in[30];
  float* out;
  char* ws;
  int ph_lo, ph_hi;
};

DI uint32_t pack2(float a, float b) {
  f32x2 v = {a, b};
  bf16x2v r = __builtin_convertvector(v, bf16x2v);
  return __builtin_bit_cast(uint32_t, r);
}
DI float bflo(uint32_t w) { return __uint_as_float(w << 16); }
DI float bfhi(uint32_t w) { return __uint_as_float(w & 0xffff0000u); }
DI float bf2f(u16 h) { return __uint_as_float(((uint32_t)h) << 16); }
DI f32x4 unpack4(u32x2 w) { return f32x4{bflo(w.x), bfhi(w.x), bflo(w.y), bfhi(w.y)}; }
DI u32x2 pack4(f32x4 v) { return u32x2{pack2(v[0], v[1]), pack2(v[2], v[3])}; }
DI int opaque_tid(const int wv) {
  int lane;
  asm volatile("v_mbcnt_lo_u32_b32 %0, -1, 0\n\tv_mbcnt_hi_u32_b32 %0, -1, %0" : "=v"(lane));
  return (wv << 6) | lane;
}
DI int opaque_bid() { int b = blockIdx.x; asm volatile("" : "+s"(b)); return b; }
DI unsigned xb_xcc_id_early() { return (unsigned)__builtin_amdgcn_s_getreg((3 << 11) | 20) & 0xFu; }
DI unsigned ld_agent(unsigned* p) { return __hip_atomic_load(p, __ATOMIC_RELAXED, __HIP_MEMORY_SCOPE_AGENT); }
DI unsigned add_agent(unsigned* p, unsigned v) { return __hip_atomic_fetch_add(p, v, __ATOMIC_RELAXED, __HIP_MEMORY_SCOPE_AGENT); }
DI float sigmoidf_(float x) { return __builtin_amdgcn_rcpf(1.f + __expf(-x)); }
DI float siluf_(float x) { return x * __builtin_amdgcn_rcpf(1.f + __expf(-x)); }
DI float tanhf_(float x) { return 1.f - 2.f * __builtin_amdgcn_rcpf(__expf(2.f * x) + 1.f); }
DI float xsum16(float x) { u32x2 r = __builtin_amdgcn_permlane16_swap(__float_as_uint(x), __float_as_uint(x), false, false); return __uint_as_float(r.x) + __uint_as_float(r.y); }
DI float xsum32(float x) { u32x2 r = __builtin_amdgcn_permlane32_swap(__float_as_uint(x), __float_as_uint(x), false, false); return __uint_as_float(r.x) + __uint_as_float(r.y); }
DI float xmax16(float x) { u32x2 r = __builtin_amdgcn_permlane16_swap(__float_as_uint(x), __float_as_uint(x), false, false); return fmaxf(__uint_as_float(r.x), __uint_as_float(r.y)); }
DI float xmax32(float x) { u32x2 r = __builtin_amdgcn_permlane32_swap(__float_as_uint(x), __float_as_uint(x), false, false); return fmaxf(__uint_as_float(r.x), __uint_as_float(r.y)); }
DI float xor_sum(float v, int m) {
  if (m == 1) return v + __int_as_float(__builtin_amdgcn_update_dpp(0, __float_as_int(v), 0xB1, 0xf, 0xf, false));
  if (m == 2) return v + __int_as_float(__builtin_amdgcn_update_dpp(0, __float_as_int(v), 0x4E, 0xf, 0xf, false));
  if (m == 4) return v + __int_as_float(__builtin_amdgcn_update_dpp(0, __float_as_int(v), 0x141, 0xf, 0xf, false));
  if (m == 8) return v + __int_as_float(__builtin_amdgcn_update_dpp(0, __float_as_int(v), 0x140, 0xf, 0xf, false));
  if (m == 16) return xsum16(v);
  if (m == 32) return xsum32(v);
  return v + __shfl_xor(v, m);
}
DI f32x4 ld4(const float* p) { return *(const f32x4*)p; }

DI void rope_cs(int pos, int j, float& c, float& s) {
  float inv = exp2f(-(float)j * 0.8304820237218405f);
  float ang = (float)pos * inv;
  double a = (double)ang;
  double k = rint(a * 0.15915494309189535);
  float r = (float)(a - k * 6.283185307179586);
  c = __cosf(r);
  s = __sinf(r);
}
DI int tok_pos(int t) { return (t < TP) ? (t % LP) - 16 : 2048 + ((t - TP) & 15); }

DI const float* x_src(const Params& p, int l, int t) {
  if (t < TP) {
    int b = t / LP, i = t - b * LP;
    if (i < 16) return (l == 0) ? p.in[I_META] + (size_t)i * 1024 : (const float*)(p.ws + WS_XMETA) + (size_t)(b * 16 + i) * 1024;
    return ((l == 0) ? p.in[I_XP] : (const float*)(p.out + O_YP)) + ((size_t)b * 4096 + (i - 16)) * 1024;
  }
  return ((l == 0) ? p.in[I_XS] : (const float*)(p.out + O_YS)) + (size_t)(t - TP) * 1024;
}
DI float* x_dst(const Params& p, int t) {
  if (t < TP) {
    int b = t / LP, i = t - b * LP;
    if (i < 16) return (float*)(p.ws + WS_XMETA) + (size_t)(b * 16 + i) * 1024;
    return p.out + O_YP + ((size_t)b * 4096 + (i - 16)) * 1024;
  }
  return p.out + O_YS + (size_t)(t - TP) * 1024;
}

DI void shifted16(const Params& p, int l, int t, int col, f32x4 (&out)[4]) {
  const u16* z = (const u16*)(p.ws + WS_Z);
  const u16* zc = z + (size_t)t * ZC + col;
  u32x4 c0 = *(const u32x4*)zc, c1 = *(const u32x4*)(zc + 8);
  f32x4 cur[4] = {unpack4(u32x2{c0.x, c0.y}), unpack4(u32x2{c0.z, c0.w}), unpack4(u32x2{c1.x, c1.y}), unpack4(u32x2{c1.z, c1.w})};
  f32x4 prv[4];
  bool first;
  int sb = 0;
  if (t < TP) first = (t % LP) == 0;
  else { int s = t - TP; sb = s >> 4; first = (s & 15) == 0; }
  if (!first) {
    u32x4 q0 = *(const u32x4*)(zc - ZC), q1 = *(const u32x4*)(zc - ZC + 8);
    prv[0] = unpack4(u32x2{q0.x, q0.y}); prv[1] = unpack4(u32x2{q0.z, q0.w});
    prv[2] = unpack4(u32x2{q1.x, q1.y}); prv[3] = unpack4(u32x2{q1.z, q1.w});
  } else if (t < TP) {
#pragma unroll
    for (int j = 0; j < 4; ++j) prv[j] = f32x4{0.f, 0.f, 0.f, 0.f};
  } else {
    const float* ss = p.in[I_SSHIFT] + ((size_t)l * 32 + sb) * 2176 + col;
#pragma unroll
    for (int j = 0; j < 4; ++j) prv[j] = ld4(ss + 4 * j);
  }
  const float* m0 = p.in[I_MIX] + ((size_t)l * 2 + 0) * 2176 + col;
  const float* m1 = p.in[I_MIX] + ((size_t)l * 2 + 1) * 2176 + col;
#pragma unroll
  for (int j = 0; j < 4; ++j) out[j] = cur[j] * ld4(m0 + 4 * j) + prv[j] * ld4(m1 + 4 * j);
}

DI Params load_params(const Params& k) {
  typedef const volatile unsigned long long __attribute__((address_space(4))) * kptr_t;
  kptr_t kp = (kptr_t)__builtin_amdgcn_kernarg_segment_ptr();
  Params q;
#pragma unroll
  for (int i = 0; i < 30; ++i) q.in[i] = (const float*)kp[i];
  q.out = (float*)kp[30];
  q.ws = (char*)kp[31];
  q.ph_lo = 0; q.ph_hi = 0;
  return q;
}

DI f32x4 shifted4(const Params& p, int l, int t, int col) {
  const u16* z = (const u16*)(p.ws + WS_Z);
  f32x4 cur = unpack4(*(const u32x2*)(z + (size_t)t * ZC + col));
  f32x4 prv;
  bool first;
  int sb = 0;
  if (t < TP) first = (t % LP) == 0;
  else { int s = t - TP; sb = s >> 4; first = (s & 15) == 0; }
  if (!first) prv = unpack4(*(const u32x2*)(z + (size_t)(t - 1) * ZC + col));
  else if (t < TP) prv = f32x4{0.f, 0.f, 0.f, 0.f};
  else prv = ld4(p.in[I_SSHIFT] + ((size_t)l * 32 + sb) * 2176 + col);
  f32x4 m0 = ld4(p.in[I_MIX] + ((size_t)l * 2 + 0) * 2176 + col);
  f32x4 m1 = ld4(p.in[I_MIX] + ((size_t)l * 2 + 1) * 2176 + col);
  return cur * m0 + prv * m1;
}

struct XcdMap { int xcc, rank, nlb, nx; };
DI int xcd_total(const XcdMap& xm, int MT, int NT, int& m_start, int& m_cnt) {
  const int base = MT / xm.nx, rem = MT - base * xm.nx;
  m_start = xm.xcc * base + (xm.xcc < rem ? xm.xcc : rem);
  m_cnt = base + (xm.xcc < rem ? 1 : 0);
  return m_cnt * NT;
}
DI void xcd_tile(int t, int m_start, int m_cnt, int NT, int& mtile, int& ntile) {
  const int band = t / (8 * NT);
  const int r = t - band * 8 * NT;
  int bh = m_cnt - band * 8;
  bh = bh < 8 ? bh : 8;
  const int ni = r / bh;
  mtile = m_start + band * 8 + (r - ni * bh);
  ntile = ni;
}

constexpr int LDA = 144;

DI void glds16(const void* g, char* l) {
  __builtin_amdgcn_global_load_lds((const __attribute__((address_space(1))) unsigned*)g, (LAS unsigned*)l, 16, 0, 0);
}
#define WAIT_V(n) asm volatile("s_waitcnt vmcnt(%0)" ::"n"(n) : "memory")
DI void raw_barrier() { asm volatile("s_waitcnt lgkmcnt(0)" ::: "memory"); __builtin_amdgcn_s_barrier(); }
DI int swz4(int q) { return (0x78 >> (2 * q)) & 3; }
template <int OFF> DI bf16x8 ldsr(unsigned a) {
  bf16x8 r;
  asm volatile("ds_read_b128 %0, %1 offset:%2" : "=v"(r) : "v"(a), "n"(OFF));
  return r;
}

template <int BM, int BN, int WR, int WC, int NSWAP, bool PERM = false>
DI void gemm_ring(const int tid_, const u16* __restrict__ Ab, int lda, const u16* __restrict__ Bt, int ldb, int brow_max, int nk,
                  char* s0, char* s1, char* s2, f32x4 (&acc)[BM / WR / 16][BN / WC / 16]) {
  constexpr int MT = BM / WR / 16, NT = BN / WC / 16;
  constexpr int WM = BM / WR, WN = BN / WC;
  constexpr int SA = BM * 64;
  constexpr int LA = BM / 64, LB = BN / 64, LPW = LA + LB;
  static_assert(SA + BN * 64 <= 24576, "stage too large");
  const int tid = tid_, lane = tid & 63, wave = tid >> 6;
  const int wr = wave / WC, wc = wave % WC;
  const int lrow = lane >> 2, lc = (lane & 3) ^ swz4(lane >> 4);
  const u16* ap = Ab + (size_t)(wave * 16 + lrow) * lda + lc * 8;
  const u16* bp[LB];
#pragma unroll
  for (int i = 0; i < LB; ++i) {
    int r = i * 64 + wave * 16 + lrow;
    if (PERM) {
      const int wcg = r / WN, np = r - wcg * WN;
      r = wcg * WN + ((np >> 2) & 3) * (WN / 4) + (np >> 4) * 4 + (np & 3);
    }
    r = r < brow_max ? r : brow_max;
    bp[i] = Bt + (size_t)r * ldb + lc * 8;
  }
#pragma unroll
  for (int mt = 0; mt < MT; ++mt)
#pragma unroll
    for (int nt = 0; nt < NT; ++nt) acc[mt][nt] = f32x4{0.f, 0.f, 0.f, 0.f};
  const int g = lane >> 4;
  const int fo = (lane & 15) * 64 + ((g ^ swz4((lane & 15) >> 2)) * 16);
  auto issue = [&](char* sa, int kt) {
    const int ko = kt * 32;
#pragma unroll
    for (int i = 0; i < LA; ++i) glds16(ap + (size_t)(i * 64) * lda + ko, sa + (i * 4 + wave) * 1024);
#pragma unroll
    for (int i = 0; i < LB; ++i) glds16(bp[i] + ko, sa + SA + (i * 4 + wave) * 1024);
  };
  auto step = [&](int kt, char* cur, char* nxt) {
    if (kt + 1 < nk) WAIT_V(LPW); else WAIT_V(0);
    raw_barrier();
    if (kt + 2 < nk) issue(nxt, kt + 2);
    const unsigned aA = (unsigned)(size_t)cur + (unsigned)((wr * WM) * 64 + fo);
    const unsigned aB = (unsigned)(size_t)cur + (unsigned)(SA + (wc * WN) * 64 + fo);
    bf16x8 xf[MT], wf[NT];
    xf[0] = ldsr<0>(aA);
    if constexpr (MT > 1) xf[1] = ldsr<1024>(aA);
    if constexpr (MT > 2) xf[2] = ldsr<2048>(aA);
    if constexpr (MT > 3) xf[3] = ldsr<3072>(aA);
    if constexpr (MT > 4) xf[4] = ldsr<4096>(aA);
    if constexpr (MT > 5) xf[5] = ldsr<5120>(aA);
    wf[0] = ldsr<0>(aB);
    if constexpr (NT > 1) wf[1] = ldsr<1024>(aB);
    if constexpr (NT > 2) wf[2] = ldsr<2048>(aB);
    if constexpr (NT > 3) wf[3] = ldsr<3072>(aB);
    if constexpr (NT > 4) wf[4] = ldsr<4096>(aB);
    if constexpr (NT > 5) wf[5] = ldsr<5120>(aB);
    if constexpr (NT > 6) wf[6] = ldsr<6144>(aB);
    if constexpr (NT > 7) wf[7] = ldsr<7168>(aB);
    constexpr int NH = NT / 2;
    asm volatile("s_waitcnt lgkmcnt(%0)" ::"n"(NT - NH) : "memory");
#pragma unroll
    for (int mt = 0; mt < MT; ++mt) asm volatile("" : "+v"(xf[mt]));
#pragma unroll
    for (int nt = 0; nt < NH; ++nt) asm volatile("" : "+v"(wf[nt]));
#pragma unroll
    for (int nt = 0; nt < NH; ++nt) {
#pragma unroll
      for (int mt = 0; mt < MT; ++mt) {
        if (nt < NSWAP) acc[mt][nt] = __builtin_amdgcn_mfma_f32_16x16x32_bf16(wf[nt], xf[mt], acc[mt][nt], 0, 0, 0);
        else acc[mt][nt] = __builtin_amdgcn_mfma_f32_16x16x32_bf16(xf[mt], wf[nt], acc[mt][nt], 0, 0, 0);
      }
    }
    asm volatile("s_waitcnt lgkmcnt(0)" ::: "memory");
#pragma unroll
    for (int nt = NH; nt < NT; ++nt) asm volatile("" : "+v"(wf[nt]));
#pragma unroll
    for (int nt = NH; nt < NT; ++nt) {
#pragma unroll
      for (int mt = 0; mt < MT; ++mt) {
        if (nt < NSWAP) acc[mt][nt] = __builtin_amdgcn_mfma_f32_16x16x32_bf16(wf[nt], xf[mt], acc[mt][nt], 0, 0, 0);
        else acc[mt][nt] = __builtin_amdgcn_mfma_f32_16x16x32_bf16(xf[mt], wf[nt], acc[mt][nt], 0, 0, 0);
      }
    }
  };
  WAIT_V(0);
  __syncthreads();
  issue(s0, 0);
  issue(s1, 1);
  for (int kt = 0; kt < nk; kt += 3) {
    step(kt, s0, s2);
    if (kt + 1 < nk) step(kt + 1, s1, s0);
    if (kt + 2 < nk) step(kt + 2, s2, s1);
  }
}

DI float sum4sq(f32x4 v) { return v[0] * v[0] + v[1] * v[1] + v[2] * v[2] + v[3] * v[3]; }

DI void transpose_job(const int tid_, const float* __restrict__ src, const float* __restrict__ scale, u16* __restrict__ dst, u16* __restrict__ dst2,
                      int K, int N, int kt, int nt, char* s0, char* s1, char* s2) {
  float* tile = (float*)s0;
  const int tid = tid_;
  __syncthreads();
#pragma unroll
  for (int i = 0; i < 16; ++i) {
    int kl = (tid >> 6) + 4 * i, nl = tid & 63;
    int k = kt * 64 + kl, n = nt * 64 + nl;
    tile[kl * 65 + nl] = (n < N) ? src[(size_t)k * N + n] : 0.f;
  }
  __syncthreads();
#pragma unroll
  for (int i = 0; i < 16; ++i) {
    int nl = (tid >> 6) + 4 * i, kl = tid & 63;
    int k = kt * 64 + kl, n = nt * 64 + nl;
    float v = tile[kl * 65 + nl];
    float sc = scale ? scale[k] : 1.f;
    dst[(size_t)n * K + k] = (u16)(pack2(v * sc, 0.f) & 0xffffu);
    if (dst2) dst2[(size_t)n * K + k] = (u16)(pack2(v, 0.f) & 0xffffu);
  }
}

DI void phase0(const int wv, const Params& p0, char* s0, char* s1, char* s2) {
  const Params p = load_params(p0);
  const int tid_ = opaque_tid(wv);
  if (opaque_bid() == 0 && tid_ < 64) ((unsigned*)(p.ws + WS_CTR))[tid_] = 0u;
  {
    unsigned* cue = (unsigned*)(p.ws + WS_CUE);
#pragma unroll 1
    for (int i = opaque_bid() * 256 + tid_; i < 8 * 4096; i += (int)gridDim.x * 256) cue[i] = 0u;
  }
  {
    u16* xb = (u16*)(p.ws + WS_XB);
#pragma unroll 1
    for (int job = opaque_bid(); job < T; job += gridDim.x) {
      const float* xs = x_src(p, 0, job);
      f32x4 xv = ld4(xs + tid_ * 4);
      *(u32x2*)(xb + (size_t)job * 1024 + tid_ * 4) = pack4(xv);
      float ss = sum4sq(xv);
#pragma unroll
      for (int m = 1; m < 64; m <<= 1) ss = xor_sum(ss, m);
      float* ssx = (float*)(p.ws + WS_SSX) + (size_t)job * 16;
      if ((tid_ & 63) == 0) ssx[tid_ >> 6] = ss;
      if (tid_ >= 4 && tid_ < 16) ssx[tid_] = 0.f;
    }
  }
#pragma unroll 1
  for (int job = opaque_bid(); job < 4 * 2040; job += gridDim.x) {
    int l = job / 2040, j = job - l * 2040;
    if (j < 1376) {
      transpose_job(tid_, p.in[I_WIN] + (size_t)l * 1024 * ZC, p.in[I_NORMW] + l * 1024, (u16*)(p.ws + WS_WIN) + (size_t)l * 5504 * 1024, nullptr,
                    1024, ZC, j / 86, j % 86, s0, s1, s2);
    } else if (j < 1384) {
      transpose_job(tid_, p.in[I_W2] + (size_t)l * 64 * 512, nullptr, (u16*)(p.ws + WS_W2) + (size_t)l * 512 * 64, nullptr, 64, 512, 0, j - 1376, s0, s1, s2);
    } else if (j < 1392) {
      transpose_job(tid_, p.in[I_A2] + (size_t)l * 64 * 512, nullptr, (u16*)(p.ws + WS_A2) + (size_t)l * 512 * 64, nullptr, 64, 512, 0, j - 1384, s0, s1, s2);
    } else if (j < 1464) {
      int q = j - 1392;
      transpose_job(tid_, p.in[I_WUQ] + (size_t)l * 384 * 768, p.in[I_QNORM] + l * 384, (u16*)(p.ws + WS_WUQ) + (size_t)l * 768 * 384, nullptr,
                    384, 768, q / 12, q % 12, s0, s1, s2);
    } else if (j < 1528) {
      int q = j - 1464;
      transpose_job(tid_, p.in[I_WUKV] + (size_t)l * 256 * 1024, p.in[I_KVNORM] + l * 256, (u16*)(p.ws + WS_WKVF) + (size_t)l * 1024 * 256,
                    (u16*)(p.ws + WS_WKVP) + (size_t)l * 1024 * 256, 256, 1024, q / 16, q % 16, s0, s1, s2);
    } else if (j < 1656) {
      int q = j - 1528;
      transpose_job(tid_, p.in[I_WA] + (size_t)l * 512 * 1024, nullptr, (u16*)(p.ws + WS_WA) + (size_t)l * 1024 * 512, nullptr, 512, 1024, q / 16, q % 16, s0, s1, s2);
    } else if (j < 1784) {
      int q = j - 1656;
      transpose_job(tid_, p.in[I_WB] + (size_t)l * 512 * 1024, nullptr, (u16*)(p.ws + WS_WB) + (size_t)l * 1024 * 512, nullptr, 512, 1024, q / 16, q % 16, s0, s1, s2);
    } else {
      int q = j - 1784;
      transpose_job(tid_, p.in[I_WOUT] + (size_t)l * 1024 * 1024, nullptr, (u16*)(p.ws + WS_WOUT) + (size_t)l * 1024 * 1024, nullptr, 1024, 1024, q / 16, q % 16, s0, s1, s2);
    }
  }
}

DI void phase1(const XcdMap xm, const int wv, const Params& p0, int l, char* s0, char* s1, char* s2) {
  const Params p = load_params(p0);
  const int tid_ = opaque_tid(wv);
  const int tid = tid_, lane = tid & 63, wave = tid >> 6, g = lane >> 4, c16 = lane & 15;
  u16* z = (u16*)(p.ws + WS_Z);
  {
    const float* src = p.in[I_CLAT] + (size_t)l * 65536 * 256;
    u16* dst = (u16*)(p.ws + WS_LATB);
#pragma unroll 1
    for (int job = opaque_bid(); job < 8192; job += gridDim.x) {
      const size_t e = ((size_t)job * 256 + tid) * 8;
      f32x4 a = __builtin_nontemporal_load((const f32x4*)(src + e)), b = __builtin_nontemporal_load((const f32x4*)(src + e + 4));
      u32x2 pa = pack4(a), pb = pack4(b);
      *(u32x4*)(dst + e) = u32x4{pa.x, pa.y, pb.x, pb.y};
    }
  }
  int m_start, m_cnt;
  const int total = xcd_total(xm, 261, 22, m_start, m_cnt);
#pragma unroll 1
  for (int t = xm.rank; t < total; t += xm.nlb) {
    int mtile, ntile;
    xcd_tile(t, m_start, m_cnt, 22, mtile, ntile);
    const int m0 = mtile * 128, n0 = ntile * 256;
    if (ntile == 21) {
      const int tl = opaque_tid(wv);
      const int lane = tl & 63, wave = tl >> 6, g = lane >> 4, c16 = lane & 15;
      f32x4 acc2[2][4];
      gemm_ring<128, 64, 4, 1, 4>(tl, (const u16*)(p.ws + WS_XB) + (size_t)m0 * 1024, 1024,
                                  (const u16*)(p.ws + WS_WIN) + ((size_t)l * 5504 + n0) * 1024, 1024, ZC - 1 - n0, 32, s0, s1, s2, acc2);
      const float* ssx = (const float*)(p.ws + WS_SSX);
#pragma unroll
      for (int mt = 0; mt < 2; ++mt) {
        const int m = m0 + wave * 32 + mt * 16 + c16;
        f32x4 s0_ = ld4(ssx + (size_t)m * 16), s1_ = ld4(ssx + (size_t)m * 16 + 4), s2_ = ld4(ssx + (size_t)m * 16 + 8), s3_ = ld4(ssx + (size_t)m * 16 + 12);
        f32x4 st = s0_ + s1_ + s2_ + s3_;
        const float rs = rsqrtf((st[0] + st[1] + st[2] + st[3]) * (1.f / 1024.f) + 1e-6f);
#pragma unroll
        for (int nt = 0; nt < 2; ++nt) {
          const int n = n0 + nt * 16 + g * 4;
          *(u32x2*)(z + (size_t)m * ZC + n) = pack4(acc2[mt][nt] * rs);
        }
      }
      continue;
    }
    f32x4 acc[4][8];
    gemm_ring<128, 256, 2, 2, 8, true>(tid_, (const u16*)(p.ws + WS_XB) + (size_t)m0 * 1024, 1024,
                               (const u16*)(p.ws + WS_WIN) + ((size_t)l * 5504 + n0) * 1024, 1024, ZC - 1 - n0, 32, s0, s1, s2, acc);
    const int wr = wave >> 1, wc = wave & 1;
    const float* ssx = (const float*)(p.ws + WS_SSX);
#pragma unroll
    for (int mt = 0; mt < 4; ++mt) {
      const int m = m0 + wr * 64 + mt * 16 + c16;
      f32x4 s0 = ld4(ssx + (size_t)m * 16), s1 = ld4(ssx + (size_t)m * 16 + 4), s2 = ld4(ssx + (size_t)m * 16 + 8), s3 = ld4(ssx + (size_t)m * 16 + 12);
      f32x4 st = s0 + s1 + s2 + s3;
      const float rs = rsqrtf((st[0] + st[1] + st[2] + st[3]) * (1.f / 1024.f) + 1e-6f);
      float psum = 0.f;
#pragma unroll
      for (int nt = 0; nt < 8; nt += 2) {
        const int n = n0 + wc * 128 + g * 32 + nt * 4;
        f32x4 v0 = acc[mt][nt] * rs, v1 = acc[mt][nt + 1] * rs;
        psum += sum4sq(v0) + sum4sq(v1);
        u32x2 a = pack4(v0), b = pack4(v1);
        *(u32x4*)(z + (size_t)m * ZC + n) = u32x4{a.x, a.y, b.x, b.y};
      }
      const bool isq = (ntile == 8 && wc == 1) || ntile == 9;
      if (isq || ntile == 10) {
        psum = xor_sum(psum, 16);
        psum = xor_sum(psum, 32);
        if (g == 0) {
          if (isq) ((float*)(p.ws + WS_SSQ))[(size_t)m * 8 + (ntile == 8 ? 0 : 1 + wc)] = psum;
          else ((float*)(p.ws + WS_SSKV))[(size_t)m * 4 + wc] = psum;
        }
      }
    }
  }
}

DI void rwkv_prep_tile(const int wv, const Params& p, int l, int mtile, int h, char* s0, char* s1, char* s2) {
  int tid = opaque_tid(wv);
  const u16* z = (const u16*)(p.ws + WS_Z);
  char* sAw = s0;
  char* sAa = s1;
  char* sBw = s2;
  char* sBa = s2 + 64 * LDA;
  const int t0 = mtile * 128;
  __syncthreads();
  {
    const int c8 = (tid & 15) * 8;
#pragma unroll 1
    for (int i = 0; i < 8; ++i) {
      const int row = (tid >> 4) + 16 * i;
      f32x4 a = shifted4(p, l, t0 + row, C_WL + c8);
      f32x4 b = shifted4(p, l, t0 + row, C_WL + c8 + 4);
      if (c8 < 64) {
#pragma unroll
        for (int e = 0; e < 4; ++e) { a[e] = tanhf_(a[e]); b[e] = tanhf_(b[e]); }
      }
      u32x2 pa = pack4(a), pb = pack4(b);
      char* dst = (c8 < 64 ? sAw : sAa) + row * LDA + (c8 & 63) * 2;
      *(u32x4*)dst = u32x4{pa.x, pa.y, pb.x, pb.y};
    }
    const u16* w2 = (const u16*)(p.ws + WS_W2) + ((size_t)l * 512 + h * 64) * 64;
    const u16* a2 = (const u16*)(p.ws + WS_A2) + ((size_t)l * 512 + h * 64) * 64;
#pragma unroll
    for (int i = 0; i < 2; ++i) {
      const int row = (tid >> 3) + 32 * i, ch = tid & 7;
      const int crow = ((row >> 2) & 3) * 16 + (row >> 4) * 4 + (row & 3);
      *(u32x4*)(sBw + row * LDA + ch * 16) = *(const u32x4*)(w2 + crow * 64 + ch * 8);
      *(u32x4*)(sBa + row * LDA + ch * 16) = *(const u32x4*)(a2 + crow * 64 + ch * 8);
    }
  }
  __syncthreads();
  tid = opaque_tid(wv);
  const int lane = tid & 63, wave = tid >> 6, g = lane >> 4, c16 = lane & 15;
  f32x4 accw[2][4], acca[2][4];
#pragma unroll
  for (int mt = 0; mt < 2; ++mt)
#pragma unroll
    for (int nt = 0; nt < 4; ++nt) { accw[mt][nt] = f32x4{0, 0, 0, 0}; acca[mt][nt] = f32x4{0, 0, 0, 0}; }
  const int fo = c16 * LDA + g * 16;
#pragma unroll
  for (int ks = 0; ks < 2; ++ks) {
    bf16x8 xw[2], xa[2], ww[4], wa[4];
#pragma unroll
    for (int mt = 0; mt < 2; ++mt) {
      xw[mt] = *(const bf16x8*)(sAw + (wave * 32 + mt * 16) * LDA + fo + ks * 64);
      xa[mt] = *(const bf16x8*)(sAa + (wave * 32 + mt * 16) * LDA + fo + ks * 64);
    }
#pragma unroll
    for (int nt = 0; nt < 4; ++nt) {
      ww[nt] = *(const bf16x8*)(sBw + (nt * 16) * LDA + fo + ks * 64);
      wa[nt] = *(const bf16x8*)(sBa + (nt * 16) * LDA + fo + ks * 64);
    }
#pragma unroll
    for (int mt = 0; mt < 2; ++mt)
#pragma unroll
      for (int nt = 0; nt < 4; ++nt) {
        accw[mt][nt] = __builtin_amdgcn_mfma_f32_16x16x32_bf16(ww[nt], xw[mt], accw[mt][nt], 0, 0, 0);
        acca[mt][nt] = __builtin_amdgcn_mfma_f32_16x16x32_bf16(wa[nt], xa[mt], acca[mt][nt], 0, 0, 0);
      }
  }
  float* DEC = (float*)(p.ws + WS_DEC);
  u16* R = (u16*)(p.ws + WS_R);
  u16* KM = (u16*)(p.ws + WS_KM);
  u16* V = (u16*)(p.ws + WS_V);
  u16* NKK = (u16*)(p.ws + WS_NKK);
  u16* KKA = (u16*)(p.ws + WS_KKA);
#pragma unroll
  for (int mt = 0; mt < 2; ++mt) {
    const int t = t0 + wave * 32 + mt * 16 + c16;
    const int cb = h * 64 + g * 16;
    const size_t o = (size_t)t * 512 + cb;
    f32x4 k4[4], kk[4];
    {
      f32x4 r4[4];
      shifted16(p, l, t, C_R + cb, r4);
      u32x2 a = pack4(r4[0]), b = pack4(r4[1]), c = pack4(r4[2]), d = pack4(r4[3]);
      *(u32x4*)(R + o) = u32x4{a.x, a.y, b.x, b.y};
      *(u32x4*)(R + o + 8) = u32x4{c.x, c.y, d.x, d.y};
    }
    {
      f32x4 v4[4];
      shifted16(p, l, t, C_V + cb, v4);
      u32x2 a = pack4(v4[0]), b = pack4(v4[1]), c = pack4(v4[2]), d = pack4(v4[3]);
      *(u32x4*)(V + o) = u32x4{a.x, a.y, b.x, b.y};
      *(u32x4*)(V + o + 8) = u32x4{c.x, c.y, d.x, d.y};
    }
    shifted16(p, l, t, C_K + cb, k4);
    float ssq = 0.f;
#pragma unroll
    for (int nt = 0; nt < 4; ++nt) {
      const int c = cb + nt * 4;
      f32x4 a0 = ld4(p.in[I_A0] + l * 512 + c), w0 = ld4(p.in[I_W0] + l * 512 + c);
      f32x4 a, dec;
#pragma unroll
      for (int e = 0; e < 4; ++e) {
        a[e] = sigmoidf_(a0[e] + acca[mt][nt][e]);
        float x = -(w0[e] + accw[mt][nt][e]);
        float sp = fmaxf(x, 0.f) + __logf(1.f + __expf(-fabsf(x)));
        float w = -sp - 0.5f;
        dec[e] = __expf(-__expf(w));
      }
      acca[mt][nt] = a;
      *(f32x4*)(DEC + o + nt * 4) = dec;
      f32x4 k_k = ld4(p.in[I_KK] + l * 512 + c);
      kk[nt] = k4[nt] * k_k;
      ssq += sum4sq(kk[nt]);
    }
    ssq = xor_sum(ssq, 16);
    ssq = xor_sum(ssq, 32);
    const float inv = rsqrtf(fmaxf(ssq, 1e-24f));
    u32x2 pn[4], pa[4], pk[4];
#pragma unroll
    for (int nt = 0; nt < 4; ++nt) {
      const int c = cb + nt * 4;
      f32x4 k_a = ld4(p.in[I_KA] + l * 512 + c);
      f32x4 kn = kk[nt] * inv;
      f32x4 av = acca[mt][nt];
      f32x4 one = f32x4{1.f, 1.f, 1.f, 1.f};
      pn[nt] = pack4(-kn);
      pa[nt] = pack4(kn * av);
      pk[nt] = pack4(k4[nt] * (one + (av - one) * k_a));
    }
    *(u32x4*)(NKK + o) = u32x4{pn[0].x, pn[0].y, pn[1].x, pn[1].y};
    *(u32x4*)(NKK + o + 8) = u32x4{pn[2].x, pn[2].y, pn[3].x, pn[3].y};
    *(u32x4*)(KKA + o) = u32x4{pa[0].x, pa[0].y, pa[1].x, pa[1].y};
    *(u32x4*)(KKA + o + 8) = u32x4{pa[2].x, pa[2].y, pa[3].x, pa[3].y};
    *(u32x4*)(KM + o) = u32x4{pk[0].x, pk[0].y, pk[1].x, pk[1].y};
    *(u32x4*)(KM + o + 8) = u32x4{pk[2].x, pk[2].y, pk[3].x, pk[3].y};
    __builtin_amdgcn_sched_barrier(0);
  }
}

DI void q_tile(const int tid_, const Params& p, int l, int mtile, int h, char* s0, char* s1, char* s2) {
  const int tid = tid_, lane = tid & 63, wave = tid >> 6, g = lane >> 4, c16 = lane & 15;
  const int m0 = mtile * 128;
  f32x4 acc[2][8];
  gemm_ring<128, 128, 4, 1, 8>(tid_, (const u16*)(p.ws + WS_Z) + (size_t)m0 * ZC + C_QC, ZC,
                             (const u16*)(p.ws + WS_WUQ) + ((size_t)l * 768 + h * 96) * 384, 384, 767 - h * 96, 12, s0, s1, s2, acc);
  u16* Q = (u16*)(p.ws + WS_Q);
  const float qscale = 0.14724576f;
#pragma unroll
  for (int mt = 0; mt < 2; ++mt) {
    const int ml = wave * 32 + mt * 16 + c16;
    const int t = m0 + ml;
    float rs;
    {
      const float* sq = (const float*)(p.ws + WS_SSQ) + (size_t)t * 8;
      rs = rsqrtf((sq[0] + sq[1] + sq[2]) * (1.f / 384.f) + 1e-6f);
    }
    float ssn = 0.f, ssr = 0.f;
#pragma unroll
    for (int nt = 0; nt < 6; ++nt) {
      acc[mt][nt] *= rs;
      float s = acc[mt][nt][0] * acc[mt][nt][0] + acc[mt][nt][1] * acc[mt][nt][1] + acc[mt][nt][2] * acc[mt][nt][2] + acc[mt][nt][3] * acc[mt][nt][3];
      if (nt < 4) ssn += s; else ssr += s;
    }
    ssn = xor_sum(ssn, 16); ssn = xor_sum(ssn, 32);
    ssr = xor_sum(ssr, 16); ssr = xor_sum(ssr, 32);
    const float rn = rsqrtf(ssn * (1.f / 64.f) + 1e-6f) * qscale;
    const float rr = rsqrtf(ssr * (1.f / 32.f) + 1e-6f) * qscale;
    u16* qrow = Q + (size_t)t * 768 + h * 96;
#pragma unroll
    for (int nt = 0; nt < 4; ++nt) {
      const int n = nt * 16 + g * 4;
      f32x4 gw = ld4(p.in[I_QNN] + l * 64 + n);
      *(u32x2*)(qrow + n) = pack4(acc[mt][nt] * gw * rn);
    }
    const int pos = tok_pos(t);
    const int j0 = g * 4;
    f32x4 g1 = ld4(p.in[I_QNR] + l * 32 + j0), g2 = ld4(p.in[I_QNR] + l * 32 + 16 + j0);
    f32x4 o1, o2;
#pragma unroll
    for (int e = 0; e < 4; ++e) {
      float c, s;
      rope_cs(pos, j0 + e, c, s);
      float x1 = acc[mt][4][e] * g1[e] * rr, x2 = acc[mt][5][e] * g2[e] * rr;
      o1[e] = x1 * c - x2 * s;
      o2[e] = x1 * s + x2 * c;
    }
    *(u32x2*)(qrow + 64 + j0) = pack4(o1);
    *(u32x2*)(qrow + 80 + j0) = pack4(o2);
  }
}

DI void kv_tile(const int tid_, const Params& p, int l, int mtile, int h, char* s0, char* s1, char* s2) {
  const int tid = tid_, lane = tid & 63, wave = tid >> 6, g = lane >> 4, c16 = lane & 15;
  f32x4 acc[2][8];
  const bool past = mtile >= 261;
  const int m0 = past ? (mtile - 261) * 128 : mtile * 128;
  if (!past) {
    gemm_ring<128, 128, 4, 1, 4>(tid_, (const u16*)(p.ws + WS_Z) + (size_t)m0 * ZC + C_CKV, ZC,
                               (const u16*)(p.ws + WS_WKVF) + ((size_t)l * 1024 + h * 128) * 256, 256, 127, 8, s0, s1, s2, acc);
  } else {
    gemm_ring<128, 128, 4, 1, 4>(tid_, (const u16*)(p.ws + WS_LATB) + (size_t)m0 * 256, 256,
                               (const u16*)(p.ws + WS_WKVP) + ((size_t)l * 1024 + h * 128) * 256, 256, 127, 8, s0, s1, s2, acc);
  }
  u16 *KN, *VT;
  int skv;
  if (!past && m0 < TP) { KN = (u16*)(p.ws + WS_KP); VT = (u16*)(p.ws + WS_VTP); skv = LP; }
  else { KN = (u16*)(p.ws + WS_KS); VT = (u16*)(p.ws + WS_VTS); skv = SK; }
#pragma unroll
  for (int mt = 0; mt < 2; ++mt) {
    {
      const int ml = wave * 32 + mt * 16 + c16;
      const int r = m0 + ml;
      float rs = 1.f;
      if (!past) { f32x4 s0 = ld4((const float*)(p.ws + WS_SSKV) + (size_t)r * 4); rs = rsqrtf((s0[0] + s0[1]) * (1.f / 256.f) + 1e-6f); }
      size_t krow;
      if (past) krow = (size_t)(r >> 11) * SK + (r & 2047);
      else if (r < TP) krow = r;
      else { int s = r - TP; krow = (size_t)(s >> 4) * SK + 2048 + (s & 15); }
      float ss = 0.f;
#pragma unroll
      for (int nt = 0; nt < 4; ++nt) {
        acc[mt][nt] *= rs;
        ss += acc[mt][nt][0] * acc[mt][nt][0] + acc[mt][nt][1] * acc[mt][nt][1] + acc[mt][nt][2] * acc[mt][nt][2] + acc[mt][nt][3] * acc[mt][nt][3];
      }
      ss = xor_sum(ss, 16); ss = xor_sum(ss, 32);
      const float rn = rsqrtf(ss * (1.f / 64.f) + 1e-6f);
#pragma unroll
      for (int nt = 0; nt < 4; ++nt) {
        const int n = nt * 16 + g * 4;
        f32x4 gw = ld4(p.in[I_KNN] + l * 64 + n);
        *(u32x2*)(KN + krow * 512 + h * 64 + n) = pack4(acc[mt][nt] * gw * rn);
      }
    }
    {
      const int mlb = wave * 32 + mt * 16 + g * 4;
      const int r = m0 + mlb;
      f32x4 rs4 = f32x4{1.f, 1.f, 1.f, 1.f};
      if (!past) {
        const float* sk = (const float*)(p.ws + WS_SSKV) + (size_t)r * 4;
#pragma unroll
        for (int e = 0; e < 4; ++e) { f32x4 s0 = ld4(sk + e * 4); rs4[e] = rsqrtf((s0[0] + s0[1]) * (1.f / 256.f) + 1e-6f); }
      }
      size_t vrow;
      if (past) vrow = ((size_t)((r >> 11) * 8 + h) * 64) * SK + (r & 2047);
      else if (r < TP) { int b = r / LP; vrow = ((size_t)(b * 8 + h) * 64) * LP + (r - b * LP); }
      else { int s = r - TP; vrow = ((size_t)((s >> 4) * 8 + h) * 64) * SK + 2048 + (s & 15); }
#pragma unroll
      for (int nt = 4; nt < 8; ++nt) {
        const int dv = (nt - 4) * 16 + c16;
        *(u32x2*)(VT + vrow + (size_t)dv * skv) = pack4(acc[mt][nt] * rs4);
      }
    }
  }
}

DI void lat_job(const int tid_, const Params& p, int l, int job) {
  const int tid = tid_, lane = tid & 63, wave = tid >> 6;
  const u16* z = (const u16*)(p.ws + WS_Z);
  for (int q = 0; q < 8; ++q) {
    const int t = job * 32 + wave * 8 + q;
    float* lat_out; float* kr_out; u16* kr_bf;
    if (t < TP) {
      int b = t / LP, i = t - b * LP;
      lat_out = p.out + O_LATP + ((size_t)(l * 8 + b) * LP + i) * 256;
      kr_out = p.out + O_KRP + ((size_t)(l * 8 + b) * LP + i) * 32;
      kr_bf = (u16*)(p.ws + WS_KRP) + (size_t)t * 32;
    } else {
      int s = t - TP, sb = s >> 4, j = s & 15;
      lat_out = p.out + O_LATN + ((size_t)(l * 32 + sb) * 16 + j) * 256;
      kr_out = p.out + O_KRN + ((size_t)(l * 32 + sb) * 16 + j) * 32;
      kr_bf = (u16*)(p.ws + WS_KRS) + ((size_t)sb * SK + 2048 + j) * 32;
    }
    f32x4 x = unpack4(*(const u32x2*)(z + (size_t)t * ZC + C_CKV + lane * 4));
    float ss = x[0] * x[0] + x[1] * x[1] + x[2] * x[2] + x[3] * x[3];
#pragma unroll
    for (int m = 1; m < 64; m <<= 1) ss = xor_sum(ss, m);
    float rs = rsqrtf(ss * (1.f / 256.f) + 1e-6f);
    f32x4 gw = ld4(p.in[I_KVNORM] + l * 256 + lane * 4);
    *(f32x4*)(lat_out + lane * 4) = x * rs * gw;
    float x1 = 0.f, x2 = 0.f;
    if (lane < 16) { x1 = bf2f(z[(size_t)t * ZC + C_KR + lane]); x2 = bf2f(z[(size_t)t * ZC + C_KR + 16 + lane]); }
    float s2 = x1 * x1 + x2 * x2;
#pragma unroll
    for (int m = 1; m < 64; m <<= 1) s2 = xor_sum(s2, m);
    float r2 = rsqrtf(s2 * (1.f / 32.f) + 1e-6f);
    if (lane < 16) {
      float y1 = x1 * r2 * p.in[I_KNR][l * 32 + lane], y2 = x2 * r2 * p.in[I_KNR][l * 32 + 16 + lane];
      float c, s;
      rope_cs(tok_pos(t), lane, c, s);
      float o1 = y1 * c - y2 * s, o2 = y1 * s + y2 * c;
      kr_out[lane] = o1; kr_out[16 + lane] = o2;
      kr_bf[lane] = (u16)(pack2(o1, 0.f) & 0xffffu);
      kr_bf[16 + lane] = (u16)(pack2(o2, 0.f) & 0xffffu);
    }
  }
}
DI void pastkr_job(const int tid_, const Params& p, int l, int job) {
  const int tid = tid_;
  const int r = job * 64 + (tid >> 2), c = (tid & 3) * 8;
  const float* src = p.in[I_CKR] + ((size_t)l * 65536 + r) * 32 + c;
  f32x4 a = ld4(src), b = ld4(src + 4);
  u32x2 pa = pack4(a), pb = pack4(b);
  u16* dst = (u16*)(p.ws + WS_KRS) + ((size_t)(r >> 11) * SK + (r & 2047)) * 32 + c;
  *(u32x4*)dst = u32x4{pa.x, pa.y, pb.x, pb.y};
}
DI void shiftrow_job(const int tid_, const Params& p, int l, int job) {
  const u16* z = (const u16*)(p.ws + WS_Z);
  int t; float* dst;
  if (job < 8) { t = job * LP + LP - 1; dst = p.out + O_SHP + (size_t)(l * 8 + job) * 2176; }
  else { int sb = job - 8; t = TP + sb * 16 + 15; dst = p.out + O_SHS + (size_t)(l * 32 + sb) * 2176; }
  for (int c = tid_; c < 2176; c += 256) dst[c] = bf2f(z[(size_t)t * ZC + c]);
}

DI void phase2(const XcdMap xm, const int wv, const Params& p0, int l, char* s0, char* s1, char* s2, int mask = 12) {
  if (mask & 4) { const int tid_ = opaque_tid(wv); const Params p = load_params(p0);
    int m_start, m_cnt; const int total = xcd_total(xm, 261, 8, m_start, m_cnt);
    for (int t = xm.rank; t < total; t += xm.nlb) { int mt_, nt_; xcd_tile(t, m_start, m_cnt, 8, mt_, nt_); rwkv_prep_tile(wv, p, l, mt_, nt_, s0, s1, s2); } }
  if (mask & 8) { const int tid_ = opaque_tid(wv); const Params p = load_params(p0);
#pragma unroll 1
    for (int job = opaque_bid(); job < 1044; job += gridDim.x) lat_job(tid_, p, l, job);
#pragma unroll 1
    for (int job = opaque_bid(); job < 1024; job += gridDim.x) pastkr_job(tid_, p, l, job);
#pragma unroll 1
    for (int job = opaque_bid(); job < 40; job += gridDim.x) shiftrow_job(tid_, p, l, job); }
}

DI float row_allreduce(float x) {
  x += __int_as_float(__builtin_amdgcn_update_dpp(0, __float_as_int(x), 0x128, 0xf, 0xf, false));
  x += __int_as_float(__builtin_amdgcn_update_dpp(0, __float_as_int(x), 0x124, 0xf, 0xf, false));
  x += __int_as_float(__builtin_amdgcn_update_dpp(0, __float_as_int(x), 0x122, 0xf, 0xf, false));
  x += __int_as_float(__builtin_amdgcn_update_dpp(0, __float_as_int(x), 0x121, 0xf, 0xf, false));
  return x;
}

struct ScanRegs { f32x4 d; u32x4 a0, a1; u16 v; };

DI void scan_gload(const int tid_, ScanRegs& r, const Params& p, int tokc, int h, int rg) {
  const int tid = tid_;
  const float* DEC = (const float*)(p.ws + WS_DEC);
  const u16* V = (const u16*)(p.ws + WS_V);
  {
    int st = tid >> 4, c = tid & 15;
    r.d = ld4(DEC + (size_t)(tokc + st) * 512 + h * 64 + c * 4);
    r.v = V[(size_t)(tokc + st) * 512 + h * 64 + rg * 16 + c];
  }
  {
    int arr = tid >> 7, idx = tid & 127, st = idx >> 3, c8 = idx & 7;
    size_t off = (size_t)(tokc + st) * 512 + h * 64 + c8 * 8;
    const u16* s0 = (const u16*)(p.ws + (arr ? WS_KKA : WS_NKK));
    const u16* s1 = (const u16*)(p.ws + (arr ? WS_R : WS_KM));
    r.a0 = *(const u32x4*)(s0 + off);
    r.a1 = *(const u32x4*)(s1 + off);
  }
}
DI void scan_lstore(const int tid_, const ScanRegs& r, float* buf) {
  const int tid = tid_;
  {
    int st = tid >> 4, c = tid & 15;
    *(f32x4*)(buf + st * 64 + c * 4) = r.d;
    buf[5120 + st * 16 + c] = bf2f(r.v);
  }
  {
    int arr = tid >> 7, idx = tid & 127, st = idx >> 3, c8 = idx & 7;
    float* d0 = buf + 1024 + arr * 1024 + st * 64 + c8 * 8;
    float* d1 = buf + 3072 + arr * 1024 + st * 64 + c8 * 8;
    *(f32x4*)(d0) = unpack4(u32x2{r.a0.x, r.a0.y});
    *(f32x4*)(d0 + 4) = unpack4(u32x2{r.a0.z, r.a0.w});
    *(f32x4*)(d1) = unpack4(u32x2{r.a1.x, r.a1.y});
    *(f32x4*)(d1 + 4) = unpack4(u32x2{r.a1.z, r.a1.w});
  }
}

template <int CTRL> DI float dpp_get(float x) { return __int_as_float(__builtin_amdgcn_update_dpp(0, __float_as_int(x), CTRL, 0xf, 0xf, false)); }
DI void scan_chunk(const float* buf, f32x4& S, int w, int rw, int kg, float& ys) {
  float yp[16];
#pragma unroll
  for (int s = 0; s < 16; ++s) {
    const float* b = buf + s * 64 + kg * 4;
    f32x4 d = *(const f32x4*)(b), n = *(const f32x4*)(b + 1024), a = *(const f32x4*)(b + 2048), k = *(const f32x4*)(b + 3072),
          r = *(const f32x4*)(b + 4096);
    float vv = buf[5120 + s * 16 + w * 4 + rw];
    float pp = S[0] * n[0];
    pp = fmaf(S[1], n[1], pp); pp = fmaf(S[2], n[2], pp); pp = fmaf(S[3], n[3], pp);
    float sa = row_allreduce(pp);
#pragma unroll
    for (int e = 0; e < 4; ++e) S[e] = fmaf(sa, a[e], fmaf(S[e], d[e], vv * k[e]));
    float y = S[0] * r[0];
    y = fmaf(S[1], r[1], y); y = fmaf(S[2], r[2], y); y = fmaf(S[3], r[3], y);
    yp[s] = y;
  }
  const bool b3 = (kg & 8) != 0, b2 = (kg & 4) != 0, b1 = (kg & 2) != 0, b0 = (kg & 1) != 0;
  float t[8], u[4], v2[2];
#pragma unroll
  for (int j = 0; j < 8; ++j) { float keep = b3 ? yp[j + 8] : yp[j], send = b3 ? yp[j] : yp[j + 8]; t[j] = keep + dpp_get<0x140>(send); }
#pragma unroll
  for (int j = 0; j < 4; ++j) { float keep = b2 ? t[j + 4] : t[j], send = b2 ? t[j] : t[j + 4]; u[j] = keep + dpp_get<0x141>(send); }
#pragma unroll
  for (int j = 0; j < 2; ++j) { float keep = b1 ? u[j + 2] : u[j], send = b1 ? u[j] : u[j + 2]; v2[j] = keep + dpp_get<0x4E>(send); }
  { float keep = b0 ? v2[1] : v2[0], send = b0 ? v2[0] : v2[1]; ys = keep + dpp_get<0xB1>(send); }
}

DI void scan_job(const int tid_, const Params& p, int l, int job, char* s0, char* s1, char* s2) {
  const int tid = tid_, lane = tid & 63, w = tid >> 6, rw = lane >> 4, kg = lane & 15;
  int h, tok0, nchunks, rg;
  float* sout;
  f32x4 S;
  rg = job & 3;
  const int row = rg * 16 + w * 4 + rw;
  if (job < 256) {
    int seq = job >> 2, b = seq >> 3; h = seq & 7;
    tok0 = b * LP; nchunks = LP / 16;
    sout = p.out + O_SRP + ((((size_t)l * 8 + b) * 8 + h) * 64 + row) * 64 + kg * 4;
    S = f32x4{0.f, 0.f, 0.f, 0.f};
  } else {
    int seq = (job - 256) >> 2, sb = seq >> 3; h = seq & 7;
    tok0 = TP + sb * 16; nchunks = 1;
    sout = p.out + O_SRS + ((((size_t)l * 32 + sb) * 8 + h) * 64 + row) * 64 + kg * 4;
    S = ld4(p.in[I_SRWKV] + ((((size_t)l * 32 + sb) * 8 + h) * 64 + row) * 64 + kg * 4);
  }
  float* buf0 = (float*)s0;
  float* buf1 = (float*)s1;
  float* Y = p.out + O_YP;
  ScanRegs A, B;
  __syncthreads();
  __builtin_amdgcn_s_setprio(3);
  scan_gload(tid_, A, p, tok0, h, rg);
  scan_lstore(tid_, A, buf0);
  if (nchunks > 1) scan_gload(tid_, A, p, tok0 + 16, h, rg);
  __syncthreads();
  for (int c = 0; c < nchunks; c += 2) {
    if (c + 2 < nchunks) scan_gload(tid_, B, p, tok0 + (c + 2) * 16, h, rg);
    float ys = 0.f;
    scan_chunk(buf0, S, w, rw, kg, ys);
    Y[(size_t)(tok0 + c * 16 + kg) * 512 + h * 64 + row] = ys;
    if (c + 1 < nchunks) scan_lstore(tid_, A, buf1);
    __syncthreads();
    if (c + 1 < nchunks) {
      if (c + 3 < nchunks) scan_gload(tid_, A, p, tok0 + (c + 3) * 16, h, rg);
      ys = 0.f;
      scan_chunk(buf1, S, w, rw, kg, ys);
      Y[(size_t)(tok0 + (c + 1) * 16 + kg) * 512 + h * 64 + row] = ys;
      if (c + 2 < nchunks) scan_lstore(tid_, B, buf0);
      __syncthreads();
    }
  }
  *(f32x4*)sout = S;
  __builtin_amdgcn_s_setprio(0);
}

DI void attn_item(const int tid_, const Params& p, int l, int item, char* s0, char* s1, char* s2) {
  const int tid = tid_, lane = tid & 63, w = tid >> 6, g = lane >> 4, c16 = lane & 15;
  int h, qtok0, nq, ntiles, vis, kmode, skv;
  const u16 *KN, *KR, *VT;
  if (item < 256) {
    int sb = item >> 3; h = item & 7;
    qtok0 = TP + sb * 16; nq = 16; ntiles = 33; vis = (w == 0) ? 33 : 0; kmode = 1; skv = SK;
    KN = (const u16*)(p.ws + WS_KS) + (size_t)sb * SK * 512;
    KR = (const u16*)(p.ws + WS_KRS) + (size_t)sb * SK * 32;
    VT = (const u16*)(p.ws + WS_VTS) + (size_t)(sb * 8 + h) * 64 * SK;
  } else {
    int b;
    if (item < 2304) {
      int idx = item - 256, m = 31 - (idx >> 6), bh = idx & 63;
      b = bh >> 3; h = bh & 7;
      qtok0 = b * LP + 16 + 128 * m; nq = 128; ntiles = 2 * m + 3; vis = (w < 2) ? 2 * m + 2 : 2 * m + 3;
    } else {
      int bh = item - 2304;
      b = bh >> 3; h = bh & 7;
      qtok0 = b * LP; nq = 16; ntiles = 1; vis = (w == 0) ? 1 : 0;
    }
    kmode = 0; skv = LP;
    KN = (const u16*)(p.ws + WS_KP) + (size_t)b * LP * 512;
    KR = (const u16*)(p.ws + WS_KRP) + (size_t)b * LP * 32;
    VT = (const u16*)(p.ws + WS_VTP) + (size_t)(b * 8 + h) * 64 * LP;
  }
  const u16* Q = (const u16*)(p.ws + WS_Q);
  bf16x8 qf[2][3];
#pragma unroll
  for (int nt = 0; nt < 2; ++nt) {
    int ql = w * 32 + nt * 16 + c16;
    ql = ql < nq ? ql : nq - 1;
#pragma unroll
    for (int ks = 0; ks < 3; ++ks) qf[nt][ks] = *(const bf16x8*)(Q + (size_t)(qtok0 + ql) * 768 + h * 96 + ks * 32 + g * 8);
  }
  u32x4 kr[3], vr[2];
  auto tile_info = [&](int kt, int& key0, int& nvalid) {
    if (kmode == 0) { if (kt == 0) { key0 = 0; nvalid = 16; } else { key0 = 16 + 64 * (kt - 1); nvalid = 64; } }
    else { key0 = 64 * kt; nvalid = (kt == 32) ? 16 : 64; }
  };
  auto gload = [&](int kt) {
    int key0, nvalid;
    tile_info(kt, key0, nvalid);
#pragma unroll
    for (int i = 0; i < 3; ++i) {
      int idx = tid + 256 * i, row = idx / 12, ch = idx - row * 12;
      const u16* src = (ch < 8) ? KN + (size_t)(key0 + row) * 512 + h * 64 + ch * 8 : KR + (size_t)(key0 + row) * 32 + (ch - 8) * 8;
      kr[i] = (row < nvalid) ? *(const u32x4*)src : u32x4{0, 0, 0, 0};
    }
#pragma unroll
    for (int i = 0; i < 2; ++i) {
      int idx = tid + 256 * i, dv = idx >> 3, ch = idx & 7;
      vr[i] = (ch * 8 < nvalid) ? *(const u32x4*)(VT + (size_t)dv * skv + key0 + ch * 8) : u32x4{0, 0, 0, 0};
    }
  };
  auto lstore = [&](char* buf) {
#pragma unroll
    for (int i = 0; i < 3; ++i) {
      int idx = tid + 256 * i, row = idx / 12, ch = idx - row * 12;
      *(u32x4*)(buf + row * 208 + ch * 16) = kr[i];
    }
#pragma unroll
    for (int i = 0; i < 2; ++i) {
      int idx = tid + 256 * i, dv = idx >> 3, ch = idx & 7;
      *(u32x4*)(buf + 64 * 208 + dv * LDA + ch * 16) = vr[i];
    }
  };
  constexpr int BUFSZ = 64 * 208 + 64 * LDA;
  f32x4 o[4][2];
  float mrow[2], lsum[2];
#pragma unroll
  for (int nt = 0; nt < 2; ++nt) {
    mrow[nt] = -1e30f; lsum[nt] = 0.f;
#pragma unroll
    for (int dt = 0; dt < 4; ++dt) o[dt][nt] = f32x4{0, 0, 0, 0};
  }
  __syncthreads();
  gload(0);
  lstore(s0);
  if (ntiles > 1) gload(1);
  __syncthreads();
  for (int kt = 0; kt < ntiles; ++kt) {
    char* cur = (kt & 1) ? s1 : s0;
    if (kt + 1 < ntiles) {
      lstore(((kt + 1) & 1) ? s1 : s0);
      if (kt + 2 < ntiles) gload(kt + 2);
    }
    if (kt < vis) {
      int key0, nvalid;
      tile_info(kt, key0, nvalid);
      f32x4 s[4][2];
#pragma unroll
      for (int mt = 0; mt < 4; ++mt)
#pragma unroll
        for (int nt = 0; nt < 2; ++nt) s[mt][nt] = f32x4{0, 0, 0, 0};
#pragma unroll
      for (int ks = 0; ks < 3; ++ks)
#pragma unroll
        for (int mt = 0; mt < 4; ++mt) {
          bf16x8 kf = *(const bf16x8*)(cur + (mt * 16 + c16) * 208 + ks * 64 + g * 16);
#pragma unroll
          for (int nt = 0; nt < 2; ++nt) s[mt][nt] = __builtin_amdgcn_mfma_f32_16x16x32_bf16(kf, qf[nt][ks], s[mt][nt], 0, 0, 0);
        }
      if (nvalid < 64) {
#pragma unroll
        for (int mt = 0; mt < 4; ++mt)
#pragma unroll
          for (int nt = 0; nt < 2; ++nt)
#pragma unroll
            for (int e = 0; e < 4; ++e)
              if (mt * 16 + g * 4 + e >= nvalid) s[mt][nt][e] = -1e30f;
      }
      bf16x8 pf[2][2];
#pragma unroll
      for (int nt = 0; nt < 2; ++nt) {
        float mx = -1e30f;
#pragma unroll
        for (int mt = 0; mt < 4; ++mt)
#pragma unroll
          for (int e = 0; e < 4; ++e) mx = fmaxf(mx, s[mt][nt][e]);
        mx = xmax16(mx);
        mx = xmax32(mx);
        const float mnew = fmaxf(mrow[nt], mx);
        const float alpha = __builtin_amdgcn_exp2f(mrow[nt] - mnew);
        mrow[nt] = mnew;
        float ps = 0.f;
#pragma unroll
        for (int mt = 0; mt < 4; ++mt)
#pragma unroll
          for (int e = 0; e < 4; ++e) {
            float pv = __builtin_amdgcn_exp2f(s[mt][nt][e] - mnew);
            s[mt][nt][e] = pv;
            ps += pv;
          }
        lsum[nt] = lsum[nt] * alpha + ps;
        if (__builtin_amdgcn_ballot_w64(alpha != 1.f) != 0ull) {
#pragma unroll
          for (int dt = 0; dt < 4; ++dt) o[dt][nt] *= alpha;
        }
#pragma unroll
        for (int kk = 0; kk < 2; ++kk) {
          u32x2 lo = pack4(s[2 * kk][nt]), hi = pack4(s[2 * kk + 1][nt]);
          u32x4 pk = u32x4{lo.x, lo.y, hi.x, hi.y};
          pf[nt][kk] = __builtin_bit_cast(bf16x8, pk);
        }
      }
      const char* sV = cur + 64 * 208;
#pragma unroll
      for (int dt = 0; dt < 4; ++dt)
#pragma unroll
        for (int kk = 0; kk < 2; ++kk) {
          u32x2 lo = *(const u32x2*)(sV + (dt * 16 + c16) * LDA + (kk * 32 + g * 4) * 2);
          u32x2 hi = *(const u32x2*)(sV + (dt * 16 + c16) * LDA + (kk * 32 + 16 + g * 4) * 2);
          u32x4 pk = u32x4{lo.x, lo.y, hi.x, hi.y};
          bf16x8 vf = __builtin_bit_cast(bf16x8, pk);
#pragma unroll
          for (int nt = 0; nt < 2; ++nt) o[dt][nt] = __builtin_amdgcn_mfma_f32_16x16x32_bf16(vf, pf[nt][kk], o[dt][nt], 0, 0, 0);
        }
    }
    __syncthreads();
  }
  const u16* z = (const u16*)(p.ws + WS_Z);
  u16* YB = (u16*)(p.ws + WS_YB);
#pragma unroll
  for (int nt = 0; nt < 2; ++nt) {
    float lt = lsum[nt];
    lt = xsum16(lt);
    lt = xsum32(lt);
    const int ql = w * 32 + nt * 16 + c16;
    if (ql < nq && vis > 0) {
      const float il = 1.f / lt;
      const int tok = qtok0 + ql;
#pragma unroll
      for (int dt = 0; dt < 4; ++dt) {
        const int dv = dt * 16 + g * 4;
        f32x4 gt = unpack4(*(const u32x2*)(z + (size_t)tok * ZC + C_GB + h * 64 + dv));
        f32x4 ov = o[dt][nt] * il;
#pragma unroll
        for (int e = 0; e < 4; ++e) ov[e] *= siluf_(gt[e]);
        *(u32x2*)(YB + (size_t)tok * 512 + h * 64 + dv) = pack4(ov);
      }
    }
  }
}

DI void phase3(const int wv, const Params& p0, int l, char* s0, char* s1, char* s2, int coff, int mode = 0) {
  const Params p = load_params(p0);
  const int tid_ = opaque_tid(wv);
  unsigned* ctr = (unsigned*)(p.ws + WS_CTR) + l + coff;
  unsigned* done = (unsigned*)(p.ws + WS_CTR) + 8 + l + coff;
  unsigned* scanq = (unsigned*)(p.ws + WS_CTR) + 16 + l + coff;
  int* sjob = (int*)(s2 + 24576 - 16);
  __syncthreads();
  if (tid_ == 0) {
    const unsigned hw = (unsigned)__builtin_amdgcn_s_getreg((31 << 11) | 4);
    const unsigned key = ((xb_xcc_id_early() & 15u) << 8) | ((hw >> 8) & 0xffu);
    unsigned* cue = (unsigned*)(p.ws + WS_CUE) + (size_t)(l + coff) * 4096 + key;
    int j = -1;
    if (add_agent(cue, 1u) == 0u) { const unsigned q = add_agent(scanq, 1u); if (q < 256u) j = (int)q; }
    *sjob = j;
  }
  __syncthreads();
  {
    const int j = *sjob;
    if (j >= 0 && mode != 2) scan_job(opaque_tid(wv), p, l, j, s0, s1, s2);
  }
  constexpr int NQJ = 261 * 2;
  constexpr int J_Q = 773, J_AT = J_Q + NQJ, J_LS = J_AT + 2368, J_SS = J_LS + 256, NJ = J_SS + 1024;
  bool ready = false;
  while (true) {
    __syncthreads();
    if (tid_ == 0) *sjob = (int)atomicAdd(ctr, 1u);
    __syncthreads();
    const int job = *sjob;
    if (job >= NJ) break;
    const int tj = opaque_tid(wv);
    if (job < J_AT) {
      if (job < J_Q) {
#pragma unroll 1
        for (int h = 0; h < 8; ++h) kv_tile(opaque_tid(wv), p, l, job, h, s0, s1, s2);
      } else {
        const int jq = job - J_Q;
#pragma unroll 1
        for (int h = 0; h < 4; ++h) q_tile(opaque_tid(wv), p, l, jq >> 1, (jq & 1) * 4 + h, s0, s1, s2);
      }
      asm volatile("s_waitcnt vmcnt(0)" ::: "memory");
      __syncthreads();
      if (tj == 0) {
        __builtin_amdgcn_fence(__ATOMIC_RELEASE, "agent");
        asm volatile("s_waitcnt vmcnt(0)" ::: "memory");
        add_agent(done, 1u);
      }
    } else if (job < J_LS) {
      if (!ready) {
        if (tj == 0) { while (ld_agent(done) < (unsigned)(773 + NQJ)) __builtin_amdgcn_s_sleep(4); }
        __syncthreads();
        __builtin_amdgcn_fence(__ATOMIC_ACQUIRE, "agent");
        asm volatile("s_waitcnt vmcnt(0)" ::: "memory");
        ready = true;
      }
      if (mode != 1) attn_item(tj, p, l, job - J_AT, s0, s1, s2);
    } else if (job < J_SS) {
      __syncthreads();
      if (tj == 0) { const unsigned q = add_agent(scanq, 1u); *sjob = (q < 256u) ? (int)q : -1; }
      __syncthreads();
      const int j = *sjob;
      if (j >= 0 && mode != 2) scan_job(opaque_tid(wv), p, l, j, s0, s1, s2);
    } else { if (mode != 2) scan_job(tj, p, l, 256 + (job - J_SS), s0, s1, s2); }
  }
}

DI void phase3b(const int wv, const Params& p0, int l) {
  const Params p = load_params(p0);
  const int tid_ = opaque_tid(wv);
  const int tid = tid_, lane = tid & 63, wave = tid >> 6;
  const float* Y = p.out + O_YP;
  const u16* R = (const u16*)(p.ws + WS_R);
  const u16* KM = (const u16*)(p.ws + WS_KM);
  const u16* V = (const u16*)(p.ws + WS_V);
  u16* YA = (u16*)(p.ws + WS_YA);
  for (int job = opaque_bid(); job < 1044; job += gridDim.x) {
    for (int q = 0; q < 8; ++q) {
      const int t = job * 32 + wave * 8 + q;
      const int c = lane * 8;
      const size_t o = (size_t)t * 512 + c;
      f32x4 y0 = ld4(Y + o), y1 = ld4(Y + o + 4);
      float s = y0[0] + y0[1] + y0[2] + y0[3] + y1[0] + y1[1] + y1[2] + y1[3];
      s = xor_sum(s, 1); s = xor_sum(s, 2); s = xor_sum(s, 4);
      const float mu = s * (1.f / 64.f);
      f32x4 d0 = y0 - mu, d1 = y1 - mu;
      float vs = d0[0] * d0[0] + d0[1] * d0[1] + d0[2] * d0[2] + d0[3] * d0[3] + d1[0] * d1[0] + d1[1] * d1[1] + d1[2] * d1[2] + d1[3] * d1[3];
      vs = xor_sum(vs, 1); vs = xor_sum(vs, 2); vs = xor_sum(vs, 4);
      const float rstd = rsqrtf(vs * (1.f / 64.f) + 64e-5f);
      u32x4 rw = *(const u32x4*)(R + o), kw = *(const u32x4*)(KM + o), vw = *(const u32x4*)(V + o);
      f32x4 r0 = unpack4(u32x2{rw.x, rw.y}), r1 = unpack4(u32x2{rw.z, rw.w});
      f32x4 k0 = unpack4(u32x2{kw.x, kw.y}), k1 = unpack4(u32x2{kw.z, kw.w});
      f32x4 v0 = unpack4(u32x2{vw.x, vw.y}), v1 = unpack4(u32x2{vw.z, vw.w});
      f32x4 rk0 = ld4(p.in[I_RK] + l * 512 + c), rk1 = ld4(p.in[I_RK] + l * 512 + c + 4);
      f32x4 b0 = r0 * k0 * rk0, b1 = r1 * k1 * rk1;
      float bs = b0[0] + b0[1] + b0[2] + b0[3] + b1[0] + b1[1] + b1[2] + b1[3];
      bs = xor_sum(bs, 1); bs = xor_sum(bs, 2); bs = xor_sum(bs, 4);
      f32x4 lw0 = ld4(p.in[I_LNW] + l * 512 + c), lw1 = ld4(p.in[I_LNW] + l * 512 + c + 4);
      f32x4 lb0 = ld4(p.in[I_LNB] + l * 512 + c), lb1 = ld4(p.in[I_LNB] + l * 512 + c + 4);
      f32x4 g0 = shifted4(p, l, t, C_G + c), g1 = shifted4(p, l, t, C_G + c + 4);
      f32x4 o0 = d0 * rstd * lw0 + lb0 + v0 * bs;
      f32x4 o1 = d1 * rstd * lw1 + lb1 + v1 * bs;
#pragma unroll
      for (int e = 0; e < 4; ++e) { o0[e] *= siluf_(g0[e]); o1[e] *= siluf_(g1[e]); }
      u32x2 pa = pack4(o0), pb = pack4(o1);
      *(u32x4*)(YA + o) = u32x4{pa.x, pa.y, pb.x, pb.y};
    }
  }
}

DI void phase4(const XcdMap xm, const int wv, const Params& p0, int l, char* s0, char* s1, char* s2) {
  const Params p = load_params(p0);
  const int tid_ = opaque_tid(wv);
  const u16* z = (const u16*)(p.ws + WS_Z);
  u16* U = (u16*)(p.ws + WS_U);
  int m_start, m_cnt;
  const int total = xcd_total(xm, 174, 8, m_start, m_cnt);
#pragma unroll 1
  for (int t = xm.rank; t < total; t += xm.nlb) {
    int mtile, ntile;
    xcd_tile(t, m_start, m_cnt, 8, mtile, ntile);
    const int tl = opaque_tid(wv);
    const int lane = tl & 63, wave = tl >> 6, g = lane >> 4, c16 = lane & 15;
    const int m0 = mtile * 192, n0 = ntile * 128;
    f32x4 acc[6][4];
    {
      gemm_ring<192, 128, 2, 2, 4, true>(tl, (const u16*)(p.ws + WS_YA) + (size_t)m0 * 512, 512,
                                 (const u16*)(p.ws + WS_WA) + ((size_t)l * 1024 + n0) * 512, 512, 127, 16, s0, s1, s2, acc);
    }
    const int wr = wave >> 1, wc = wave & 1;
#pragma unroll
    for (int mt = 0; mt < 6; ++mt) {
      const int m = m0 + wr * 96 + mt * 16 + c16;
#pragma unroll
      for (int nt = 0; nt < 4; nt += 2) {
        const int n = n0 + wc * 64 + g * 16 + nt * 4;
        u32x4 gw = *(const u32x4*)(z + (size_t)m * ZC + C_GA1 + n);
        f32x4 ga0 = unpack4(u32x2{gw.x, gw.y}), ga1 = unpack4(u32x2{gw.z, gw.w});
        f32x4 r0 = acc[mt][nt], r1 = acc[mt][nt + 1];
#pragma unroll
        for (int e = 0; e < 4; ++e) { r0[e] *= sigmoidf_(ga0[e]); r1[e] *= sigmoidf_(ga1[e]); }
        u32x2 a = pack4(r0), b = pack4(r1);
        *(u32x4*)(U + (size_t)m * 1024 + n) = u32x4{a.x, a.y, b.x, b.y};
        __builtin_amdgcn_sched_barrier(0);
      }
    }
    {
      gemm_ring<192, 128, 2, 2, 4, true>(tl, (const u16*)(p.ws + WS_YB) + (size_t)m0 * 512, 512,
                                 (const u16*)(p.ws + WS_WB) + ((size_t)l * 1024 + n0) * 512, 512, 127, 16, s0, s1, s2, acc);
    }
#pragma unroll
    for (int mt = 0; mt < 6; ++mt) {
      const int m = m0 + wr * 96 + mt * 16 + c16;
#pragma unroll
      for (int nt = 0; nt < 4; nt += 2) {
        const int n = n0 + wc * 64 + g * 16 + nt * 4;
        u32x4 gw = *(const u32x4*)(z + (size_t)m * ZC + C_GB1 + n);
        u32x4 uw = *(const u32x4*)(U + (size_t)m * 1024 + n);
        f32x4 gb0 = unpack4(u32x2{gw.x, gw.y}), gb1 = unpack4(u32x2{gw.z, gw.w});
        f32x4 r0 = unpack4(u32x2{uw.x, uw.y}), r1 = unpack4(u32x2{uw.z, uw.w});
#pragma unroll
        for (int e = 0; e < 4; ++e) { r0[e] += acc[mt][nt][e] * sigmoidf_(gb0[e]); r1[e] += acc[mt][nt + 1][e] * sigmoidf_(gb1[e]); }
        u32x2 a = pack4(r0), b = pack4(r1);
        *(u32x4*)(U + (size_t)m * 1024 + n) = u32x4{a.x, a.y, b.x, b.y};
        __builtin_amdgcn_sched_barrier(0);
      }
    }
  }
}

DI void phase5(const XcdMap xm, const int wv, const Params& p0, int l, char* s0, char* s1, char* s2) {
  const Params p = load_params(p0);
  const int tid_ = opaque_tid(wv);
  u16* xb = (u16*)(p.ws + WS_XB);
  int m_start, m_cnt;
  const int total = xcd_total(xm, 174, 8, m_start, m_cnt);
#pragma unroll 1
  for (int t = xm.rank; t < total; t += xm.nlb) {
    int mtile, ntile;
    xcd_tile(t, m_start, m_cnt, 8, mtile, ntile);
    const int tl = opaque_tid(wv);
    const int lane = tl & 63, wave = tl >> 6, g = lane >> 4, c16 = lane & 15;
    const int m0 = mtile * 192, n0 = ntile * 128;
    f32x4 acc[6][4];
    {
      gemm_ring<192, 128, 2, 2, 4, true>(tl, (const u16*)(p.ws + WS_U) + (size_t)m0 * 1024, 1024,
                                 (const u16*)(p.ws + WS_WOUT) + ((size_t)l * 1024 + n0) * 1024, 1024, 127, 32, s0, s1, s2, acc);
    }
    const int wr = wave >> 1, wc = wave & 1;
#pragma unroll
    for (int mt = 0; mt < 6; ++mt) {
      const int m = m0 + wr * 96 + mt * 16 + c16;
      float* xd = x_dst(p, m);
      float psum = 0.f;
#pragma unroll
      for (int nt = 0; nt < 4; nt += 2) {
        const int n = n0 + wc * 64 + g * 16 + nt * 4;
        u32x4 xw = *(const u32x4*)(xb + (size_t)m * 1024 + n);
        f32x4 x0 = unpack4(u32x2{xw.x, xw.y}) + acc[mt][nt], x1 = unpack4(u32x2{xw.z, xw.w}) + acc[mt][nt + 1];
        psum += sum4sq(x0) + sum4sq(x1);
        if (l == 3) { *(f32x4*)(xd + n) = x0; *(f32x4*)(xd + n + 4) = x1; }
        else { u32x2 a = pack4(x0), b = pack4(x1); *(u32x4*)(xb + (size_t)m * 1024 + n) = u32x4{a.x, a.y, b.x, b.y}; }
      }
      psum = xor_sum(psum, 16);
      psum = xor_sum(psum, 32);
      if (g == 0) ((float*)(p.ws + WS_SSX))[(size_t)m * 16 + ntile * 2 + wc] = psum;
    }
  }
}

#define XB_TMO      128
#define XB_XCNT(j)  (256  + 64 * (j))
#define XB_XSUB(j)  (1280 + 64 * (j))
#define XB_XGEN(j)  (2304 + 64 * (j))
#define XB_TOP      3328
#define XB_TOPGEN   3392
#define XCD_BAR_WORDS 3456
#define XB_SPIN_CAP (1u << 22)
DI unsigned xb_ld(unsigned* p) { return __hip_atomic_load(p, __ATOMIC_RELAXED, __HIP_MEMORY_SCOPE_AGENT); }
DI unsigned xb_add(unsigned* p, unsigned v) { return __hip_atomic_fetch_add(p, v, __ATOMIC_RELAXED, __HIP_MEMORY_SCOPE_AGENT); }
DI unsigned xb_xcc_id() { return (unsigned)__builtin_amdgcn_s_getreg((3 << 11) | 20) & 0xFu; }
#define XB_SPIN(cond, bar) do { unsigned _sp = 0; while (cond) { __builtin_amdgcn_s_sleep(1); \
    if ((++_sp & 255u) == 0u) { if (xb_ld(&(bar)[XB_TMO])) break; if (_sp > XB_SPIN_CAP) { atomicAdd(&(bar)[XB_TMO], 1u); break; } } } } while (0)
struct XcdBarrier { unsigned* bar; unsigned x; volatile LAS unsigned* st; };
DI void xcd_barrier_complete(unsigned* bar, unsigned x, unsigned& nloc, unsigned& nx) {
  const unsigned G = gridDim.x;
  unsigned sum, cnt, mine, sp = 0u;
  for (;;) {
    sum = 0u; cnt = 0u; mine = 0u;
#pragma unroll
    for (unsigned j = 0; j < 16; ++j) { const unsigned c = xb_ld(&bar[XB_XCNT(j)]); sum += c; cnt += (c > 0u) ? 1u : 0u; mine = (j == x) ? c : mine; }
    if (sum == G) break;
    __builtin_amdgcn_s_sleep(1);
    if ((++sp & 255u) == 0u) { if (xb_ld(&bar[XB_TMO])) break; if (sp > XB_SPIN_CAP) { atomicAdd(&bar[XB_TMO], 1u); break; } }
  }
  nloc = mine > 0u ? mine : 1u; nx = cnt > 0u ? cnt : 1u;
}
DI void xcd_barrier(const XcdBarrier& b, const int tid) {
  asm volatile("s_waitcnt vmcnt(0)" ::: "memory");
  __syncthreads();
  if (tid == 0) {
    unsigned* bar = b.bar;
    __builtin_amdgcn_s_waitcnt(0);
    unsigned nloc = b.st[0], nx = b.st[1];
    if (nloc == 0u) { xcd_barrier_complete(bar, b.x, nloc, nx); b.st[0] = nloc; b.st[1] = nx; }
    const unsigned old = xb_add(&bar[XB_XSUB(b.x)], 1u);
    const unsigned gen = old / nloc;
    if (old + 1u == (gen + 1u) * nloc) {
      __builtin_amdgcn_fence(__ATOMIC_RELEASE, "agent");
      asm volatile("s_waitcnt vmcnt(0)" ::: "memory");
      const unsigned og = xb_add(&bar[XB_TOP], 1u);
      const unsigned tg = og / nx;
      if (og + 1u == (tg + 1u) * nx) xb_add(&bar[XB_TOPGEN], 1u);
      else XB_SPIN(xb_ld(&bar[XB_TOPGEN]) == tg, bar);
      __builtin_amdgcn_fence(__ATOMIC_ACQUIRE, "agent");
      xb_add(&bar[XB_XGEN(b.x)], 1u);
      asm volatile("s_waitcnt vmcnt(0)" ::: "memory");
    } else {
      XB_SPIN(xb_ld(&bar[XB_XGEN(b.x)]) == gen, bar);
      __builtin_amdgcn_fence(__ATOMIC_ACQUIRE, "agent");
      asm volatile("s_waitcnt vmcnt(0)" ::: "memory");
    }
  }
  __syncthreads();
}

__global__ void __launch_bounds__(256, 2) mega_kernel(Params p) {
  __shared__ __attribute__((aligned(1024))) char lds0[24576];
  __shared__ __attribute__((aligned(1024))) char lds1[24576];
  __shared__ __attribute__((aligned(1024))) char lds2[24576];
  __shared__ __attribute__((aligned(16))) unsigned xbw[4];
  cg::grid_group grid = cg::this_grid();
  const int wv = __builtin_amdgcn_readfirstlane((int)(threadIdx.x >> 6));
  XcdBarrier xb;
  {
    const int t0 = opaque_tid(wv);
    if (t0 == 0) { xbw[0] = 0u; xbw[1] = 0u; xbw[2] = 0u; xbw[3] = 0u; }
    __syncthreads();
    xb.bar = (unsigned*)(p.ws + WS_BAR); xb.x = xb_xcc_id(); xb.st = (volatile LAS unsigned*)xbw;
    if (t0 == 0) xbw[2] = xb_add(&xb.bar[XB_XCNT(xb.x)], 1u);
    __syncthreads();
  }
  XcdMap xm;
  xm.rank = __builtin_amdgcn_readfirstlane((int)xbw[2]);
  xm.xcc = 0; xm.nlb = 1; xm.nx = 1;
  for (int ph = 0; ph < NPH; ++ph) {
    if (ph == 1) {
      if (p.ph_hi < 0) grid.sync();
      xcd_barrier(xb, opaque_tid(wv));
      const int t0 = opaque_tid(wv);
      if (t0 == 0) {
        unsigned mine = 0u, cnt = 0u, idx = 0u;
#pragma unroll
        for (unsigned j = 0; j < 16; ++j) {
          const unsigned c = xb_ld(&xb.bar[XB_XCNT(j)]);
          cnt += (c > 0u) ? 1u : 0u;
          idx += (c > 0u && j < xb.x) ? 1u : 0u;
          mine = (j == xb.x) ? c : mine;
        }
        xbw[0] = mine; xbw[1] = cnt; xbw[3] = idx;
      }
      __syncthreads();
      xm.nlb = __builtin_amdgcn_readfirstlane((int)xbw[0]);
      xm.nx = __builtin_amdgcn_readfirstlane((int)xbw[1]);
      xm.xcc = __builtin_amdgcn_readfirstlane((int)xbw[3]);
    } else if (ph > 1) xcd_barrier(xb, opaque_tid(wv));
    if (ph == 0) phase0(wv, p, lds0, lds1, lds2);
    else {
      const int l = (ph - 1) / 6, s = (ph - 1) - l * 6;
      if (s == 0) phase1(xm, wv, p, l, lds0, lds1, lds2);
      else if (s == 1) phase2(xm, wv, p, l, lds0, lds1, lds2);
      else if (s == 2) phase3(wv, p, l, lds0, lds1, lds2, 0);
      else if (s == 3) phase3b(wv, p, l);
      else if (s == 4) phase4(xm, wv, p, l, lds0, lds1, lds2);
      else phase5(xm, wv, p, l, lds0, lds1, lds2);
#if PROBE_PHASE >= 0
      if (s == PROBE_PHASE) {
        xcd_barrier(xb, opaque_tid(wv));
        if (s == 0) phase1(xm, wv, p, l, lds0, lds1, lds2);
        else if (s == 1) phase2(xm, wv, p, l, lds0, lds1, lds2, PROBE_MODE);
        else if (s == 2) phase3(wv, p, l, lds0, lds1, lds2, 4, PROBE_MODE);
        else if (s == 3) phase3b(wv, p, l);
        else if (s == 4) phase4(xm, wv, p, l, lds0, lds1, lds2);
      }
#endif
    }
  }
}

extern "C" void kernel_launch(void* const* d_in, const int* in_sizes, int n_in, void* d_out, int out_size, void* d_ws, size_t ws_size,
                              hipStream_t stream) {
  static int grid_blocks = 0;
  if (!grid_blocks) {
    int dev = 0, cus = 0, per_cu = 0;
    hipGetDevice(&dev);
    hipDeviceGetAttribute(&cus, hipDeviceAttributeMultiprocessorCount, dev);
    hipOccupancyMaxActiveBlocksPerMultiprocessor(&per_cu, mega_kernel, 256, 0);
    if (per_cu > 2) per_cu = 2;
    if (per_cu < 1) per_cu = 1;
    grid_blocks = cus * per_cu;
  }
  if (ws_size < WS_END) { fprintf(stderr, "workspace too small: %zu < %zu\n", ws_size, (size_t)WS_END); return; }
  Params p{};
  for (int i = 0; i < 30; ++i) p.in[i] = (const float*)d_in[i];
  p.out = (float*)d_out;
  p.ws = (char*)d_ws;
  hipMemsetAsync((char*)d_ws + WS_BAR, 0, 16384, stream);
  p.ph_lo = 0; p.ph_hi = NPH;
  void* args[] = {&p};
  hipError_t e = hipLaunchCooperativeKernel((void*)mega_kernel, dim3(grid_blocks), dim3(256), args, 0, stream);
  if (e != hipSuccess) fprintf(stderr, "cooperative launch failed: %s (grid %d)\n", hipGetErrorString(e), grid_blocks);
}
```

```cpp
#include <hip/hip_runtime.h>
#include <hip/hip_cooperative_groups.h>
#include <stdint.h>
#include <cstdio>
namespace cg = cooperative_groups;

#ifndef PROBE_MODE
#define PROBE_MODE 0
#endif
#ifndef PROBE_PHASE
#define PROBE_PHASE -1
#endif
#ifndef MULTI_LAUNCH
#define MULTI_LAUNCH 0
#endif

typedef unsigned short u16;
typedef __attribute__((ext_vector_type(4))) unsigned u32x4;
typedef __attribute__((ext_vector_type(2))) unsigned u32x2;
typedef __attribute__((ext_vector_type(8))) short bf16x8;
typedef __attribute__((ext_vector_type(4))) float f32x4;
typedef __attribute__((ext_vector_type(2))) float f32x2;
typedef __attribute__((ext_vector_type(2))) __bf16 bf16x2v;
#define DI __device__ __forceinline__
#define LAS __attribute__((address_space(3)))

constexpr int LP = 4112, TP = 8 * LP, TS = 512, T = TP + TS;
constexpr int SK = 2064;
constexpr int ZC = 5408;
constexpr int C_R = 0, C_K = 512, C_V = 1024, C_G = 1536, C_WL = 2048, C_QC = 2176, C_CKV = 2560, C_KR = 2816,
              C_GB = 2848, C_GA1 = 3360, C_GB1 = 4384;
constexpr int NPH = 25;

enum { I_XP = 0, I_XS, I_SRWKV, I_SSHIFT, I_CLAT, I_CKR, I_META, I_NORMW, I_WIN, I_MIX, I_W0, I_W2, I_A0, I_A2, I_KK, I_KA,
       I_RK, I_LNW, I_LNB, I_QNORM, I_WUQ, I_KVNORM, I_WUKV, I_QNN, I_KNN, I_QNR, I_KNR, I_WA, I_WB, I_WOUT };

constexpr size_t O_YP = 0;
constexpr size_t O_YS = O_YP + (size_t)8 * 4096 * 1024;
constexpr size_t O_SRP = O_YS + (size_t)512 * 1024;
constexpr size_t O_SHP = O_SRP + (size_t)4 * 8 * 8 * 64 * 64;
constexpr size_t O_LATP = O_SHP + (size_t)4 * 8 * 2176;
constexpr size_t O_KRP = O_LATP + (size_t)4 * 8 * LP * 256;
constexpr size_t O_SRS = O_KRP + (size_t)4 * 8 * LP * 32;
constexpr size_t O_SHS = O_SRS + (size_t)4 * 32 * 8 * 64 * 64;
constexpr size_t O_LATN = O_SHS + (size_t)4 * 32 * 2176;
constexpr size_t O_KRN = O_LATN + (size_t)4 * 32 * 16 * 256;

constexpr size_t al256(size_t x) { return (x + 255) & ~(size_t)255; }
constexpr size_t WS_WIN = 0;
constexpr size_t WS_W2 = al256(WS_WIN + (size_t)4 * 5504 * 1024 * 2);
constexpr size_t WS_A2 = al256(WS_W2 + (size_t)4 * 512 * 64 * 2);
constexpr size_t WS_WUQ = al256(WS_A2 + (size_t)4 * 512 * 64 * 2);
constexpr size_t WS_WKVF = al256(WS_WUQ + (size_t)4 * 768 * 384 * 2);
constexpr size_t WS_WKVP = al256(WS_WKVF + (size_t)4 * 1024 * 256 * 2);
constexpr size_t WS_WA = al256(WS_WKVP + (size_t)4 * 1024 * 256 * 2);
constexpr size_t WS_WB = al256(WS_WA + (size_t)4 * 1024 * 512 * 2);
constexpr size_t WS_WOUT = al256(WS_WB + (size_t)4 * 1024 * 512 * 2);
constexpr size_t WS_XMETA = al256(WS_WOUT + (size_t)4 * 1024 * 1024 * 2);
constexpr size_t WS_CTR = al256(WS_XMETA + (size_t)128 * 1024 * 4);
constexpr size_t WS_Z = al256(WS_CTR + 1024);
constexpr size_t WS_DEC = al256(WS_Z + (size_t)T * ZC * 2);
constexpr size_t WS_R = al256(WS_DEC + (size_t)T * 512 * 4);
constexpr size_t WS_KM = al256(WS_R + (size_t)T * 512 * 2);
constexpr size_t WS_V = al256(WS_KM + (size_t)T * 512 * 2);
constexpr size_t WS_NKK = al256(WS_V + (size_t)T * 512 * 2);
constexpr size_t WS_KKA = al256(WS_NKK + (size_t)T * 512 * 2);
constexpr size_t WS_Y = al256(WS_KKA + (size_t)T * 512 * 2);
constexpr size_t WS_Q = al256(WS_Y + (size_t)T * 512 * 4);
constexpr size_t WS_KP = al256(WS_Q + (size_t)T * 768 * 2);
constexpr size_t WS_VTP = al256(WS_KP + (size_t)TP * 512 * 2);
constexpr size_t WS_KRP = al256(WS_VTP + (size_t)TP * 512 * 2);
constexpr size_t WS_KS = al256(WS_KRP + (size_t)TP * 32 * 2);
constexpr size_t WS_VTS = al256(WS_KS + (size_t)32 * SK * 512 * 2);
constexpr size_t WS_KRS = al256(WS_VTS + (size_t)32 * SK * 512 * 2 + 4096);
constexpr size_t WS_YB = al256(WS_KRS + (size_t)32 * SK * 32 * 2);
constexpr size_t WS_LATB = al256(WS_YB + (size_t)T * 512 * 2);
constexpr size_t WS_BAR = al256(WS_LATB + (size_t)65536 * 256 * 2);
constexpr size_t WS_TAB = al256(WS_BAR + 16384);
constexpr size_t WS_SSX = al256(WS_TAB + 512);
constexpr size_t WS_SSQ = al256(WS_SSX + (size_t)T * 16 * 4);
constexpr size_t WS_SSKV = al256(WS_SSQ + (size_t)T * 8 * 4);
constexpr size_t WS_CUE = al256(WS_SSKV + (size_t)T * 4 * 4);
constexpr size_t WS_END = al256(WS_CUE + (size_t)8 * 4096 * 4);
constexpr size_t WS_U = WS_DEC;
constexpr size_t WS_YA = WS_Q;
constexpr size_t WS_XB = WS_Y;

struct Params {
  const float* in[30];
  float* out;
  char* ws;
  int ph_lo, ph_hi;
};

DI uint32_t pack2(float a, float b) {
  f32x2 v = {a, b};
  bf16x2v r = __builtin_convertvector(v, bf16x2v);
  return __builtin_bit_cast(uint32_t, r);
}
DI float bflo(uint32_t w) { return __uint_as_float(w << 16); }
DI float bfhi(uint32_t w) { return __uint_as_float(w & 0xffff0000u); }
DI float bf2f(u16 h) { return __uint_as_float(((uint32_t)h) << 16); }
DI f32x4 unpack4(u32x2 w) { return f32x4{bflo(w.x), bfhi(w.x), bflo(w.y), bfhi(w.y)}; }
DI u32x2 pack4(f32x4 v) { return u32x2{pack2(v[0], v[1]), pack2(v[2], v[3])}; }
DI int opaque_tid(const int wv) {
  int lane;
  asm volatile("v_mbcnt_lo_u32_b32 %0, -1, 0\n\tv_mbcnt_hi_u32_b32 %0, -1, %0" : "=v"(lane));
  return (wv << 6) | lane;
}
DI int opaque_bid() { int b = blockIdx.x; asm volatile("" : "+s"(b)); return b; }
DI unsigned xb_xcc_id_early() { return (unsigned)__builtin_amdgcn_s_getreg((3 << 11) | 20) & 0xFu; }
DI unsigned ld_agent(unsigned* p) { return __hip_atomic_load(p, __ATOMIC_RELAXED, __HIP_MEMORY_SCOPE_AGENT); }
DI unsigned add_agent(unsigned* p, unsigned v) { return __hip_atomic_fetch_add(p, v, __ATOMIC_RELAXED, __HIP_MEMORY_SCOPE_AGENT); }
DI float sigmoidf_(float x) { return __builtin_amdgcn_rcpf(1.f + __expf(-x)); }
DI float siluf_(float x) { return x * __builtin_amdgcn_rcpf(1.f + __expf(-x)); }
DI float tanhf_(float x) { return 1.f - 2.f * __builtin_amdgcn_rcpf(__expf(2.f * x) + 1.f); }
DI float xsum16(float x) { u32x2 r = __builtin_amdgcn_permlane16_swap(__float_as_uint(x), __float_as_uint(x), false, false); return __uint_as_float(r.x) + __uint_as_float(r.y); }
DI float xsum32(float x) { u32x2 r = __builtin_amdgcn_permlane32_swap(__float_as_uint(x), __float_as_uint(x), false, false); return __uint_as_float(r.x) + __uint_as_float(r.y); }
DI float xmax16(float x) { u32x2 r = __builtin_amdgcn_permlane16_swap(__float_as_uint(x), __float_as_uint(x), false, false); return fmaxf(__uint_as_float(r.x), __uint_as_float(r.y)); }
DI float xmax32(float x) { u32x2 r = __builtin_amdgcn_permlane32_swap(__float_as_uint(x), __float_as_uint(x), false, false); return fmaxf(__uint_as_float(r.x), __uint_as_float(r.y)); }
DI float xor_sum(float v, int m) {
  if (m == 1) return v + __int_as_float(__builtin_amdgcn_update_dpp(0, __float_as_int(v), 0xB1, 0xf, 0xf, false));
  if (m == 2) return v + __int_as_float(__builtin_amdgcn_update_dpp(0, __float_as_int(v), 0x4E, 0xf, 0xf, false));
  if (m == 4) return v + __int_as_float(__builtin_amdgcn_update_dpp(0, __float_as_int(v), 0x141, 0xf, 0xf, false));
  if (m == 8) return v + __int_as_float(__builtin_amdgcn_update_dpp(0, __float_as_int(v), 0x140, 0xf, 0xf, false));
  if (m == 16) return xsum16(v);
  if (m == 32) return xsum32(v);
  return v + __shfl_xor(v, m);
}
DI f32x4 ld4(const float* p) { return *(const f32x4*)p; }

DI void rope_cs(int pos, int j, float& c, float& s) {
  float inv = exp2f(-(float)j * 0.8304820237218405f);
  float ang = (float)pos * inv;
  double a = (double)ang;
  double k = rint(a * 0.15915494309189535);
  float r = (float)(a - k * 6.283185307179586);
  c = __cosf(r);
  s = __sinf(r);
}
DI int tok_pos(int t) { return (t < TP) ? (t % LP) - 16 : 2048 + ((t - TP) & 15); }

DI const float* x_src(const Params& p, int l, int t) {
  if (t < TP) {
    int b = t / LP, i = t - b * LP;
    if (i < 16) return (l == 0) ? p.in[I_META] + (size_t)i * 1024 : (const float*)(p.ws + WS_XMETA) + (size_t)(b * 16 + i) * 1024;
    return ((l == 0) ? p.in[I_XP] : (const float*)(p.out + O_YP)) + ((size_t)b * 4096 + (i - 16)) * 1024;
  }
  return ((l == 0) ? p.in[I_XS] : (const float*)(p.out + O_YS)) + (size_t)(t - TP) * 1024;
}
DI float* x_dst(const Params& p, int t) {
  if (t < TP) {
    int b = t / LP, i = t - b * LP;
    if (i < 16) return (float*)(p.ws + WS_XMETA) + (size_t)(b * 16 + i) * 1024;
    return p.out + O_YP + ((size_t)b * 4096 + (i - 16)) * 1024;
  }
  return p.out + O_YS + (size_t)(t - TP) * 1024;
}

DI void shifted16(const Params& p, int l, int t, int col, f32x4 (&out)[4]) {
  const u16* z = (const u16*)(p.ws + WS_Z);
  const u16* zc = z + (size_t)t * ZC + col;
  u32x4 c0 = *(const u32x4*)zc, c1 = *(const u32x4*)(zc + 8);
  f32x4 cur[4] = {unpack4(u32x2{c0.x, c0.y}), unpack4(u32x2{c0.z, c0.w}), unpack4(u32x2{c1.x, c1.y}), unpack4(u32x2{c1.z, c1.w})};
  f32x4 prv[4];
  bool first;
  int sb = 0;
  if (t < TP) first = (t % LP) == 0;
  else { int s = t - TP; sb = s >> 4; first = (s & 15) == 0; }
  if (!first) {
    u32x4 q0 = *(const u32x4*)(zc - ZC), q1 = *(const u32x4*)(zc - ZC + 8);
    prv[0] = unpack4(u32x2{q0.x, q0.y}); prv[1] = unpack4(u32x2{q0.z, q0.w});
    prv[2] = unpack4(u32x2{q1.x, q1.y}); prv[3] = unpack4(u32x2{q1.z, q1.w});
  } else if (t < TP) {
#pragma unroll
    for (int j = 0; j < 4; ++j) prv[j] = f32x4{0.f, 0.f, 0.f, 0.f};
  } else {
    const float* ss = p.in[I_SSHIFT] + ((size_t)l * 32 + sb) * 2176 + col;
#pragma unroll
    for (int j = 0; j < 4; ++j) prv[j] = ld4(ss + 4 * j);
  }
  const float* m0 = p.in[I_MIX] + ((size_t)l * 2 + 0) * 2176 + col;
  const float* m1 = p.in[I_MIX] + ((size_t)l * 2 + 1) * 2176 + col;
#pragma unroll
  for (int j = 0; j < 4; ++j) out[j] = cur[j] * ld4(m0 + 4 * j) + prv[j] * ld4(m1 + 4 * j);
}

DI Params load_params(const Params& k) {
  typedef const volatile unsigned long long __attribute__((address_space(4))) * kptr_t;
  kptr_t kp = (kptr_t)__builtin_amdgcn_kernarg_segment_ptr();
  Params q;
#pragma unroll
  for (int i = 0; i < 30; ++i) q.in[i] = (const float*)kp[i];
  q.out = (float*)kp[30];
  q.ws = (char*)kp[31];
  q.ph_lo = 0; q.ph_hi = 0;
  return q;
}

DI f32x4 shifted4(const Params& p, int l, int t, int col) {
  const u16* z = (const u16*)(p.ws + WS_Z);
  f32x4 cur = unpack4(*(const u32x2*)(z + (size_t)t * ZC + col));
  f32x4 prv;
  bool first;
  int sb = 0;
  if (t < TP) first = (t % LP) == 0;
  else { int s = t - TP; sb = s >> 4; first = (s & 15) == 0; }
  if (!first) prv = unpack4(*(const u32x2*)(z + (size_t)(t - 1) * ZC + col));
  else if (t < TP) prv = f32x4{0.f, 0.f, 0.f, 0.f};
  else prv = ld4(p.in[I_SSHIFT] + ((size_t)l * 32 + sb) * 2176 + col);
  f32x4 m0 = ld4(p.in[I_MIX] + ((size_t)l * 2 + 0) * 2176 + col);
  f32x4 m1 = ld4(p.in[I_MIX] + ((size_t)l * 2 + 1) * 2176 + col);
  return cur * m0 + prv * m1;
}

struct XcdMap { int xcc, rank, nlb, nx; };
DI int xcd_total(const XcdMap& xm, int MT, int NT, int& m_start, int& m_cnt) {
  const int base = MT / xm.nx, rem = MT - base * xm.nx;
  m_start = xm.xcc * base + (xm.xcc < rem ? xm.xcc : rem);
  m_cnt = base + (xm.xcc < rem ? 1 : 0);
  return m_cnt * NT;
}
DI void xcd_tile(int t, int m_start, int m_cnt, int NT, int& mtile, int& ntile) {
  const int band = t / (8 * NT);
  const int r = t - band * 8 * NT;
  int bh = m_cnt - band * 8;
  bh = bh < 8 ? bh : 8;
  const int ni = r / bh;
  mtile = m_start + band * 8 + (r - ni * bh);
  ntile = ni;
}

constexpr int LDA = 144;

DI void glds16(const void* g, char* l) {
  __builtin_amdgcn_global_load_lds((const __attribute__((address_space(1))) unsigned*)g, (LAS unsigned*)l, 16, 0, 0);
}
#define WAIT_V(n) asm volatile("s_waitcnt vmcnt(%0)" ::"n"(n) : "memory")
DI void raw_barrier() { asm volatile("s_waitcnt lgkmcnt(0)" ::: "memory"); __builtin_amdgcn_s_barrier(); }
DI int swz4(int q) { return (0x78 >> (2 * q)) & 3; }
template <int OFF> DI bf16x8 ldsr(unsigned a) {
  bf16x8 r;
  asm volatile("ds_read_b128 %0, %1 offset:%2" : "=v"(r) : "v"(a), "n"(OFF));
  return r;
}

template <int BM, int BN, int WR, int WC, int NSWAP, bool PERM = false>
DI void gemm_ring(const int tid_, const u16* __restrict__ Ab, int lda, const u16* __restrict__ Bt, int ldb, int brow_max, int nk,
                  char* s0, char* s1, char* s2, f32x4 (&acc)[BM / WR / 16][BN / WC / 16]) {
  constexpr int MT = BM / WR / 16, NT = BN / WC / 16;
  constexpr int WM = BM / WR, WN = BN / WC;
  constexpr int SA = BM * 64;
  constexpr int LA = BM / 64, LB = BN / 64, LPW = LA + LB;
  static_assert(SA + BN * 64 <= 24576, "stage too large");
  const int tid = tid_, lane = tid & 63, wave = tid >> 6;
  const int wr = wave / WC, wc = wave % WC;
  const int lrow = lane >> 2, lc = (lane & 3) ^ swz4(lane >> 4);
  const u16* ap = Ab + (size_t)(wave * 16 + lrow) * lda + lc * 8;
  const u16* bp[LB];
#pragma unroll
  for (int i = 0; i < LB; ++i) {
    int r = i * 64 + wave * 16 + lrow;
    if (PERM) {
      const int wcg = r / WN, np = r - wcg * WN;
      r = wcg * WN + ((np >> 2) & 3) * (WN / 4) + (np >> 4) * 4 + (np & 3);
    }
    r = r < brow_max ? r : brow_max;
    bp[i] = Bt + (size_t)r * ldb + lc * 8;
  }
#pragma unroll
  for (int mt = 0; mt < MT; ++mt)
#pragma unroll
    for (int nt = 0; nt < NT; ++nt) acc[mt][nt] = f32x4{0.f, 0.f, 0.f, 0.f};
  const int g = lane >> 4;
  const int fo = (lane & 15) * 64 + ((g ^ swz4((lane & 15) >> 2)) * 16);
  auto issue = [&](char* sa, int kt) {
    const int ko = kt * 32;
#pragma unroll
    for (int i = 0; i < LA; ++i) glds16(ap + (size_t)(i * 64) * lda + ko, sa + (i * 4 + wave) * 1024);
#pragma unroll
    for (int i = 0; i < LB; ++i) glds16(bp[i] + ko, sa + SA + (i * 4 + wave) * 1024);
  };
  auto step = [&](int kt, char* cur, char* nxt) {
    if (kt + 1 < nk) WAIT_V(LPW); else WAIT_V(0);
    raw_barrier();
    if (kt + 2 < nk) issue(nxt, kt + 2);
    const unsigned aA = (unsigned)(size_t)cur + (unsigned)((wr * WM) * 64 + fo);
    const unsigned aB = (unsigned)(size_t)cur + (unsigned)(SA + (wc * WN) * 64 + fo);
    bf16x8 xf[MT], wf[NT];
    xf[0] = ldsr<0>(aA);
    if constexpr (MT > 1) xf[1] = ldsr<1024>(aA);
    if constexpr (MT > 2) xf[2] = ldsr<2048>(aA);
    if constexpr (MT > 3) xf[3] = ldsr<3072>(aA);
    if constexpr (MT > 4) xf[4] = ldsr<4096>(aA);
    if constexpr (MT > 5) xf[5] = ldsr<5120>(aA);
    wf[0] = ldsr<0>(aB);
    if constexpr (NT > 1) wf[1] = ldsr<1024>(aB);
    if constexpr (NT > 2) wf[2] = ldsr<2048>(aB);
    if constexpr (NT > 3) wf[3] = ldsr<3072>(aB);
    if constexpr (NT > 4) wf[4] = ldsr<4096>(aB);
    if constexpr (NT > 5) wf[5] = ldsr<5120>(aB);
    if constexpr (NT > 6) wf[6] = ldsr<6144>(aB);
    if constexpr (NT > 7) wf[7] = ldsr<7168>(aB);
    constexpr int NH = NT / 2;
    asm volatile("s_waitcnt lgkmcnt(%0)" ::"n"(NT - NH) : "memory");
#pragma unroll
    for (int mt = 0; mt < MT; ++mt) asm volatile("" : "+v"(xf[mt]));
#pragma unroll
    for (int nt = 0; nt < NH; ++nt) asm volatile("" : "+v"(wf[nt]));
#pragma unroll
    for (int nt = 0; nt < NH; ++nt) {
#pragma unroll
      for (int mt = 0; mt < MT; ++mt) {
        if (nt < NSWAP) acc[mt][nt] = __builtin_amdgcn_mfma_f32_16x16x32_bf16(wf[nt], xf[mt], acc[mt][nt], 0, 0, 0);
        else acc[mt][nt] = __builtin_amdgcn_mfma_f32_16x16x32_bf16(xf[mt], wf[nt], acc[mt][nt], 0, 0, 0);
      }
    }
    asm volatile("s_waitcnt lgkmcnt(0)" ::: "memory");
#pragma unroll
    for (int nt = NH; nt < NT; ++nt) asm volatile("" : "+v"(wf[nt]));
#pragma unroll
    for (int nt = NH; nt < NT; ++nt) {
#pragma unroll
      for (int mt = 0; mt < MT; ++mt) {
        if (nt < NSWAP) acc[mt][nt] = __builtin_amdgcn_mfma_f32_16x16x32_bf16(wf[nt], xf[mt], acc[mt][nt], 0, 0, 0);
        else acc[mt][nt] = __builtin_amdgcn_mfma_f32_16x16x32_bf16(xf[mt], wf[nt], acc[mt][nt], 0, 0, 0);
      }
    }
  };
  WAIT_V(0);
  __syncthreads();
  issue(s0, 0);
  issue(s1, 1);
  for (int kt = 0; kt < nk; kt += 3) {
    step(kt, s0, s2);
    if (kt + 1 < nk) step(kt + 1, s1, s0);
    if (kt + 2 < nk) step(kt + 2, s2, s1);
  }
}

DI float sum4sq(f32x4 v) { return v[0] * v[0] + v[1] * v[1] + v[2] * v[2] + v[3] * v[3]; }

DI void transpose_job(const int tid_, const float* __restrict__ src, const float* __restrict__ scale, u16* __restrict__ dst, u16* __restrict__ dst2,
                      int K, int N, int kt, int nt, char* s0, char* s1, char* s2) {
  float* tile = (float*)s0;
  const int tid = tid_;
  __syncthreads();
#pragma unroll
  for (int i = 0; i < 16; ++i) {
    int kl = (tid >> 6) + 4 * i, nl = tid & 63;
    int k = kt * 64 + kl, n = nt * 64 + nl;
    tile[kl * 65 + nl] = (n < N) ? src[(size_t)k * N + n] : 0.f;
  }
  __syncthreads();
#pragma unroll
  for (int i = 0; i < 16; ++i) {
    int nl = (tid >> 6) + 4 * i, kl = tid & 63;
    int k = kt * 64 + kl, n = nt * 64 + nl;
    float v = tile[kl * 65 + nl];
    float sc = scale ? scale[k] : 1.f;
    dst[(size_t)n * K + k] = (u16)(pack2(v * sc, 0.f) & 0xffffu);
    if (dst2) dst2[(size_t)n * K + k] = (u16)(pack2(v, 0.f) & 0xffffu);
  }
}

DI void phase0(const int wv, const Params& p0, char* s0, char* s1, char* s2) {
  const Params p = load_params(p0);
  const int tid_ = opaque_tid(wv);
  if (opaque_bid() == 0 && tid_ < 64) ((unsigned*)(p.ws + WS_CTR))[tid_] = 0u;
  {
    u16* xb = (u16*)(p.ws + WS_XB);
#pragma unroll 1
    for (int job = opaque_bid(); job < T; job += gridDim.x) {
      const float* xs = x_src(p, 0, job);
      f32x4 xv = ld4(xs + tid_ * 4);
      *(u32x2*)(xb + (size_t)job * 1024 + tid_ * 4) = pack4(xv);
      float ss = sum4sq(xv);
#pragma unroll
      for (int m = 1; m < 64; m <<= 1) ss = xor_sum(ss, m);
      float* ssx = (float*)(p.ws + WS_SSX) + (size_t)job * 16;
      if ((tid_ & 63) == 0) ssx[tid_ >> 6] = ss;
      if (tid_ >= 4 && tid_ < 16) ssx[tid_] = 0.f;
    }
  }
#pragma unroll 1
  for (int job = opaque_bid(); job < 4 * 2040; job += gridDim.x) {
    int l = job / 2040, j = job - l * 2040;
    if (j < 1376) {
      transpose_job(tid_, p.in[I_WIN] + (size_t)l * 1024 * ZC, p.in[I_NORMW] + l * 1024, (u16*)(p.ws + WS_WIN) + (size_t)l * 5504 * 1024, nullptr,
                    1024, ZC, j / 86, j % 86, s0, s1, s2);
    } else if (j < 1384) {
      transpose_job(tid_, p.in[I_W2] + (size_t)l * 64 * 512, nullptr, (u16*)(p.ws + WS_W2) + (size_t)l * 512 * 64, nullptr, 64, 512, 0, j - 1376, s0, s1, s2);
    } else if (j < 1392) {
      transpose_job(tid_, p.in[I_A2] + (size_t)l * 64 * 512, nullptr, (u16*)(p.ws + WS_A2) + (size_t)l * 512 * 64, nullptr, 64, 512, 0, j - 1384, s0, s1, s2);
    } else if (j < 1464) {
      int q = j - 1392;
      transpose_job(tid_, p.in[I_WUQ] + (size_t)l * 384 * 768, p.in[I_QNORM] + l * 384, (u16*)(p.ws + WS_WUQ) + (size_t)l * 768 * 384, nullptr,
                    384, 768, q / 12, q % 12, s0, s1, s2);
    } else if (j < 1528) {
      int q = j - 1464;
      transpose_job(tid_, p.in[I_WUKV] + (size_t)l * 256 * 1024, p.in[I_KVNORM] + l * 256, (u16*)(p.ws + WS_WKVF) + (size_t)l * 1024 * 256,
                    (u16*)(p.ws + WS_WKVP) + (size_t)l * 1024 * 256, 256, 1024, q / 16, q % 16, s0, s1, s2);
    } else if (j < 1656) {
      int q = j - 1528;
      transpose_job(tid_, p.in[I_WA] + (size_t)l * 512 * 1024, nullptr, (u16*)(p.ws + WS_WA) + (size_t)l * 1024 * 512, nullptr, 512, 1024, q / 16, q % 16, s0, s1, s2);
    } else if (j < 1784) {
      int q = j - 1656;
      transpose_job(tid_, p.in[I_WB] + (size_t)l * 512 * 1024, nullptr, (u16*)(p.ws + WS_WB) + (size_t)l * 1024 * 512, nullptr, 512, 1024, q / 16, q % 16, s0, s1, s2);
    } else {
      int q = j - 1784;
      transpose_job(tid_, p.in[I_WOUT] + (size_t)l * 1024 * 1024, nullptr, (u16*)(p.ws + WS_WOUT) + (size_t)l * 1024 * 1024, nullptr, 1024, 1024, q / 16, q % 16, s0, s1, s2);
    }
  }
}

DI void phase1(const XcdMap xm, const int wv, const Params& p0, int l, char* s0, char* s1, char* s2) {
  const Params p = load_params(p0);
  const int tid_ = opaque_tid(wv);
  const int tid = tid_, lane = tid & 63, wave = tid >> 6, g = lane >> 4, c16 = lane & 15;
  u16* z = (u16*)(p.ws + WS_Z);
  {
    const float* src = p.in[I_CLAT] + (size_t)l * 65536 * 256;
    u16* dst = (u16*)(p.ws + WS_LATB);
#pragma unroll 1
    for (int job = opaque_bid(); job < 8192; job += gridDim.x) {
      const size_t e = ((size_t)job * 256 + tid) * 8;
      f32x4 a = ld4(src + e), b = ld4(src + e + 4);
      u32x2 pa = pack4(a), pb = pack4(b);
      *(u32x4*)(dst + e) = u32x4{pa.x, pa.y, pb.x, pb.y};
    }
  }
  int m_start, m_cnt;
  const int total = xcd_total(xm, 261, 22, m_start, m_cnt);
#pragma unroll 1
  for (int t = xm.rank; t < total; t += xm.nlb) {
    int mtile, ntile;
    xcd_tile(t, m_start, m_cnt, 22, mtile, ntile);
    const int m0 = mtile * 128, n0 = ntile * 256;
    if (ntile == 21) {
      const int tl = opaque_tid(wv);
      const int lane = tl & 63, wave = tl >> 6, g = lane >> 4, c16 = lane & 15;
      f32x4 acc2[2][4];
      gemm_ring<128, 64, 4, 1, 4>(tl, (const u16*)(p.ws + WS_XB) + (size_t)m0 * 1024, 1024,
                                  (const u16*)(p.ws + WS_WIN) + ((size_t)l * 5504 + n0) * 1024, 1024, ZC - 1 - n0, 32, s0, s1, s2, acc2);
      const float* ssx = (const float*)(p.ws + WS_SSX);
#pragma unroll
      for (int mt = 0; mt < 2; ++mt) {
        const int m = m0 + wave * 32 + mt * 16 + c16;
        f32x4 s0_ = ld4(ssx + (size_t)m * 16), s1_ = ld4(ssx + (size_t)m * 16 + 4), s2_ = ld4(ssx + (size_t)m * 16 + 8), s3_ = ld4(ssx + (size_t)m * 16 + 12);
        f32x4 st = s0_ + s1_ + s2_ + s3_;
        const float rs = rsqrtf((st[0] + st[1] + st[2] + st[3]) * (1.f / 1024.f) + 1e-6f);
#pragma unroll
        for (int nt = 0; nt < 2; ++nt) {
          const int n = n0 + nt * 16 + g * 4;
          *(u32x2*)(z + (size_t)m * ZC + n) = pack4(acc2[mt][nt] * rs);
        }
      }
      continue;
    }
    f32x4 acc[4][8];
    gemm_ring<128, 256, 2, 2, 8, true>(tid_, (const u16*)(p.ws + WS_XB) + (size_t)m0 * 1024, 1024,
                               (const u16*)(p.ws + WS_WIN) + ((size_t)l * 5504 + n0) * 1024, 1024, ZC - 1 - n0, 32, s0, s1, s2, acc);
    const int wr = wave >> 1, wc = wave & 1;
    const float* ssx = (const float*)(p.ws + WS_SSX);
#pragma unroll
    for (int mt = 0; mt < 4; ++mt) {
      const int m = m0 + wr * 64 + mt * 16 + c16;
      f32x4 s0 = ld4(ssx + (size_t)m * 16), s1 = ld4(ssx + (size_t)m * 16 + 4), s2 = ld4(ssx + (size_t)m * 16 + 8), s3 = ld4(ssx + (size_t)m * 16 + 12);
      f32x4 st = s0 + s1 + s2 + s3;
      const float rs = rsqrtf((st[0] + st[1] + st[2] + st[3]) * (1.f / 1024.f) + 1e-6f);
      float psum = 0.f;
#pragma unroll
      for (int nt = 0; nt < 8; nt += 2) {
        const int n = n0 + wc * 128 + g * 32 + nt * 4;
        f32x4 v0 = acc[mt][nt] * rs, v1 = acc[mt][nt + 1] * rs;
        psum += sum4sq(v0) + sum4sq(v1);
        u32x2 a = pack4(v0), b = pack4(v1);
        *(u32x4*)(z + (size_t)m * ZC + n) = u32x4{a.x, a.y, b.x, b.y};
      }
      const bool isq = (ntile == 8 && wc == 1) || ntile == 9;
      if (isq || ntile == 10) {
        psum = xor_sum(psum, 16);
        psum = xor_sum(psum, 32);
        if (g == 0) {
          if (isq) ((float*)(p.ws + WS_SSQ))[(size_t)m * 8 + (ntile == 8 ? 0 : 1 + wc)] = psum;
          else ((float*)(p.ws + WS_SSKV))[(size_t)m * 4 + wc] = psum;
        }
      }
    }
  }
}

DI void rwkv_prep_tile(const int wv, const Params& p, int l, int mtile, int h, char* s0, char* s1, char* s2) {
  int tid = opaque_tid(wv);
  const u16* z = (const u16*)(p.ws + WS_Z);
  char* sAw = s0;
  char* sAa = s1;
  char* sBw = s2;
  char* sBa = s2 + 64 * LDA;
  const int t0 = mtile * 128;
  __syncthreads();
  {
    const int c8 = (tid & 15) * 8;
#pragma unroll 1
    for (int i = 0; i < 8; ++i) {
      const int row = (tid >> 4) + 16 * i;
      f32x4 a = shifted4(p, l, t0 + row, C_WL + c8);
      f32x4 b = shifted4(p, l, t0 + row, C_WL + c8 + 4);
      if (c8 < 64) {
#pragma unroll
        for (int e = 0; e < 4; ++e) { a[e] = tanhf_(a[e]); b[e] = tanhf_(b[e]); }
      }
      u32x2 pa = pack4(a), pb = pack4(b);
      char* dst = (c8 < 64 ? sAw : sAa) + row * LDA + (c8 & 63) * 2;
      *(u32x4*)dst = u32x4{pa.x, pa.y, pb.x, pb.y};
    }
    const u16* w2 = (const u16*)(p.ws + WS_W2) + ((size_t)l * 512 + h * 64) * 64;
    const u16* a2 = (const u16*)(p.ws + WS_A2) + ((size_t)l * 512 + h * 64) * 64;
#pragma unroll
    for (int i = 0; i < 2; ++i) {
      const int row = (tid >> 3) + 32 * i, ch = tid & 7;
      const int crow = ((row >> 2) & 3) * 16 + (row >> 4) * 4 + (row & 3);
      *(u32x4*)(sBw + row * LDA + ch * 16) = *(const u32x4*)(w2 + crow * 64 + ch * 8);
      *(u32x4*)(sBa + row * LDA + ch * 16) = *(const u32x4*)(a2 + crow * 64 + ch * 8);
    }
  }
  __syncthreads();
  tid = opaque_tid(wv);
  const int lane = tid & 63, wave = tid >> 6, g = lane >> 4, c16 = lane & 15;
  f32x4 accw[2][4], acca[2][4];
#pragma unroll
  for (int mt = 0; mt < 2; ++mt)
#pragma unroll
    for (int nt = 0; nt < 4; ++nt) { accw[mt][nt] = f32x4{0, 0, 0, 0}; acca[mt][nt] = f32x4{0, 0, 0, 0}; }
  const int fo = c16 * LDA + g * 16;
#pragma unroll
  for (int ks = 0; ks < 2; ++ks) {
    bf16x8 xw[2], xa[2], ww[4], wa[4];
#pragma unroll
    for (int mt = 0; mt < 2; ++mt) {
      xw[mt] = *(const bf16x8*)(sAw + (wave * 32 + mt * 16) * LDA + fo + ks * 64);
      xa[mt] = *(const bf16x8*)(sAa + (wave * 32 + mt * 16) * LDA + fo + ks * 64);
    }
#pragma unroll
    for (int nt = 0; nt < 4; ++nt) {
      ww[nt] = *(const bf16x8*)(sBw + (nt * 16) * LDA + fo + ks * 64);
      wa[nt] = *(const bf16x8*)(sBa + (nt * 16) * LDA + fo + ks * 64);
    }
#pragma unroll
    for (int mt = 0; mt < 2; ++mt)
#pragma unroll
      for (int nt = 0; nt < 4; ++nt) {
        accw[mt][nt] = __builtin_amdgcn_mfma_f32_16x16x32_bf16(ww[nt], xw[mt], accw[mt][nt], 0, 0, 0);
        acca[mt][nt] = __builtin_amdgcn_mfma_f32_16x16x32_bf16(wa[nt], xa[mt], acca[mt][nt], 0, 0, 0);
      }
  }
  float* DEC = (float*)(p.ws + WS_DEC);
  u16* R = (u16*)(p.ws + WS_R);
  u16* KM = (u16*)(p.ws + WS_KM);
  u16* V = (u16*)(p.ws + WS_V);
  u16* NKK = (u16*)(p.ws + WS_NKK);
  u16* KKA = (u16*)(p.ws + WS_KKA);
#pragma unroll
  for (int mt = 0; mt < 2; ++mt) {
    const int t = t0 + wave * 32 + mt * 16 + c16;
    const int cb = h * 64 + g * 16;
    const size_t o = (size_t)t * 512 + cb;
    f32x4 k4[4], kk[4];
    {
      f32x4 r4[4];
      shifted16(p, l, t, C_R + cb, r4);
      u32x2 a = pack4(r4[0]), b = pack4(r4[1]), c = pack4(r4[2]), d = pack4(r4[3]);
      *(u32x4*)(R + o) = u32x4{a.x, a.y, b.x, b.y};
      *(u32x4*)(R + o + 8) = u32x4{c.x, c.y, d.x, d.y};
    }
    {
      f32x4 v4[4];
      shifted16(p, l, t, C_V + cb, v4);
      u32x2 a = pack4(v4[0]), b = pack4(v4[1]), c = pack4(v4[2]), d = pack4(v4[3]);
      *(u32x4*)(V + o) = u32x4{a.x, a.y, b.x, b.y};
      *(u32x4*)(V + o + 8) = u32x4{c.x, c.y, d.x, d.y};
    }
    shifted16(p, l, t, C_K + cb, k4);
    float ssq = 0.f;
#pragma unroll
    for (int nt = 0; nt < 4; ++nt) {
      const int c = cb + nt * 4;
      f32x4 a0 = ld4(p.in[I_A0] + l * 512 + c), w0 = ld4(p.in[I_W0] + l * 512 + c);
      f32x4 a, dec;
#pragma unroll
      for (int e = 0; e < 4; ++e) {
        a[e] = sigmoidf_(a0[e] + acca[mt][nt][e]);
        float x = -(w0[e] + accw[mt][nt][e]);
        float sp = fmaxf(x, 0.f) + __logf(1.f + __expf(-fabsf(x)));
        float w = -sp - 0.5f;
        dec[e] = __expf(-__expf(w));
      }
      acca[mt][nt] = a;
      *(f32x4*)(DEC + o + nt * 4) = dec;
      f32x4 k_k = ld4(p.in[I_KK] + l * 512 + c);
      kk[nt] = k4[nt] * k_k;
      ssq += sum4sq(kk[nt]);
    }
    ssq = xor_sum(ssq, 16);
    ssq = xor_sum(ssq, 32);
    const float inv = rsqrtf(fmaxf(ssq, 1e-24f));
    u32x2 pn[4], pa[4], pk[4];
#pragma unroll
    for (int nt = 0; nt < 4; ++nt) {
      const int c = cb + nt * 4;
      f32x4 k_a = ld4(p.in[I_KA] + l * 512 + c);
      f32x4 kn = kk[nt] * inv;
      f32x4 av = acca[mt][nt];
      f32x4 one = f32x4{1.f, 1.f, 1.f, 1.f};
      pn[nt] = pack4(-kn);
      pa[nt] = pack4(kn * av);
      pk[nt] = pack4(k4[nt] * (one + (av - one) * k_a));
    }
    *(u32x4*)(NKK + o) = u32x4{pn[0].x, pn[0].y, pn[1].x, pn[1].y};
    *(u32x4*)(NKK + o + 8) = u32x4{pn[2].x, pn[2].y, pn[3].x, pn[3].y};
    *(u32x4*)(KKA + o) = u32x4{pa[0].x, pa[0].y, pa[1].x, pa[1].y};
    *(u32x4*)(KKA + o + 8) = u32x4{pa[2].x, pa[2].y, pa[3].x, pa[3].y};
    *(u32x4*)(KM + o) = u32x4{pk[0].x, pk[0].y, pk[1].x, pk[1].y};
    *(u32x4*)(KM + o + 8) = u32x4{pk[2].x, pk[2].y, pk[3].x, pk[3].y};
    __builtin_amdgcn_sched_barrier(0);
  }
}

DI void q_tile(const int tid_, const Params& p, int l, int mtile, int h, char* s0, char* s1, char* s2) {
  const int tid = tid_, lane = tid & 63, wave = tid >> 6, g = lane >> 4, c16 = lane & 15;
  const int m0 = mtile * 128;
  f32x4 acc[2][8];
  gemm_ring<128, 128, 4, 1, 8>(tid_, (const u16*)(p.ws + WS_Z) + (size_t)m0 * ZC + C_QC, ZC,
                             (const u16*)(p.ws + WS_WUQ) + ((size_t)l * 768 + h * 96) * 384, 384, 767 - h * 96, 12, s0, s1, s2, acc);
  u16* Q = (u16*)(p.ws + WS_Q);
  const float qscale = 0.14724576f;
#pragma unroll
  for (int mt = 0; mt < 2; ++mt) {
    const int ml = wave * 32 + mt * 16 + c16;
    const int t = m0 + ml;
    float rs;
    {
      const float* sq = (const float*)(p.ws + WS_SSQ) + (size_t)t * 8;
      rs = rsqrtf((sq[0] + sq[1] + sq[2]) * (1.f / 384.f) + 1e-6f);
    }
    float ssn = 0.f, ssr = 0.f;
#pragma unroll
    for (int nt = 0; nt < 6; ++nt) {
      acc[mt][nt] *= rs;
      float s = acc[mt][nt][0] * acc[mt][nt][0] + acc[mt][nt][1] * acc[mt][nt][1] + acc[mt][nt][2] * acc[mt][nt][2] + acc[mt][nt][3] * acc[mt][nt][3];
      if (nt < 4) ssn += s; else ssr += s;
    }
    ssn = xor_sum(ssn, 16); ssn = xor_sum(ssn, 32);
    ssr = xor_sum(ssr, 16); ssr = xor_sum(ssr, 32);
    const float rn = rsqrtf(ssn * (1.f / 64.f) + 1e-6f) * qscale;
    const float rr = rsqrtf(ssr * (1.f / 32.f) + 1e-6f) * qscale;
    u16* qrow = Q + (size_t)t * 768 + h * 96;
#pragma unroll
    for (int nt = 0; nt < 4; ++nt) {
      const int n = nt * 16 + g * 4;
      f32x4 gw = ld4(p.in[I_QNN] + l * 64 + n);
      *(u32x2*)(qrow + n) = pack4(acc[mt][nt] * gw * rn);
    }
    const int pos = tok_pos(t);
    const int j0 = g * 4;
    f32x4 g1 = ld4(p.in[I_QNR] + l * 32 + j0), g2 = ld4(p.in[I_QNR] + l * 32 + 16 + j0);
    f32x4 o1, o2;
#pragma unroll
    for (int e = 0; e < 4; ++e) {
      float c, s;
      rope_cs(pos, j0 + e, c, s);
      float x1 = acc[mt][4][e] * g1[e] * rr, x2 = acc[mt][5][e] * g2[e] * rr;
      o1[e] = x1 * c - x2 * s;
      o2[e] = x1 * s + x2 * c;
    }
    *(u32x2*)(qrow + 64 + j0) = pack4(o1);
    *(u32x2*)(qrow + 80 + j0) = pack4(o2);
  }
}

DI void kv_tile(const int tid_, const Params& p, int l, int mtile, int h, char* s0, char* s1, char* s2) {
  const int tid = tid_, lane = tid & 63, wave = tid >> 6, g = lane >> 4, c16 = lane & 15;
  f32x4 acc[2][8];
  const bool past = mtile >= 261;
  const int m0 = past ? (mtile - 261) * 128 : mtile * 128;
  if (!past) {
    gemm_ring<128, 128, 4, 1, 4>(tid_, (const u16*)(p.ws + WS_Z) + (size_t)m0 * ZC + C_CKV, ZC,
                               (const u16*)(p.ws + WS_WKVF) + ((size_t)l * 1024 + h * 128) * 256, 256, 127, 8, s0, s1, s2, acc);
  } else {
    gemm_ring<128, 128, 4, 1, 4>(tid_, (const u16*)(p.ws + WS_LATB) + (size_t)m0 * 256, 256,
                               (const u16*)(p.ws + WS_WKVP) + ((size_t)l * 1024 + h * 128) * 256, 256, 127, 8, s0, s1, s2, acc);
  }
  u16 *KN, *VT;
  int skv;
  if (!past && m0 < TP) { KN = (u16*)(p.ws + WS_KP); VT = (u16*)(p.ws + WS_VTP); skv = LP; }
  else { KN = (u16*)(p.ws + WS_KS); VT = (u16*)(p.ws + WS_VTS); skv = SK; }
#pragma unroll
  for (int mt = 0; mt < 2; ++mt) {
    {
      const int ml = wave * 32 + mt * 16 + c16;
      const int r = m0 + ml;
      float rs = 1.f;
      if (!past) { f32x4 s0 = ld4((const float*)(p.ws + WS_SSKV) + (size_t)r * 4); rs = rsqrtf((s0[0] + s0[1]) * (1.f / 256.f) + 1e-6f); }
      size_t krow;
      if (past) krow = (size_t)(r >> 11) * SK + (r & 2047);
      else if (r < TP) krow = r;
      else { int s = r - TP; krow = (size_t)(s >> 4) * SK + 2048 + (s & 15); }
      float ss = 0.f;
#pragma unroll
      for (int nt = 0; nt < 4; ++nt) {
        acc[mt][nt] *= rs;
        ss += acc[mt][nt][0] * acc[mt][nt][0] + acc[mt][nt][1] * acc[mt][nt][1] + acc[mt][nt][2] * acc[mt][nt][2] + acc[mt][nt][3] * acc[mt][nt][3];
      }
      ss = xor_sum(ss, 16); ss = xor_sum(ss, 32);
      const float rn = rsqrtf(ss * (1.f / 64.f) + 1e-6f);
#pragma unroll
      for (int nt = 0; nt < 4; ++nt) {
        const int n = nt * 16 + g * 4;
        f32x4 gw = ld4(p.in[I_KNN] + l * 64 + n);
        *(u32x2*)(KN + krow * 512 + h * 64 + n) = pack4(acc[mt][nt] * gw * rn);
      }
    }
    {
      const int mlb = wave * 32 + mt * 16 + g * 4;
      const int r = m0 + mlb;
      f32x4 rs4 = f32x4{1.f, 1.f, 1.f, 1.f};
      if (!past) {
        const float* sk = (const float*)(p.ws + WS_SSKV) + (size_t)r * 4;
#pragma unroll
        for (int e = 0; e < 4; ++e) { f32x4 s0 = ld4(sk + e * 4); rs4[e] = rsqrtf((s0[0] + s0[1]) * (1.f / 256.f) + 1e-6f); }
      }
      size_t vrow;
      if (past) vrow = ((size_t)((r >> 11) * 8 + h) * 64) * SK + (r & 2047);
      else if (r < TP) { int b = r / LP; vrow = ((size_t)(b * 8 + h) * 64) * LP + (r - b * LP); }
      else { int s = r - TP; vrow = ((size_t)((s >> 4) * 8 + h) * 64) * SK + 2048 + (s & 15); }
#pragma unroll
      for (int nt = 4; nt < 8; ++nt) {
        const int dv = (nt - 4) * 16 + c16;
        *(u32x2*)(VT + vrow + (size_t)dv * skv) = pack4(acc[mt][nt] * rs4);
      }
    }
  }
}

DI void lat_job(const int tid_, const Params& p, int l, int job) {
  const int tid = tid_, lane = tid & 63, wave = tid >> 6;
  const u16* z = (const u16*)(p.ws + WS_Z);
  for (int q = 0; q < 8; ++q) {
    const int t = job * 32 + wave * 8 + q;
    float* lat_out; float* kr_out; u16* kr_bf;
    if (t < TP) {
      int b = t / LP, i = t - b * LP;
      lat_out = p.out + O_LATP + ((size_t)(l * 8 + b) * LP + i) * 256;
      kr_out = p.out + O_KRP + ((size_t)(l * 8 + b) * LP + i) * 32;
      kr_bf = (u16*)(p.ws + WS_KRP) + (size_t)t * 32;
    } else {
      int s = t - TP, sb = s >> 4, j = s & 15;
      lat_out = p.out + O_LATN + ((size_t)(l * 32 + sb) * 16 + j) * 256;
      kr_out = p.out + O_KRN + ((size_t)(l * 32 + sb) * 16 + j) * 32;
      kr_bf = (u16*)(p.ws + WS_KRS) + ((size_t)sb * SK + 2048 + j) * 32;
    }
    f32x4 x = unpack4(*(const u32x2*)(z + (size_t)t * ZC + C_CKV + lane * 4));
    float ss = x[0] * x[0] + x[1] * x[1] + x[2] * x[2] + x[3] * x[3];
#pragma unroll
    for (int m = 1; m < 64; m <<= 1) ss = xor_sum(ss, m);
    float rs = rsqrtf(ss * (1.f / 256.f) + 1e-6f);
    f32x4 gw = ld4(p.in[I_KVNORM] + l * 256 + lane * 4);
    *(f32x4*)(lat_out + lane * 4) = x * rs * gw;
    float x1 = 0.f, x2 = 0.f;
    if (lane < 16) { x1 = bf2f(z[(size_t)t * ZC + C_KR + lane]); x2 = bf2f(z[(size_t)t * ZC + C_KR + 16 + lane]); }
    float s2 = x1 * x1 + x2 * x2;
#pragma unroll
    for (int m = 1; m < 64; m <<= 1) s2 = xor_sum(s2, m);
    float r2 = rsqrtf(s2 * (1.f / 32.f) + 1e-6f);
    if (lane < 16) {
      float y1 = x1 * r2 * p.in[I_KNR][l * 32 + lane], y2 = x2 * r2 * p.in[I_KNR][l * 32 + 16 + lane];
      float c, s;
      rope_cs(tok_pos(t), lane, c, s);
      float o1 = y1 * c - y2 * s, o2 = y1 * s + y2 * c;
      kr_out[lane] = o1; kr_out[16 + lane] = o2;
      kr_bf[lane] = (u16)(pack2(o1, 0.f) & 0xffffu);
      kr_bf[16 + lane] = (u16)(pack2(o2, 0.f) & 0xffffu);
    }
  }
}
DI void pastkr_job(const int tid_, const Params& p, int l, int job) {
  const int tid = tid_;
  const int r = job * 64 + (tid >> 2), c = (tid & 3) * 8;
  const float* src = p.in[I_CKR] + ((size_t)l * 65536 + r) * 32 + c;
  f32x4 a = ld4(src), b = ld4(src + 4);
  u32x2 pa = pack4(a), pb = pack4(b);
  u16* dst = (u16*)(p.ws + WS_KRS) + ((size_t)(r >> 11) * SK + (r & 2047)) * 32 + c;
  *(u32x4*)dst = u32x4{pa.x, pa.y, pb.x, pb.y};
}
DI void shiftrow_job(const int tid_, const Params& p, int l, int job) {
  const u16* z = (const u16*)(p.ws + WS_Z);
  int t; float* dst;
  if (job < 8) { t = job * LP + LP - 1; dst = p.out + O_SHP + (size_t)(l * 8 + job) * 2176; }
  else { int sb = job - 8; t = TP + sb * 16 + 15; dst = p.out + O_SHS + (size_t)(l * 32 + sb) * 2176; }
  for (int c = tid_; c < 2176; c += 256) dst[c] = bf2f(z[(size_t)t * ZC + c]);
}

DI void phase2(const XcdMap xm, const int wv, const Params& p0, int l, char* s0, char* s1, char* s2, int mask = 12) {
  if (mask & 4) { const int tid_ = opaque_tid(wv); const Params p = load_params(p0);
    int m_start, m_cnt; const int total = xcd_total(xm, 261, 8, m_start, m_cnt);
    for (int t = xm.rank; t < total; t += xm.nlb) { int mt_, nt_; xcd_tile(t, m_start, m_cnt, 8, mt_, nt_); rwkv_prep_tile(wv, p, l, mt_, nt_, s0, s1, s2); } }
  if (mask & 8) { const int tid_ = opaque_tid(wv); const Params p = load_params(p0);
#pragma unroll 1
    for (int job = opaque_bid(); job < 1044; job += gridDim.x) lat_job(tid_, p, l, job);
#pragma unroll 1
    for (int job = opaque_bid(); job < 1024; job += gridDim.x) pastkr_job(tid_, p, l, job);
#pragma unroll 1
    for (int job = opaque_bid(); job < 40; job += gridDim.x) shiftrow_job(tid_, p, l, job); }
}

DI float row_allreduce(float x) {
  x += __int_as_float(__builtin_amdgcn_update_dpp(0, __float_as_int(x), 0x128, 0xf, 0xf, false));
  x += __int_as_float(__builtin_amdgcn_update_dpp(0, __float_as_int(x), 0x124, 0xf, 0xf, false));
  x += __int_as_float(__builtin_amdgcn_update_dpp(0, __float_as_int(x), 0x122, 0xf, 0xf, false));
  x += __int_as_float(__builtin_amdgcn_update_dpp(0, __float_as_int(x), 0x121, 0xf, 0xf, false));
  return x;
}

struct ScanRegs { f32x4 d; u32x4 a0, a1; u16 v; };

DI void scan_gload(const int tid_, ScanRegs& r, const Params& p, int tokc, int h, int rg) {
  const int tid = tid_;
  const float* DEC = (const float*)(p.ws + WS_DEC);
  const u16* V = (const u16*)(p.ws + WS_V);
  {
    int st = tid >> 4, c = tid & 15;
    r.d = ld4(DEC + (size_t)(tokc + st) * 512 + h * 64 + c * 4);
    r.v = V[(size_t)(tokc + st) * 512 + h * 64 + rg * 16 + c];
  }
  {
    int arr = tid >> 7, idx = tid & 127, st = idx >> 3, c8 = idx & 7;
    size_t off = (size_t)(tokc + st) * 512 + h * 64 + c8 * 8;
    const u16* s0 = (const u16*)(p.ws + (arr ? WS_KKA : WS_NKK));
    const u16* s1 = (const u16*)(p.ws + (arr ? WS_R : WS_KM));
    r.a0 = *(const u32x4*)(s0 + off);
    r.a1 = *(const u32x4*)(s1 + off);
  }
}
DI void scan_lstore(const int tid_, const ScanRegs& r, float* buf) {
  const int tid = tid_;
  {
    int st = tid >> 4, c = tid & 15;
    *(f32x4*)(buf + st * 64 + c * 4) = r.d;
    buf[5120 + st * 16 + c] = bf2f(r.v);
  }
  {
    int arr = tid >> 7, idx = tid & 127, st = idx >> 3, c8 = idx & 7;
    float* d0 = buf + 1024 + arr * 1024 + st * 64 + c8 * 8;
    float* d1 = buf + 3072 + arr * 1024 + st * 64 + c8 * 8;
    *(f32x4*)(d0) = unpack4(u32x2{r.a0.x, r.a0.y});
    *(f32x4*)(d0 + 4) = unpack4(u32x2{r.a0.z, r.a0.w});
    *(f32x4*)(d1) = unpack4(u32x2{r.a1.x, r.a1.y});
    *(f32x4*)(d1 + 4) = unpack4(u32x2{r.a1.z, r.a1.w});
  }
}

template <int CTRL> DI float dpp_get(float x) { return __int_as_float(__builtin_amdgcn_update_dpp(0, __float_as_int(x), CTRL, 0xf, 0xf, false)); }
DI void scan_chunk(const float* buf, f32x4& S, int w, int rw, int kg, float& ys) {
  float yp[16];
#pragma unroll
  for (int s = 0; s < 16; ++s) {
    const float* b = buf + s * 64 + kg * 4;
    f32x4 d = *(const f32x4*)(b), n = *(const f32x4*)(b + 1024), a = *(const f32x4*)(b + 2048), k = *(const f32x4*)(b + 3072),
          r = *(const f32x4*)(b + 4096);
    float vv = buf[5120 + s * 16 + w * 4 + rw];
    float pp = S[0] * n[0];
    pp = fmaf(S[1], n[1], pp); pp = fmaf(S[2], n[2], pp); pp = fmaf(S[3], n[3], pp);
    float sa = row_allreduce(pp);
#pragma unroll
    for (int e = 0; e < 4; ++e) S[e] = fmaf(sa, a[e], fmaf(S[e], d[e], vv * k[e]));
    float y = S[0] * r[0];
    y = fmaf(S[1], r[1], y); y = fmaf(S[2], r[2], y); y = fmaf(S[3], r[3], y);
    yp[s] = y;
  }
  const bool b3 = (kg & 8) != 0, b2 = (kg & 4) != 0, b1 = (kg & 2) != 0, b0 = (kg & 1) != 0;
  float t[8], u[4], v2[2];
#pragma unroll
  for (int j = 0; j < 8; ++j) { float keep = b3 ? yp[j + 8] : yp[j], send = b3 ? yp[j] : yp[j + 8]; t[j] = keep + dpp_get<0x140>(send); }
#pragma unroll
  for (int j = 0; j < 4; ++j) { float keep = b2 ? t[j + 4] : t[j], send = b2 ? t[j] : t[j + 4]; u[j] = keep + dpp_get<0x141>(send); }
#pragma unroll
  for (int j = 0; j < 2; ++j) { float keep = b1 ? u[j + 2] : u[j], send = b1 ? u[j] : u[j + 2]; v2[j] = keep + dpp_get<0x4E>(send); }
  { float keep = b0 ? v2[1] : v2[0], send = b0 ? v2[0] : v2[1]; ys = keep + dpp_get<0xB1>(send); }
}

DI void scan_job(const int tid_, const Params& p, int l, int job, char* s0, char* s1, char* s2) {
  const int tid = tid_, lane = tid & 63, w = tid >> 6, rw = lane >> 4, kg = lane & 15;
  int h, tok0, nchunks, rg;
  float* sout;
  f32x4 S;
  rg = job & 3;
  const int row = rg * 16 + w * 4 + rw;
  if (job < 256) {
    int seq = job >> 2, b = seq >> 3; h = seq & 7;
    tok0 = b * LP; nchunks = LP / 16;
    sout = p.out + O_SRP + ((((size_t)l * 8 + b) * 8 + h) * 64 + row) * 64 + kg * 4;
    S = f32x4{0.f, 0.f, 0.f, 0.f};
  } else {
    int seq = (job - 256) >> 2, sb = seq >> 3; h = seq & 7;
    tok0 = TP + sb * 16; nchunks = 1;
    sout = p.out + O_SRS + ((((size_t)l * 32 + sb) * 8 + h) * 64 + row) * 64 + kg * 4;
    S = ld4(p.in[I_SRWKV] + ((((size_t)l * 32 + sb) * 8 + h) * 64 + row) * 64 + kg * 4);
  }
  float* buf0 = (float*)s0;
  float* buf1 = (float*)s1;
  float* Y = p.out + O_YP;
  ScanRegs A, B;
  __syncthreads();
  __builtin_amdgcn_s_setprio(3);
  scan_gload(tid_, A, p, tok0, h, rg);
  scan_lstore(tid_, A, buf0);
  if (nchunks > 1) scan_gload(tid_, A, p, tok0 + 16, h, rg);
  __syncthreads();
  for (int c = 0; c < nchunks; c += 2) {
    if (c + 2 < nchunks) scan_gload(tid_, B, p, tok0 + (c + 2) * 16, h, rg);
    float ys = 0.f;
    scan_chunk(buf0, S, w, rw, kg, ys);
    Y[(size_t)(tok0 + c * 16 + kg) * 512 + h * 64 + row] = ys;
    if (c + 1 < nchunks) scan_lstore(tid_, A, buf1);
    __syncthreads();
    if (c + 1 < nchunks) {
      if (c + 3 < nchunks) scan_gload(tid_, A, p, tok0 + (c + 3) * 16, h, rg);
      ys = 0.f;
      scan_chunk(buf1, S, w, rw, kg, ys);
      Y[(size_t)(tok0 + (c + 1) * 16 + kg) * 512 + h * 64 + row] = ys;
      if (c + 2 < nchunks) scan_lstore(tid_, B, buf0);
      __syncthreads();
    }
  }
  *(f32x4*)sout = S;
  __builtin_amdgcn_s_setprio(0);
}

DI void attn_item(const int tid_, const Params& p, int l, int item, char* s0, char* s1, char* s2) {
  const int tid = tid_, lane = tid & 63, w = tid >> 6, g = lane >> 4, c16 = lane & 15;
  int h, qtok0, nq, ntiles, vis, kmode, skv;
  const u16 *KN, *KR, *VT;
  if (item < 256) {
    int sb = item >> 3; h = item & 7;
    qtok0 = TP + sb * 16; nq = 16; ntiles = 33; vis = (w == 0) ? 33 : 0; kmode = 1; skv = SK;
    KN = (const u16*)(p.ws + WS_KS) + (size_t)sb * SK * 512;
    KR = (const u16*)(p.ws + WS_KRS) + (size_t)sb * SK * 32;
    VT = (const u16*)(p.ws + WS_VTS) + (size_t)(sb * 8 + h) * 64 * SK;
  } else {
    int b;
    if (item < 2304) {
      int idx = item - 256, m = 31 - (idx >> 6), bh = idx & 63;
      b = bh >> 3; h = bh & 7;
      qtok0 = b * LP + 16 + 128 * m; nq = 128; ntiles = 2 * m + 3; vis = (w < 2) ? 2 * m + 2 : 2 * m + 3;
    } else {
      int bh = item - 2304;
      b = bh >> 3; h = bh & 7;
      qtok0 = b * LP; nq = 16; ntiles = 1; vis = (w == 0) ? 1 : 0;
    }
    kmode = 0; skv = LP;
    KN = (const u16*)(p.ws + WS_KP) + (size_t)b * LP * 512;
    KR = (const u16*)(p.ws + WS_KRP) + (size_t)b * LP * 32;
    VT = (const u16*)(p.ws + WS_VTP) + (size_t)(b * 8 + h) * 64 * LP;
  }
  const u16* Q = (const u16*)(p.ws + WS_Q);
  bf16x8 qf[2][3];
#pragma unroll
  for (int nt = 0; nt < 2; ++nt) {
    int ql = w * 32 + nt * 16 + c16;
    ql = ql < nq ? ql : nq - 1;
#pragma unroll
    for (int ks = 0; ks < 3; ++ks) qf[nt][ks] = *(const bf16x8*)(Q + (size_t)(qtok0 + ql) * 768 + h * 96 + ks * 32 + g * 8);
  }
  u32x4 kr[3], vr[2];
  auto tile_info = [&](int kt, int& key0, int& nvalid) {
    if (kmode == 0) { if (kt == 0) { key0 = 0; nvalid = 16; } else { key0 = 16 + 64 * (kt - 1); nvalid = 64; } }
    else { key0 = 64 * kt; nvalid = (kt == 32) ? 16 : 64; }
  };
  auto gload = [&](int kt) {
    int key0, nvalid;
    tile_info(kt, key0, nvalid);
#pragma unroll
    for (int i = 0; i < 3; ++i) {
      int idx = tid + 256 * i, row = idx / 12, ch = idx - row * 12;
      const u16* src = (ch < 8) ? KN + (size_t)(key0 + row) * 512 + h * 64 + ch * 8 : KR + (size_t)(key0 + row) * 32 + (ch - 8) * 8;
      kr[i] = (row < nvalid) ? *(const u32x4*)src : u32x4{0, 0, 0, 0};
    }
#pragma unroll
    for (int i = 0; i < 2; ++i) {
      int idx = tid + 256 * i, dv = idx >> 3, ch = idx & 7;
      vr[i] = (ch * 8 < nvalid) ? *(const u32x4*)(VT + (size_t)dv * skv + key0 + ch * 8) : u32x4{0, 0, 0, 0};
    }
  };
  auto lstore = [&](char* buf) {
#pragma unroll
    for (int i = 0; i < 3; ++i) {
      int idx = tid + 256 * i, row = idx / 12, ch = idx - row * 12;
      *(u32x4*)(buf + row * 208 + ch * 16) = kr[i];
    }
#pragma unroll
    for (int i = 0; i < 2; ++i) {
      int idx = tid + 256 * i, dv = idx >> 3, ch = idx & 7;
      *(u32x4*)(buf + 64 * 208 + dv * LDA + ch * 16) = vr[i];
    }
  };
  constexpr int BUFSZ = 64 * 208 + 64 * LDA;
  f32x4 o[4][2];
  float mrow[2], lsum[2];
#pragma unroll
  for (int nt = 0; nt < 2; ++nt) {
    mrow[nt] = -1e30f; lsum[nt] = 0.f;
#pragma unroll
    for (int dt = 0; dt < 4; ++dt) o[dt][nt] = f32x4{0, 0, 0, 0};
  }
  __syncthreads();
  gload(0);
  lstore(s0);
  if (ntiles > 1) gload(1);
  __syncthreads();
  for (int kt = 0; kt < ntiles; ++kt) {
    char* cur = (kt & 1) ? s1 : s0;
    if (kt + 1 < ntiles) {
      lstore(((kt + 1) & 1) ? s1 : s0);
      if (kt + 2 < ntiles) gload(kt + 2);
    }
    if (kt < vis) {
      int key0, nvalid;
      tile_info(kt, key0, nvalid);
      f32x4 s[4][2];
#pragma unroll
      for (int mt = 0; mt < 4; ++mt)
#pragma unroll
        for (int nt = 0; nt < 2; ++nt) s[mt][nt] = f32x4{0, 0, 0, 0};
#pragma unroll
      for (int ks = 0; ks < 3; ++ks)
#pragma unroll
        for (int mt = 0; mt < 4; ++mt) {
          bf16x8 kf = *(const bf16x8*)(cur + (mt * 16 + c16) * 208 + ks * 64 + g * 16);
#pragma unroll
          for (int nt = 0; nt < 2; ++nt) s[mt][nt] = __builtin_amdgcn_mfma_f32_16x16x32_bf16(kf, qf[nt][ks], s[mt][nt], 0, 0, 0);
        }
      if (nvalid < 64) {
#pragma unroll
        for (int mt = 0; mt < 4; ++mt)
#pragma unroll
          for (int nt = 0; nt < 2; ++nt)
#pragma unroll
            for (int e = 0; e < 4; ++e)
              if (mt * 16 + g * 4 + e >= nvalid) s[mt][nt][e] = -1e30f;
      }
      bf16x8 pf[2][2];
#pragma unroll
      for (int nt = 0; nt < 2; ++nt) {
        float mx = -1e30f;
#pragma unroll
        for (int mt = 0; mt < 4; ++mt)
#pragma unroll
          for (int e = 0; e < 4; ++e) mx = fmaxf(mx, s[mt][nt][e]);
        mx = xmax16(mx);
        mx = xmax32(mx);
        const float mnew = fmaxf(mrow[nt], mx);
        const float alpha = __builtin_amdgcn_exp2f(mrow[nt] - mnew);
        mrow[nt] = mnew;
        float ps = 0.f;
#pragma unroll
        for (int mt = 0; mt < 4; ++mt)
#pragma unroll
          for (int e = 0; e < 4; ++e) {
            float pv = __builtin_amdgcn_exp2f(s[mt][nt][e] - mnew);
            s[mt][nt][e] = pv;
            ps += pv;
          }
        lsum[nt] = lsum[nt] * alpha + ps;
        if (__builtin_amdgcn_ballot_w64(alpha != 1.f) != 0ull) {
#pragma unroll
          for (int dt = 0; dt < 4; ++dt) o[dt][nt] *= alpha;
        }
#pragma unroll
        for (int kk = 0; kk < 2; ++kk) {
          u32x2 lo = pack4(s[2 * kk][nt]), hi = pack4(s[2 * kk + 1][nt]);
          u32x4 pk = u32x4{lo.x, lo.y, hi.x, hi.y};
          pf[nt][kk] = __builtin_bit_cast(bf16x8, pk);
        }
      }
      const char* sV = cur + 64 * 208;
#pragma unroll
      for (int dt = 0; dt < 4; ++dt)
#pragma unroll
        for (int kk = 0; kk < 2; ++kk) {
          u32x2 lo = *(const u32x2*)(sV + (dt * 16 + c16) * LDA + (kk * 32 + g * 4) * 2);
          u32x2 hi = *(const u32x2*)(sV + (dt * 16 + c16) * LDA + (kk * 32 + 16 + g * 4) * 2);
          u32x4 pk = u32x4{lo.x, lo.y, hi.x, hi.y};
          bf16x8 vf = __builtin_bit_cast(bf16x8, pk);
#pragma unroll
          for (int nt = 0; nt < 2; ++nt) o[dt][nt] = __builtin_amdgcn_mfma_f32_16x16x32_bf16(vf, pf[nt][kk], o[dt][nt], 0, 0, 0);
        }
    }
    __syncthreads();
  }
  const u16* z = (const u16*)(p.ws + WS_Z);
  u16* YB = (u16*)(p.ws + WS_YB);
#pragma unroll
  for (int nt = 0; nt < 2; ++nt) {
    float lt = lsum[nt];
    lt = xsum16(lt);
    lt = xsum32(lt);
    const int ql = w * 32 + nt * 16 + c16;
    if (ql < nq && vis > 0) {
      const float il = 1.f / lt;
      const int tok = qtok0 + ql;
#pragma unroll
      for (int dt = 0; dt < 4; ++dt) {
        const int dv = dt * 16 + g * 4;
        f32x4 gt = unpack4(*(const u32x2*)(z + (size_t)tok * ZC + C_GB + h * 64 + dv));
        f32x4 ov = o[dt][nt] * il;
#pragma unroll
        for (int e = 0; e < 4; ++e) ov[e] *= siluf_(gt[e]);
        *(u32x2*)(YB + (size_t)tok * 512 + h * 64 + dv) = pack4(ov);
      }
    }
  }
}

DI void phase3(const int wv, const Params& p0, int l, char* s0, char* s1, char* s2, int coff, int mode = 0) {
  const Params p = load_params(p0);
  const int tid_ = opaque_tid(wv);
  unsigned* ctr = (unsigned*)(p.ws + WS_CTR) + l + coff;
  unsigned* done = (unsigned*)(p.ws + WS_CTR) + 8 + l + coff;
  unsigned* scanq = (unsigned*)(p.ws + WS_CTR) + 16 + l + coff;
  int* sjob = (int*)(s2 + 24576 - 16);
  __syncthreads();
  if (tid_ == 0) {
    const unsigned hw = (unsigned)__builtin_amdgcn_s_getreg((31 << 11) | 4);
    const unsigned key = ((xb_xcc_id_early() & 15u) << 8) | ((hw >> 8) & 0xffu);
    unsigned* cue = (unsigned*)(p.ws + WS_CUE) + (size_t)(l + coff) * 4096 + key;
    int j = -1;
    if (add_agent(cue, 1u) == 0u) { const unsigned q = add_agent(scanq, 1u); if (q < 256u) j = (int)q; }
    *sjob = j;
  }
  __syncthreads();
  {
    const int j = *sjob;
    if (j >= 0 && mode != 2) scan_job(opaque_tid(wv), p, l, j, s0, s1, s2);
  }
  constexpr int NQJ = 261 * 2;
  constexpr int J_Q = 773, J_AT = J_Q + NQJ, J_LS = J_AT + 2368, J_SS = J_LS + 256, NJ = J_SS + 1024;
  bool ready = false;
  int nextjob = 0;
  if (tid_ == 0) nextjob = (int)atomicAdd(ctr, 1u);
  while (true) {
    __syncthreads();
    if (tid_ == 0) *sjob = nextjob;
    __syncthreads();
    const int job = *sjob;
    if (job >= NJ) break;
    if (tid_ == 0) nextjob = (int)atomicAdd(ctr, 1u);
    const int tj = opaque_tid(wv);
    if (job < J_AT) {
      if (job < J_Q) {
#pragma unroll 1
        for (int h = 0; h < 8; ++h) kv_tile(opaque_tid(wv), p, l, job, h, s0, s1, s2);
      } else {
        const int jq = job - J_Q;
#pragma unroll 1
        for (int h = 0; h < 4; ++h) q_tile(opaque_tid(wv), p, l, jq >> 1, (jq & 1) * 4 + h, s0, s1, s2);
      }
      asm volatile("s_waitcnt vmcnt(0)" ::: "memory");
      __syncthreads();
      if (tj == 0) {
        __builtin_amdgcn_fence(__ATOMIC_RELEASE, "agent");
        asm volatile("s_waitcnt vmcnt(0)" ::: "memory");
        add_agent(done, 1u);
      }
    } else if (job < J_LS) {
      if (!ready) {
        if (tj == 0) { while (ld_agent(done) < (unsigned)(773 + NQJ)) __builtin_amdgcn_s_sleep(4); }
        __syncthreads();
        __builtin_amdgcn_fence(__ATOMIC_ACQUIRE, "agent");
        asm volatile("s_waitcnt vmcnt(0)" ::: "memory");
        ready = true;
      }
      if (mode != 1) attn_item(tj, p, l, job - J_AT, s0, s1, s2);
    } else if (job < J_SS) {
      __syncthreads();
      if (tj == 0) { const unsigned q = add_agent(scanq, 1u); *sjob = (q < 256u) ? (int)q : -1; }
      __syncthreads();
      const int j = *sjob;
      if (j >= 0 && mode != 2) scan_job(opaque_tid(wv), p, l, j, s0, s1, s2);
    } else { if (mode != 2) scan_job(tj, p, l, 256 + (job - J_SS), s0, s1, s2); }
  }
}

DI void phase3b(const int wv, const Params& p0, int l) {
  const Params p = load_params(p0);
  const int tid_ = opaque_tid(wv);
  const int tid = tid_, lane = tid & 63, wave = tid >> 6;
  const float* Y = p.out + O_YP;
  const u16* R = (const u16*)(p.ws + WS_R);
  const u16* KM = (const u16*)(p.ws + WS_KM);
  const u16* V = (const u16*)(p.ws + WS_V);
  u16* YA = (u16*)(p.ws + WS_YA);
  for (int job = opaque_bid(); job < 1044; job += gridDim.x) {
    for (int q = 0; q < 8; ++q) {
      const int t = job * 32 + wave * 8 + q;
      const int c = lane * 8;
      const size_t o = (size_t)t * 512 + c;
      f32x4 y0 = ld4(Y + o), y1 = ld4(Y + o + 4);
      float s = y0[0] + y0[1] + y0[2] + y0[3] + y1[0] + y1[1] + y1[2] + y1[3];
      s = xor_sum(s, 1); s = xor_sum(s, 2); s = xor_sum(s, 4);
      const float mu = s * (1.f / 64.f);
      f32x4 d0 = y0 - mu, d1 = y1 - mu;
      float vs = d0[0] * d0[0] + d0[1] * d0[1] + d0[2] * d0[2] + d0[3] * d0[3] + d1[0] * d1[0] + d1[1] * d1[1] + d1[2] * d1[2] + d1[3] * d1[3];
      vs = xor_sum(vs, 1); vs = xor_sum(vs, 2); vs = xor_sum(vs, 4);
      const float rstd = rsqrtf(vs * (1.f / 64.f) + 64e-5f);
      u32x4 rw = *(const u32x4*)(R + o), kw = *(const u32x4*)(KM + o), vw = *(const u32x4*)(V + o);
      f32x4 r0 = unpack4(u32x2{rw.x, rw.y}), r1 = unpack4(u32x2{rw.z, rw.w});
      f32x4 k0 = unpack4(u32x2{kw.x, kw.y}), k1 = unpack4(u32x2{kw.z, kw.w});
      f32x4 v0 = unpack4(u32x2{vw.x, vw.y}), v1 = unpack4(u32x2{vw.z, vw.w});
      f32x4 rk0 = ld4(p.in[I_RK] + l * 512 + c), rk1 = ld4(p.in[I_RK] + l * 512 + c + 4);
      f32x4 b0 = r0 * k0 * rk0, b1 = r1 * k1 * rk1;
      float bs = b0[0] + b0[1] + b0[2] + b0[3] + b1[0] + b1[1] + b1[2] + b1[3];
      bs = xor_sum(bs, 1); bs = xor_sum(bs, 2); bs = xor_sum(bs, 4);
      f32x4 lw0 = ld4(p.in[I_LNW] + l * 512 + c), lw1 = ld4(p.in[I_LNW] + l * 512 + c + 4);
      f32x4 lb0 = ld4(p.in[I_LNB] + l * 512 + c), lb1 = ld4(p.in[I_LNB] + l * 512 + c + 4);
      f32x4 g0 = shifted4(p, l, t, C_G + c), g1 = shifted4(p, l, t, C_G + c + 4);
      f32x4 o0 = d0 * rstd * lw0 + lb0 + v0 * bs;
      f32x4 o1 = d1 * rstd * lw1 + lb1 + v1 * bs;
#pragma unroll
      for (int e = 0; e < 4; ++e) { o0[e] *= siluf_(g0[e]); o1[e] *= siluf_(g1[e]); }
      u32x2 pa = pack4(o0), pb = pack4(o1);
      *(u32x4*)(YA + o) = u32x4{pa.x, pa.y, pb.x, pb.y};
    }
  }
}

DI void phase4(const XcdMap xm, const int wv, const Params& p0, int l, char* s0, char* s1, char* s2) {
  const Params p = load_params(p0);
  const int tid_ = opaque_tid(wv);
  const u16* z = (const u16*)(p.ws + WS_Z);
  u16* U = (u16*)(p.ws + WS_U);
  int m_start, m_cnt;
  const int total = xcd_total(xm, 174, 8, m_start, m_cnt);
#pragma unroll 1
  for (int t = xm.rank; t < total; t += xm.nlb) {
    int mtile, ntile;
    xcd_tile(t, m_start, m_cnt, 8, mtile, ntile);
    const int tl = opaque_tid(wv);
    const int lane = tl & 63, wave = tl >> 6, g = lane >> 4, c16 = lane & 15;
    const int m0 = mtile * 192, n0 = ntile * 128;
    f32x4 acc[6][4];
    {
      gemm_ring<192, 128, 2, 2, 4, true>(tl, (const u16*)(p.ws + WS_YA) + (size_t)m0 * 512, 512,
                                 (const u16*)(p.ws + WS_WA) + ((size_t)l * 1024 + n0) * 512, 512, 127, 16, s0, s1, s2, acc);
    }
    const int wr = wave >> 1, wc = wave & 1;
#pragma unroll
    for (int mt = 0; mt < 6; ++mt) {
      const int m = m0 + wr * 96 + mt * 16 + c16;
#pragma unroll
      for (int nt = 0; nt < 4; nt += 2) {
        const int n = n0 + wc * 64 + g * 16 + nt * 4;
        u32x4 gw = *(const u32x4*)(z + (size_t)m * ZC + C_GA1 + n);
        f32x4 ga0 = unpack4(u32x2{gw.x, gw.y}), ga1 = unpack4(u32x2{gw.z, gw.w});
        f32x4 r0 = acc[mt][nt], r1 = acc[mt][nt + 1];
#pragma unroll
        for (int e = 0; e < 4; ++e) { r0[e] *= sigmoidf_(ga0[e]); r1[e] *= sigmoidf_(ga1[e]); }
        u32x2 a = pack4(r0), b = pack4(r1);
        *(u32x4*)(U + (size_t)m * 1024 + n) = u32x4{a.x, a.y, b.x, b.y};
        __builtin_amdgcn_sched_barrier(0);
      }
    }
    {
      gemm_ring<192, 128, 2, 2, 4, true>(tl, (const u16*)(p.ws + WS_YB) + (size_t)m0 * 512, 512,
                                 (const u16*)(p.ws + WS_WB) + ((size_t)l * 1024 + n0) * 512, 512, 127, 16, s0, s1, s2, acc);
    }
#pragma unroll
    for (int mt = 0; mt < 6; ++mt) {
      const int m = m0 + wr * 96 + mt * 16 + c16;
#pragma unroll
      for (int nt = 0; nt < 4; nt += 2) {
        const int n = n0 + wc * 64 + g * 16 + nt * 4;
        u32x4 gw = *(const u32x4*)(z + (size_t)m * ZC + C_GB1 + n);
        u32x4 uw = *(const u32x4*)(U + (size_t)m * 1024 + n);
        f32x4 gb0 = unpack4(u32x2{gw.x, gw.y}), gb1 = unpack4(u32x2{gw.z, gw.w});
        f32x4 r0 = unpack4(u32x2{uw.x, uw.y}), r1 = unpack4(u32x2{uw.z, uw.w});
#pragma unroll
        for (int e = 0; e < 4; ++e) { r0[e] += acc[mt][nt][e] * sigmoidf_(gb0[e]); r1[e] += acc[mt][nt + 1][e] * sigmoidf_(gb1[e]); }
        u32x2 a = pack4(r0), b = pack4(r1);
        *(u32x4*)(U + (size_t)m * 1024 + n) = u32x4{a.x, a.y, b.x, b.y};
        __builtin_amdgcn_sched_barrier(0);
      }
    }
  }
}

DI void phase5(const XcdMap xm, const int wv, const Params& p0, int l, char* s0, char* s1, char* s2) {
  const Params p = load_params(p0);
  const int tid_ = opaque_tid(wv);
  u16* xb = (u16*)(p.ws + WS_XB);
  int m_start, m_cnt;
  const int total = xcd_total(xm, 174, 8, m_start, m_cnt);
#pragma unroll 1
  for (int t = xm.rank; t < total; t += xm.nlb) {
    int mtile, ntile;
    xcd_tile(t, m_start, m_cnt, 8, mtile, ntile);
    const int tl = opaque_tid(wv);
    const int lane = tl & 63, wave = tl >> 6, g = lane >> 4, c16 = lane & 15;
    const int m0 = mtile * 192, n0 = ntile * 128;
    f32x4 acc[6][4];
    {
      gemm_ring<192, 128, 2, 2, 4, true>(tl, (const u16*)(p.ws + WS_U) + (size_t)m0 * 1024, 1024,
                                 (const u16*)(p.ws + WS_WOUT) + ((size_t)l * 1024 + n0) * 1024, 1024, 127, 32, s0, s1, s2, acc);
    }
    const int wr = wave >> 1, wc = wave & 1;
#pragma unroll
    for (int mt = 0; mt < 6; ++mt) {
      const int m = m0 + wr * 96 + mt * 16 + c16;
      float* xd = x_dst(p, m);
      float psum = 0.f;
#pragma unroll
      for (int nt = 0; nt < 4; nt += 2) {
        const int n = n0 + wc * 64 + g * 16 + nt * 4;
        u32x4 xw = *(const u32x4*)(xb + (size_t)m * 1024 + n);
        f32x4 x0 = unpack4(u32x2{xw.x, xw.y}) + acc[mt][nt], x1 = unpack4(u32x2{xw.z, xw.w}) + acc[mt][nt + 1];
        psum += sum4sq(x0) + sum4sq(x1);
        if (l == 3) { *(f32x4*)(xd + n) = x0; *(f32x4*)(xd + n + 4) = x1; }
        else { u32x2 a = pack4(x0), b = pack4(x1); *(u32x4*)(xb + (size_t)m * 1024 + n) = u32x4{a.x, a.y, b.x, b.y}; }
      }
      psum = xor_sum(psum, 16);
      psum = xor_sum(psum, 32);
      if (g == 0) ((float*)(p.ws + WS_SSX))[(size_t)m * 16 + ntile * 2 + wc] = psum;
    }
  }
}

#define XB_TMO      128
#define XB_XCNT(j)  (256  + 64 * (j))
#define XB_XSUB(j)  (1280 + 64 * (j))
#define XB_XGEN(j)  (2304 + 64 * (j))
#define XB_TOP      3328
#define XB_TOPGEN   3392
#define XCD_BAR_WORDS 3456
#define XB_SPIN_CAP (1u << 22)
DI unsigned xb_ld(unsigned* p) { return __hip_atomic_load(p, __ATOMIC_RELAXED, __HIP_MEMORY_SCOPE_AGENT); }
DI unsigned xb_add(unsigned* p, unsigned v) { return __hip_atomic_fetch_add(p, v, __ATOMIC_RELAXED, __HIP_MEMORY_SCOPE_AGENT); }
DI unsigned xb_xcc_id() { return (unsigned)__builtin_amdgcn_s_getreg((3 << 11) | 20) & 0xFu; }
#define XB_SPIN(cond, bar) do { unsigned _sp = 0; while (cond) { __builtin_amdgcn_s_sleep(1); \
    if ((++_sp & 255u) == 0u) { if (xb_ld(&(bar)[XB_TMO])) break; if (_sp > XB_SPIN_CAP) { atomicAdd(&(bar)[XB_TMO], 1u); break; } } } } while (0)
struct XcdBarrier { unsigned* bar; unsigned x; volatile LAS unsigned* st; };
DI void xcd_barrier_complete(unsigned* bar, unsigned x, unsigned& nloc, unsigned& nx) {
  const unsigned G = gridDim.x;
  unsigned sum, cnt, mine, sp = 0u;
  for (;;) {
    sum = 0u; cnt = 0u; mine = 0u;
#pragma unroll
    for (unsigned j = 0; j < 16; ++j) { const unsigned c = xb_ld(&bar[XB_XCNT(j)]); sum += c; cnt += (c > 0u) ? 1u : 0u; mine = (j == x) ? c : mine; }
    if (sum == G) break;
    __builtin_amdgcn_s_sleep(1);
    if ((++sp & 255u) == 0u) { if (xb_ld(&bar[XB_TMO])) break; if (sp > XB_SPIN_CAP) { atomicAdd(&bar[XB_TMO], 1u); break; } }
  }
  nloc = mine > 0u ? mine : 1u; nx = cnt > 0u ? cnt : 1u;
}
DI void xcd_barrier(const XcdBarrier& b, const int tid) {
  asm volatile("s_waitcnt vmcnt(0)" ::: "memory");
  __syncthreads();
  if (tid == 0) {
    unsigned* bar = b.bar;
    __builtin_amdgcn_s_waitcnt(0);
    unsigned nloc = b.st[0], nx = b.st[1];
    if (nloc == 0u) { xcd_barrier_complete(bar, b.x, nloc, nx); b.st[0] = nloc; b.st[1] = nx; }
    const unsigned old = xb_add(&bar[XB_XSUB(b.x)], 1u);
    const unsigned gen = old / nloc;
    if (old + 1u == (gen + 1u) * nloc) {
      __builtin_amdgcn_fence(__ATOMIC_RELEASE, "agent");
      asm volatile("s_waitcnt vmcnt(0)" ::: "memory");
      const unsigned og = xb_add(&bar[XB_TOP], 1u);
      const unsigned tg = og / nx;
      if (og + 1u == (tg + 1u) * nx) xb_add(&bar[XB_TOPGEN], 1u);
      else XB_SPIN(xb_ld(&bar[XB_TOPGEN]) == tg, bar);
      __builtin_amdgcn_fence(__ATOMIC_ACQUIRE, "agent");
      xb_add(&bar[XB_XGEN(b.x)], 1u);
      asm volatile("s_waitcnt vmcnt(0)" ::: "memory");
    } else {
      XB_SPIN(xb_ld(&bar[XB_XGEN(b.x)]) == gen, bar);
      __builtin_amdgcn_fence(__ATOMIC_ACQUIRE, "agent");
      asm volatile("s_waitcnt vmcnt(0)" ::: "memory");
    }
  }
  __syncthreads();
}

__global__ void __launch_bounds__(256, 2) mega_kernel(Params p) {
  __shared__ __attribute__((aligned(1024))) char lds0[24576];
  __shared__ __attribute__((aligned(1024))) char lds1[24576];
  __shared__ __attribute__((aligned(1024))) char lds2[24576];
  __shared__ __attribute__((aligned(16))) unsigned xbw[4];
  cg::grid_group grid = cg::this_grid();
  const int wv = __builtin_amdgcn_readfirstlane((int)(threadIdx.x >> 6));
  XcdBarrier xb;
  {
    const int t0 = opaque_tid(wv);
    if (t0 == 0) { xbw[0] = 0u; xbw[1] = 0u; xbw[2] = 0u; xbw[3] = 0u; }
    __syncthreads();
    xb.bar = (unsigned*)(p.ws + WS_BAR); xb.x = xb_xcc_id(); xb.st = (volatile LAS unsigned*)xbw;
    if (t0 == 0) xbw[2] = xb_add(&xb.bar[XB_XCNT(xb.x)], 1u);
    __syncthreads();
  }
  XcdMap xm;
  xm.rank = __builtin_amdgcn_readfirstlane((int)xbw[2]);
  xm.xcc = 0; xm.nlb = 1; xm.nx = 1;
  for (int ph = 0; ph < NPH; ++ph) {
    if (ph == 1) {
      if (p.ph_hi < 0) grid.sync();
      xcd_barrier(xb, opaque_tid(wv));
      const int t0 = opaque_tid(wv);
      if (t0 == 0) {
        unsigned mine = 0u, cnt = 0u, idx = 0u;
#pragma unroll
        for (unsigned j = 0; j < 16; ++j) {
          const unsigned c = xb_ld(&xb.bar[XB_XCNT(j)]);
          cnt += (c > 0u) ? 1u : 0u;
          idx += (c > 0u && j < xb.x) ? 1u : 0u;
          mine = (j == xb.x) ? c : mine;
        }
        xbw[0] = mine; xbw[1] = cnt; xbw[3] = idx;
      }
      __syncthreads();
      xm.nlb = __builtin_amdgcn_readfirstlane((int)xbw[0]);
      xm.nx = __builtin_amdgcn_readfirstlane((int)xbw[1]);
      xm.xcc = __builtin_amdgcn_readfirstlane((int)xbw[3]);
    } else if (ph > 1) xcd_barrier(xb, opaque_tid(wv));
    if (ph == 0) phase0(wv, p, lds0, lds1, lds2);
    else {
      const int l = (ph - 1) / 6, s = (ph - 1) - l * 6;
      if (s == 0) phase1(xm, wv, p, l, lds0, lds1, lds2);
      else if (s == 1) phase2(xm, wv, p, l, lds0, lds1, lds2);
      else if (s == 2) phase3(wv, p, l, lds0, lds1, lds2, 0);
      else if (s == 3) phase3b(wv, p, l);
      else if (s == 4) phase4(xm, wv, p, l, lds0, lds1, lds2);
      else phase5(xm, wv, p, l, lds0, lds1, lds2);
#if PROBE_PHASE >= 0
      if (s == PROBE_PHASE) {
        xcd_barrier(xb, opaque_tid(wv));
        if (s == 0) phase1(xm, wv, p, l, lds0, lds1, lds2);
        else if (s == 1) phase2(xm, wv, p, l, lds0, lds1, lds2, PROBE_MODE);
        else if (s == 2) phase3(wv, p, l, lds0, lds1, lds2, 4, PROBE_MODE);
        else if (s == 3) phase3b(wv, p, l);
        else if (s == 4) phase4(xm, wv, p, l, lds0, lds1, lds2);
      }
#endif
    }
  }
}

extern "C" void kernel_launch(void* const* d_in, const int* in_sizes, int n_in, void* d_out, int out_size, void* d_ws, size_t ws_size,
                              hipStream_t stream) {
  static int grid_blocks = 0;
  if (!grid_blocks) {
    int dev = 0, cus = 0, per_cu = 0;
    hipGetDevice(&dev);
    hipDeviceGetAttribute(&cus, hipDeviceAttributeMultiprocessorCount, dev);
    hipOccupancyMaxActiveBlocksPerMultiprocessor(&per_cu, mega_kernel, 256, 0);
    if (per_cu > 2) per_cu = 2;
    if (per_cu < 1) per_cu = 1;
    grid_blocks = cus * per_cu;
  }
  if (ws_size < WS_END) { fprintf(stderr, "workspace too small: %zu < %zu\n", ws_size, (size_t)WS_END); return; }
  Params p{};
  for (int i = 0; i < 30; ++i) p.in[i] = (const float*)d_in[i];
  p.out = (float*)d_out;
  p.ws = (char*)d_ws;
  hipMemsetAsync((char*)d_ws + WS_BAR, 0, 16384, stream);
  hipMemsetAsync((char*)d_ws + WS_CUE, 0, (size_t)8 * 4096 * 4, stream);
  p.ph_lo = 0; p.ph_hi = NPH;
  void* args[] = {&p};
  hipError_t e = hipLaunchCooperativeKernel((void*)mega_kernel, dim3(grid_blocks), dim3(256), args, 0, stream);
  if (e != hipSuccess) fprintf(stderr, "cooperative launch failed: %s (grid %d)\n", hipGetErrorString(e), grid_blocks);
}
```

```cpp
#include <hip/hip_runtime.h>
#include <hip/hip_cooperative_groups.h>
#include <stdint.h>
#include <cstdio>
namespace cg = cooperative_groups;

#ifndef PROBE_MODE
#define PROBE_MODE 0
#endif
#ifndef PROBE_PHASE
#define PROBE_PHASE -1
#endif
#ifndef MULTI_LAUNCH
#define MULTI_LAUNCH 0
#endif

typedef unsigned short u16;
typedef __attribute__((ext_vector_type(4))) unsigned u32x4;
typedef __attribute__((ext_vector_type(2))) unsigned u32x2;
typedef __attribute__((ext_vector_type(8))) short bf16x8;
typedef __attribute__((ext_vector_type(4))) float f32x4;
typedef __attribute__((ext_vector_type(2))) float f32x2;
typedef __attribute__((ext_vector_type(2))) __bf16 bf16x2v;
#define DI __device__ __forceinline__
#define LAS __attribute__((address_space(3)))

constexpr int LP = 4112, TP = 8 * LP, TS = 512, T = TP + TS;
constexpr int SK = 2064;
constexpr int ZC = 5408;
constexpr int C_R = 0, C_K = 512, C_V = 1024, C_G = 1536, C_WL = 2048, C_QC = 2176, C_CKV = 2560, C_KR = 2816,
              C_GB = 2848, C_GA1 = 3360, C_GB1 = 4384;
constexpr int NPH = 25;

enum { I_XP = 0, I_XS, I_SRWKV, I_SSHIFT, I_CLAT, I_CKR, I_META, I_NORMW, I_WIN, I_MIX, I_W0, I_W2, I_A0, I_A2, I_KK, I_KA,
       I_RK, I_LNW, I_LNB, I_QNORM, I_WUQ, I_KVNORM, I_WUKV, I_QNN, I_KNN, I_QNR, I_KNR, I_WA, I_WB, I_WOUT };

constexpr size_t O_YP = 0;
constexpr size_t O_YS = O_YP + (size_t)8 * 4096 * 1024;
constexpr size_t O_SRP = O_YS + (size_t)512 * 1024;
constexpr size_t O_SHP = O_SRP + (size_t)4 * 8 * 8 * 64 * 64;
constexpr size_t O_LATP = O_SHP + (size_t)4 * 8 * 2176;
constexpr size_t O_KRP = O_LATP + (size_t)4 * 8 * LP * 256;
constexpr size_t O_SRS = O_KRP + (size_t)4 * 8 * LP * 32;
constexpr size_t O_SHS = O_SRS + (size_t)4 * 32 * 8 * 64 * 64;
constexpr size_t O_LATN = O_SHS + (size_t)4 * 32 * 2176;
constexpr size_t O_KRN = O_LATN + (size_t)4 * 32 * 16 * 256;

constexpr size_t al256(size_t x) { return (x + 255) & ~(size_t)255; }
constexpr size_t WS_WIN = 0;
constexpr size_t WS_W2 = al256(WS_WIN + (size_t)4 * 5504 * 1024 * 2);
constexpr size_t WS_A2 = al256(WS_W2 + (size_t)4 * 512 * 64 * 2);
constexpr size_t WS_WUQ = al256(WS_A2 + (size_t)4 * 512 * 64 * 2);
constexpr size_t WS_WKVF = al256(WS_WUQ + (size_t)4 * 768 * 384 * 2);
constexpr size_t WS_WKVP = al256(WS_WKVF + (size_t)4 * 1024 * 256 * 2);
constexpr size_t WS_WA = al256(WS_WKVP + (size_t)4 * 1024 * 256 * 2);
constexpr size_t WS_WB = al256(WS_WA + (size_t)4 * 1024 * 512 * 2);
constexpr size_t WS_WOUT = al256(WS_WB + (size_t)4 * 1024 * 512 * 2);
constexpr size_t WS_XMETA = al256(WS_WOUT + (size_t)4 * 1024 * 1024 * 2);
constexpr size_t WS_CTR = al256(WS_XMETA + (size_t)128 * 1024 * 4);
constexpr size_t WS_Z = al256(WS_CTR + 1024);
constexpr size_t WS_DEC = al256(WS_Z + (size_t)T * ZC * 2);
constexpr size_t WS_R = al256(WS_DEC + (size_t)T * 512 * 4);
constexpr size_t WS_KM = al256(WS_R + (size_t)T * 512 * 2);
constexpr size_t WS_V = al256(WS_KM + (size_t)T * 512 * 2);
constexpr size_t WS_NKK = al256(WS_V + (size_t)T * 512 * 2);
constexpr size_t WS_KKA = al256(WS_NKK + (size_t)T * 512 * 2);
constexpr size_t WS_Y = al256(WS_KKA + (size_t)T * 512 * 2);
constexpr size_t WS_Q = al256(WS_Y + (size_t)T * 512 * 4);
constexpr size_t WS_KP = al256(WS_Q + (size_t)T * 768 * 2);
constexpr size_t WS_VTP = al256(WS_KP + (size_t)TP * 512 * 2);
constexpr size_t WS_KRP = al256(WS_VTP + (size_t)TP * 512 * 2);
constexpr size_t WS_KS = al256(WS_KRP + (size_t)TP * 32 * 2);
constexpr size_t WS_VTS = al256(WS_KS + (size_t)32 * SK * 512 * 2);
constexpr size_t WS_KRS = al256(WS_VTS + (size_t)32 * SK * 512 * 2 + 4096);
constexpr size_t WS_YB = al256(WS_KRS + (size_t)32 * SK * 32 * 2);
constexpr size_t WS_LATB = al256(WS_YB + (size_t)T * 512 * 2);
constexpr size_t WS_BAR = al256(WS_LATB + (size_t)65536 * 256 * 2);
constexpr size_t WS_TAB = al256(WS_BAR + 16384);
constexpr size_t WS_SSX = al256(WS_TAB + 512);
constexpr size_t WS_SSQ = al256(WS_SSX + (size_t)T * 16 * 4);
constexpr size_t WS_SSKV = al256(WS_SSQ + (size_t)T * 8 * 4);
constexpr size_t WS_CUE = al256(WS_SSKV + (size_t)T * 4 * 4);
constexpr size_t WS_END = al256(WS_CUE + (size_t)8 * 4096 * 4);
constexpr size_t WS_U = WS_DEC;
constexpr size_t WS_YA = WS_Q;
constexpr size_t WS_XB = WS_Y;

struct Params {
  const float* in[30];
  float* out;
  char* ws;
  int ph_lo, ph_hi;
};

DI uint32_t pack2(float a, float b) {
  f32x2 v = {a, b};
  bf16x2v r = __builtin_convertvector(v, bf16x2v);
  return __builtin_bit_cast(uint32_t, r);
}
DI float bflo(uint32_t w) { return __uint_as_float(w << 16); }
DI float bfhi(uint32_t w) { return __uint_as_float(w & 0xffff0000u); }
DI float bf2f(u16 h) { return __uint_as_float(((uint32_t)h) << 16); }
DI f32x4 unpack4(u32x2 w) { return f32x4{bflo(w.x), bfhi(w.x), bflo(w.y), bfhi(w.y)}; }
DI u32x2 pack4(f32x4 v) { return u32x2{pack2(v[0], v[1]), pack2(v[2], v[3])}; }
DI int opaque_tid(const int wv) {
  int lane;
  asm volatile("v_mbcnt_lo_u32_b32 %0, -1, 0\n\tv_mbcnt_hi_u32_b32 %0, -1, %0" : "=v"(lane));
  return (wv << 6) | lane;
}
DI int opaque_bid() { int b = blockIdx.x; asm volatile("" : "+s"(b)); return b; }
DI unsigned xb_xcc_id_early() { return (unsigned)__builtin_amdgcn_s_getreg((3 << 11) | 20) & 0xFu; }
DI unsigned ld_agent(unsigned* p) { return __hip_atomic_load(p, __ATOMIC_RELAXED, __HIP_MEMORY_SCOPE_AGENT); }
DI unsigned add_agent(unsigned* p, unsigned v) { return __hip_atomic_fetch_add(p, v, __ATOMIC_RELAXED, __HIP_MEMORY_SCOPE_AGENT); }
DI float sigmoidf_(float x) { return __builtin_amdgcn_rcpf(1.f + __expf(-x)); }
DI float siluf_(float x) { return x * __builtin_amdgcn_rcpf(1.f + __expf(-x)); }
DI float tanhf_(float x) { return 1.f - 2.f * __builtin_amdgcn_rcpf(__expf(2.f * x) + 1.f); }
DI float xsum16(float x) { u32x2 r = __builtin_amdgcn_permlane16_swap(__float_as_uint(x), __float_as_uint(x), false, false); return __uint_as_float(r.x) + __uint_as_float(r.y); }
DI float xsum32(float x) { u32x2 r = __builtin_amdgcn_permlane32_swap(__float_as_uint(x), __float_as_uint(x), false, false); return __uint_as_float(r.x) + __uint_as_float(r.y); }
DI float xmax16(float x) { u32x2 r = __builtin_amdgcn_permlane16_swap(__float_as_uint(x), __float_as_uint(x), false, false); return fmaxf(__uint_as_float(r.x), __uint_as_float(r.y)); }
DI float xmax32(float x) { u32x2 r = __builtin_amdgcn_permlane32_swap(__float_as_uint(x), __float_as_uint(x), false, false); return fmaxf(__uint_as_float(r.x), __uint_as_float(r.y)); }
DI float xor_sum(float v, int m) {
  if (m == 1) return v + __int_as_float(__builtin_amdgcn_update_dpp(0, __float_as_int(v), 0xB1, 0xf, 0xf, false));
  if (m == 2) return v + __int_as_float(__builtin_amdgcn_update_dpp(0, __float_as_int(v), 0x4E, 0xf, 0xf, false));
  if (m == 4) return v + __int_as_float(__builtin_amdgcn_update_dpp(0, __float_as_int(v), 0x141, 0xf, 0xf, false));
  if (m == 8) return v + __int_as_float(__builtin_amdgcn_update_dpp(0, __float_as_int(v), 0x140, 0xf, 0xf, false));
  if (m == 16) return xsum16(v);
  if (m == 32) return xsum32(v);
  return v + __shfl_xor(v, m);
}
DI f32x4 ld4(const float* p) { return *(const f32x4*)p; }

DI void rope_cs(int pos, int j, float& c, float& s) {
  float inv = exp2f(-(float)j * 0.8304820237218405f);
  float ang = (float)pos * inv;
  double a = (double)ang;
  double k = rint(a * 0.15915494309189535);
  float r = (float)(a - k * 6.283185307179586);
  c = __cosf(r);
  s = __sinf(r);
}
DI int tok_pos(int t) { return (t < TP) ? (t % LP) - 16 : 2048 + ((t - TP) & 15); }

DI const float* x_src(const Params& p, int l, int t) {
  if (t < TP) {
    int b = t / LP, i = t - b * LP;
    if (i < 16) return (l == 0) ? p.in[I_META] + (size_t)i * 1024 : (const float*)(p.ws + WS_XMETA) + (size_t)(b * 16 + i) * 1024;
    return ((l == 0) ? p.in[I_XP] : (const float*)(p.out + O_YP)) + ((size_t)b * 4096 + (i - 16)) * 1024;
  }
  return ((l == 0) ? p.in[I_XS] : (const float*)(p.out + O_YS)) + (size_t)(t - TP) * 1024;
}
DI float* x_dst(const Params& p, int t) {
  if (t < TP) {
    int b = t / LP, i = t - b * LP;
    if (i < 16) return (float*)(p.ws + WS_XMETA) + (size_t)(b * 16 + i) * 1024;
    return p.out + O_YP + ((size_t)b * 4096 + (i - 16)) * 1024;
  }
  return p.out + O_YS + (size_t)(t - TP) * 1024;
}

DI void shifted16(const Params& p, int l, int t, int col, f32x4 (&out)[4]) {
  const u16* z = (const u16*)(p.ws + WS_Z);
  const u16* zc = z + (size_t)t * ZC + col;
  u32x4 c0 = *(const u32x4*)zc, c1 = *(const u32x4*)(zc + 8);
  f32x4 cur[4] = {unpack4(u32x2{c0.x, c0.y}), unpack4(u32x2{c0.z, c0.w}), unpack4(u32x2{c1.x, c1.y}), unpack4(u32x2{c1.z, c1.w})};
  f32x4 prv[4];
  bool first;
  int sb = 0;
  if (t < TP) first = (t % LP) == 0;
  else { int s = t - TP; sb = s >> 4; first = (s & 15) == 0; }
  if (!first) {
    u32x4 q0 = *(const u32x4*)(zc - ZC), q1 = *(const u32x4*)(zc - ZC + 8);
    prv[0] = unpack4(u32x2{q0.x, q0.y}); prv[1] = unpack4(u32x2{q0.z, q0.w});
    prv[2] = unpack4(u32x2{q1.x, q1.y}); prv[3] = unpack4(u32x2{q1.z, q1.w});
  } else if (t < TP) {
#pragma unroll
    for (int j = 0; j < 4; ++j) prv[j] = f32x4{0.f, 0.f, 0.f, 0.f};
  } else {
    const float* ss = p.in[I_SSHIFT] + ((size_t)l * 32 + sb) * 2176 + col;
#pragma unroll
    for (int j = 0; j < 4; ++j) prv[j] = ld4(ss + 4 * j);
  }
  const float* m0 = p.in[I_MIX] + ((size_t)l * 2 + 0) * 2176 + col;
  const float* m1 = p.in[I_MIX] + ((size_t)l * 2 + 1) * 2176 + col;
#pragma unroll
  for (int j = 0; j < 4; ++j) out[j] = cur[j] * ld4(m0 + 4 * j) + prv[j] * ld4(m1 + 4 * j);
}

DI Params load_params(const Params& k) {
  typedef const volatile unsigned long long __attribute__((address_space(4))) * kptr_t;
  kptr_t kp = (kptr_t)__builtin_amdgcn_kernarg_segment_ptr();
  Params q;
#pragma unroll
  for (int i = 0; i < 30; ++i) q.in[i] = (const float*)kp[i];
  q.out = (float*)kp[30];
  q.ws = (char*)kp[31];
  q.ph_lo = 0; q.ph_hi = 0;
  return q;
}

DI f32x4 shifted4(const Params& p, int l, int t, int col) {
  const u16* z = (const u16*)(p.ws + WS_Z);
  f32x4 cur = unpack4(*(const u32x2*)(z + (size_t)t * ZC + col));
  f32x4 prv;
  bool first;
  int sb = 0;
  if (t < TP) first = (t % LP) == 0;
  else { int s = t - TP; sb = s >> 4; first = (s & 15) == 0; }
  if (!first) prv = unpack4(*(const u32x2*)(z + (size_t)(t - 1) * ZC + col));
  else if (t < TP) prv = f32x4{0.f, 0.f, 0.f, 0.f};
  else prv = ld4(p.in[I_SSHIFT] + ((size_t)l * 32 + sb) * 2176 + col);
  f32x4 m0 = ld4(p.in[I_MIX] + ((size_t)l * 2 + 0) * 2176 + col);
  f32x4 m1 = ld4(p.in[I_MIX] + ((size_t)l * 2 + 1) * 2176 + col);
  return cur * m0 + prv * m1;
}

struct XcdMap { int xcc, rank, nlb, nx; };
DI int xcd_total(const XcdMap& xm, int MT, int NT, int& m_start, int& m_cnt) {
  const int base = MT / xm.nx, rem = MT - base * xm.nx;
  m_start = xm.xcc * base + (xm.xcc < rem ? xm.xcc : rem);
  m_cnt = base + (xm.xcc < rem ? 1 : 0);
  return m_cnt * NT;
}
DI void xcd_tile(int t, int m_start, int m_cnt, int NT, int& mtile, int& ntile) {
  const int band = t / (8 * NT);
  const int r = t - band * 8 * NT;
  int bh = m_cnt - band * 8;
  bh = bh < 8 ? bh : 8;
  const int ni = r / bh;
  mtile = m_start + band * 8 + (r - ni * bh);
  ntile = ni;
}

constexpr int LDA = 144;

DI void glds16(const void* g, char* l) {
  __builtin_amdgcn_global_load_lds((const __attribute__((address_space(1))) unsigned*)g, (LAS unsigned*)l, 16, 0, 0);
}
#define WAIT_V(n) asm volatile("s_waitcnt vmcnt(%0)" ::"n"(n) : "memory")
DI void raw_barrier() { asm volatile("s_waitcnt lgkmcnt(0)" ::: "memory"); __builtin_amdgcn_s_barrier(); }
DI int swz4(int q) { return (0x78 >> (2 * q)) & 3; }
template <int OFF> DI bf16x8 ldsr(unsigned a) {
  bf16x8 r;
  asm volatile("ds_read_b128 %0, %1 offset:%2" : "=v"(r) : "v"(a), "n"(OFF));
  return r;
}

template <int BM, int BN, int WR, int WC, int NSWAP, bool PERM = false>
DI void gemm_ring(const int tid_, const u16* __restrict__ Ab, int lda, const u16* __restrict__ Bt, int ldb, int brow_max, int nk,
                  char* s0, char* s1, char* s2, f32x4 (&acc)[BM / WR / 16][BN / WC / 16]) {
  constexpr int MT = BM / WR / 16, NT = BN / WC / 16;
  constexpr int WM = BM / WR, WN = BN / WC;
  constexpr int SA = BM * 64;
  constexpr int LA = BM / 64, LB = BN / 64, LPW = LA + LB;
  static_assert(SA + BN * 64 <= 24576, "stage too large");
  const int tid = tid_, lane = tid & 63, wave = tid >> 6;
  const int wr = wave / WC, wc = wave % WC;
  const int lrow = lane >> 2, lc = (lane & 3) ^ swz4(lane >> 4);
  const u16* ap = Ab + (size_t)(wave * 16 + lrow) * lda + lc * 8;
  const u16* bp[LB];
#pragma unroll
  for (int i = 0; i < LB; ++i) {
    int r = i * 64 + wave * 16 + lrow;
    if (PERM) {
      const int wcg = r / WN, np = r - wcg * WN;
      r = wcg * WN + ((np >> 2) & 3) * (WN / 4) + (np >> 4) * 4 + (np & 3);
    }
    r = r < brow_max ? r : brow_max;
    bp[i] = Bt + (size_t)r * ldb + lc * 8;
  }
#pragma unroll
  for (int mt = 0; mt < MT; ++mt)
#pragma unroll
    for (int nt = 0; nt < NT; ++nt) acc[mt][nt] = f32x4{0.f, 0.f, 0.f, 0.f};
  const int g = lane >> 4;
  const int fo = (lane & 15) * 64 + ((g ^ swz4((lane & 15) >> 2)) * 16);
  auto issue = [&](char* sa, int kt) {
    const int ko = kt * 32;
#pragma unroll
    for (int i = 0; i < LA; ++i) glds16(ap + (size_t)(i * 64) * lda + ko, sa + (i * 4 + wave) * 1024);
#pragma unroll
    for (int i = 0; i < LB; ++i) glds16(bp[i] + ko, sa + SA + (i * 4 + wave) * 1024);
  };
  auto step = [&](int kt, char* cur, char* nxt) {
    if (kt + 1 < nk) WAIT_V(LPW); else WAIT_V(0);
    raw_barrier();
    if (kt + 2 < nk) issue(nxt, kt + 2);
    const unsigned aA = (unsigned)(size_t)cur + (unsigned)((wr * WM) * 64 + fo);
    const unsigned aB = (unsigned)(size_t)cur + (unsigned)(SA + (wc * WN) * 64 + fo);
    bf16x8 xf[MT], wf[NT];
    xf[0] = ldsr<0>(aA);
    if constexpr (MT > 1) xf[1] = ldsr<1024>(aA);
    if constexpr (MT > 2) xf[2] = ldsr<2048>(aA);
    if constexpr (MT > 3) xf[3] = ldsr<3072>(aA);
    if constexpr (MT > 4) xf[4] = ldsr<4096>(aA);
    if constexpr (MT > 5) xf[5] = ldsr<5120>(aA);
    wf[0] = ldsr<0>(aB);
    if constexpr (NT > 1) wf[1] = ldsr<1024>(aB);
    if constexpr (NT > 2) wf[2] = ldsr<2048>(aB);
    if constexpr (NT > 3) wf[3] = ldsr<3072>(aB);
    if constexpr (NT > 4) wf[4] = ldsr<4096>(aB);
    if constexpr (NT > 5) wf[5] = ldsr<5120>(aB);
    if constexpr (NT > 6) wf[6] = ldsr<6144>(aB);
    if constexpr (NT > 7) wf[7] = ldsr<7168>(aB);
    constexpr int NH = NT / 2;
    asm volatile("s_waitcnt lgkmcnt(%0)" ::"n"(NT - NH) : "memory");
#pragma unroll
    for (int mt = 0; mt < MT; ++mt) asm volatile("" : "+v"(xf[mt]));
#pragma unroll
    for (int nt = 0; nt < NH; ++nt) asm volatile("" : "+v"(wf[nt]));
#pragma unroll
    for (int nt = 0; nt < NH; ++nt) {
#pragma unroll
      for (int mt = 0; mt < MT; ++mt) {
        if (nt < NSWAP) acc[mt][nt] = __builtin_amdgcn_mfma_f32_16x16x32_bf16(wf[nt], xf[mt], acc[mt][nt], 0, 0, 0);
        else acc[mt][nt] = __builtin_amdgcn_mfma_f32_16x16x32_bf16(xf[mt], wf[nt], acc[mt][nt], 0, 0, 0);
      }
    }
    asm volatile("s_waitcnt lgkmcnt(0)" ::: "memory");
#pragma unroll
    for (int nt = NH; nt < NT; ++nt) asm volatile("" : "+v"(wf[nt]));
#pragma unroll
    for (int nt = NH; nt < NT; ++nt) {
#pragma unroll
      for (int mt = 0; mt < MT; ++mt) {
        if (nt < NSWAP) acc[mt][nt] = __builtin_amdgcn_mfma_f32_16x16x32_bf16(wf[nt], xf[mt], acc[mt][nt], 0, 0, 0);
        else acc[mt][nt] = __builtin_amdgcn_mfma_f32_16x16x32_bf16(xf[mt], wf[nt], acc[mt][nt], 0, 0, 0);
      }
    }
  };
  WAIT_V(0);
  __syncthreads();
  issue(s0, 0);
  issue(s1, 1);
  for (int kt = 0; kt < nk; kt += 3) {
    step(kt, s0, s2);
    if (kt + 1 < nk) step(kt + 1, s1, s0);
    if (kt + 2 < nk) step(kt + 2, s2, s1);
  }
}

DI float sum4sq(f32x4 v) { return v[0] * v[0] + v[1] * v[1] + v[2] * v[2] + v[3] * v[3]; }

DI void transpose_job(const int tid_, const float* __restrict__ src, const float* __restrict__ scale, u16* __restrict__ dst, u16* __restrict__ dst2,
                      int K, int N, int kt, int nt, char* s0, char* s1, char* s2) {
  float* tile = (float*)s0;
  const int tid = tid_;
  __syncthreads();
#pragma unroll
  for (int i = 0; i < 16; ++i) {
    int kl = (tid >> 6) + 4 * i, nl = tid & 63;
    int k = kt * 64 + kl, n = nt * 64 + nl;
    tile[kl * 65 + nl] = (n < N) ? src[(size_t)k * N + n] : 0.f;
  }
  __syncthreads();
#pragma unroll
  for (int i = 0; i < 16; ++i) {
    int nl = (tid >> 6) + 4 * i, kl = tid & 63;
    int k = kt * 64 + kl, n = nt * 64 + nl;
    float v = tile[kl * 65 + nl];
    float sc = scale ? scale[k] : 1.f;
    dst[(size_t)n * K + k] = (u16)(pack2(v * sc, 0.f) & 0xffffu);
    if (dst2) dst2[(size_t)n * K + k] = (u16)(pack2(v, 0.f) & 0xffffu);
  }
}

DI void wprep_job(const int tid_, const Params& p, int l, int j, char* s0, char* s1, char* s2) {
  if (j < 1376) {
    transpose_job(tid_, p.in[I_WIN] + (size_t)l * 1024 * ZC, p.in[I_NORMW] + l * 1024, (u16*)(p.ws + WS_WIN) + (size_t)l * 5504 * 1024, nullptr,
                  1024, ZC, j / 86, j % 86, s0, s1, s2);
  } else if (j < 1384) {
    transpose_job(tid_, p.in[I_W2] + (size_t)l * 64 * 512, nullptr, (u16*)(p.ws + WS_W2) + (size_t)l * 512 * 64, nullptr, 64, 512, 0, j - 1376, s0, s1, s2);
  } else if (j < 1392) {
    transpose_job(tid_, p.in[I_A2] + (size_t)l * 64 * 512, nullptr, (u16*)(p.ws + WS_A2) + (size_t)l * 512 * 64, nullptr, 64, 512, 0, j - 1384, s0, s1, s2);
  } else if (j < 1464) {
    int q = j - 1392;
    transpose_job(tid_, p.in[I_WUQ] + (size_t)l * 384 * 768, p.in[I_QNORM] + l * 384, (u16*)(p.ws + WS_WUQ) + (size_t)l * 768 * 384, nullptr,
                  384, 768, q / 12, q % 12, s0, s1, s2);
  } else if (j < 1528) {
    int q = j - 1464;
    transpose_job(tid_, p.in[I_WUKV] + (size_t)l * 256 * 1024, p.in[I_KVNORM] + l * 256, (u16*)(p.ws + WS_WKVF) + (size_t)l * 1024 * 256,
                  (u16*)(p.ws + WS_WKVP) + (size_t)l * 1024 * 256, 256, 1024, q / 16, q % 16, s0, s1, s2);
  } else if (j < 1656) {
    int q = j - 1528;
    transpose_job(tid_, p.in[I_WA] + (size_t)l * 512 * 1024, nullptr, (u16*)(p.ws + WS_WA) + (size_t)l * 1024 * 512, nullptr, 512, 1024, q / 16, q % 16, s0, s1, s2);
  } else if (j < 1784) {
    int q = j - 1656;
    transpose_job(tid_, p.in[I_WB] + (size_t)l * 512 * 1024, nullptr, (u16*)(p.ws + WS_WB) + (size_t)l * 1024 * 512, nullptr, 512, 1024, q / 16, q % 16, s0, s1, s2);
  } else {
    int q = j - 1784;
    transpose_job(tid_, p.in[I_WOUT] + (size_t)l * 1024 * 1024, nullptr, (u16*)(p.ws + WS_WOUT) + (size_t)l * 1024 * 1024, nullptr, 1024, 1024, q / 16, q % 16, s0, s1, s2);
  }
}

DI void phase0(const int wv, const Params& p0, char* s0, char* s1, char* s2) {
  const Params p = load_params(p0);
  const int tid_ = opaque_tid(wv);
  if (opaque_bid() == 0 && tid_ < 64) ((unsigned*)(p.ws + WS_CTR))[tid_] = 0u;
  {
    u16* xb = (u16*)(p.ws + WS_XB);
#pragma unroll 1
    for (int job = opaque_bid(); job < T; job += gridDim.x) {
      const float* xs = x_src(p, 0, job);
      f32x4 xv = ld4(xs + tid_ * 4);
      *(u32x2*)(xb + (size_t)job * 1024 + tid_ * 4) = pack4(xv);
      float ss = sum4sq(xv);
#pragma unroll
      for (int m = 1; m < 64; m <<= 1) ss = xor_sum(ss, m);
      float* ssx = (float*)(p.ws + WS_SSX) + (size_t)job * 16;
      if ((tid_ & 63) == 0) ssx[tid_ >> 6] = ss;
      if (tid_ >= 4 && tid_ < 16) ssx[tid_] = 0.f;
    }
  }
#pragma unroll 1
  for (int j = opaque_bid(); j < 2040; j += gridDim.x) wprep_job(tid_, p, 0, j, s0, s1, s2);
}

DI void phase1(const XcdMap xm, const int wv, const Params& p0, int l, char* s0, char* s1, char* s2) {
  const Params p = load_params(p0);
  const int tid_ = opaque_tid(wv);
  const int tid = tid_, lane = tid & 63, wave = tid >> 6, g = lane >> 4, c16 = lane & 15;
  u16* z = (u16*)(p.ws + WS_Z);
  {
    const float* src = p.in[I_CLAT] + (size_t)l * 65536 * 256;
    u16* dst = (u16*)(p.ws + WS_LATB);
#pragma unroll 1
    for (int job = opaque_bid(); job < 8192; job += gridDim.x) {
      const size_t e = ((size_t)job * 256 + tid) * 8;
      f32x4 a = ld4(src + e), b = ld4(src + e + 4);
      u32x2 pa = pack4(a), pb = pack4(b);
      *(u32x4*)(dst + e) = u32x4{pa.x, pa.y, pb.x, pb.y};
    }
  }
  int m_start, m_cnt;
  const int total = xcd_total(xm, 261, 22, m_start, m_cnt);
#pragma unroll 1
  for (int t = xm.rank; t < total; t += xm.nlb) {
    int mtile, ntile;
    xcd_tile(t, m_start, m_cnt, 22, mtile, ntile);
    const int m0 = mtile * 128, n0 = ntile * 256;
    if (ntile == 21) {
      const int tl = opaque_tid(wv);
      const int lane = tl & 63, wave = tl >> 6, g = lane >> 4, c16 = lane & 15;
      f32x4 acc2[2][4];
      gemm_ring<128, 64, 4, 1, 4>(tl, (const u16*)(p.ws + WS_XB) + (size_t)m0 * 1024, 1024,
                                  (const u16*)(p.ws + WS_WIN) + ((size_t)l * 5504 + n0) * 1024, 1024, ZC - 1 - n0, 32, s0, s1, s2, acc2);
      const float* ssx = (const float*)(p.ws + WS_SSX);
#pragma unroll
      for (int mt = 0; mt < 2; ++mt) {
        const int m = m0 + wave * 32 + mt * 16 + c16;
        f32x4 s0_ = ld4(ssx + (size_t)m * 16), s1_ = ld4(ssx + (size_t)m * 16 + 4), s2_ = ld4(ssx + (size_t)m * 16 + 8), s3_ = ld4(ssx + (size_t)m * 16 + 12);
        f32x4 st = s0_ + s1_ + s2_ + s3_;
        const float rs = rsqrtf((st[0] + st[1] + st[2] + st[3]) * (1.f / 1024.f) + 1e-6f);
#pragma unroll
        for (int nt = 0; nt < 2; ++nt) {
          const int n = n0 + nt * 16 + g * 4;
          *(u32x2*)(z + (size_t)m * ZC + n) = pack4(acc2[mt][nt] * rs);
        }
      }
      continue;
    }
    f32x4 acc[4][8];
    gemm_ring<128, 256, 2, 2, 8, true>(tid_, (const u16*)(p.ws + WS_XB) + (size_t)m0 * 1024, 1024,
                               (const u16*)(p.ws + WS_WIN) + ((size_t)l * 5504 + n0) * 1024, 1024, ZC - 1 - n0, 32, s0, s1, s2, acc);
    const int wr = wave >> 1, wc = wave & 1;
    const float* ssx = (const float*)(p.ws + WS_SSX);
#pragma unroll
    for (int mt = 0; mt < 4; ++mt) {
      const int m = m0 + wr * 64 + mt * 16 + c16;
      f32x4 s0 = ld4(ssx + (size_t)m * 16), s1 = ld4(ssx + (size_t)m * 16 + 4), s2 = ld4(ssx + (size_t)m * 16 + 8), s3 = ld4(ssx + (size_t)m * 16 + 12);
      f32x4 st = s0 + s1 + s2 + s3;
      const float rs = rsqrtf((st[0] + st[1] + st[2] + st[3]) * (1.f / 1024.f) + 1e-6f);
      float psum = 0.f;
#pragma unroll
      for (int nt = 0; nt < 8; nt += 2) {
        const int n = n0 + wc * 128 + g * 32 + nt * 4;
        f32x4 v0 = acc[mt][nt] * rs, v1 = acc[mt][nt + 1] * rs;
        psum += sum4sq(v0) + sum4sq(v1);
        u32x2 a = pack4(v0), b = pack4(v1);
        *(u32x4*)(z + (size_t)m * ZC + n) = u32x4{a.x, a.y, b.x, b.y};
      }
      const bool isq = (ntile == 8 && wc == 1) || ntile == 9;
      if (isq || ntile == 10) {
        psum = xor_sum(psum, 16);
        psum = xor_sum(psum, 32);
        if (g == 0) {
          if (isq) ((float*)(p.ws + WS_SSQ))[(size_t)m * 8 + (ntile == 8 ? 0 : 1 + wc)] = psum;
          else ((float*)(p.ws + WS_SSKV))[(size_t)m * 4 + wc] = psum;
        }
      }
    }
  }
}

DI void rwkv_prep_tile(const int wv, const Params& p, int l, int mtile, int h, char* s0, char* s1, char* s2) {
  int tid = opaque_tid(wv);
  const u16* z = (const u16*)(p.ws + WS_Z);
  char* sAw = s0;
  char* sAa = s1;
  char* sBw = s2;
  char* sBa = s2 + 64 * LDA;
  const int t0 = mtile * 128;
  __syncthreads();
  {
    const int c8 = (tid & 15) * 8;
#pragma unroll 1
    for (int i = 0; i < 8; ++i) {
      const int row = (tid >> 4) + 16 * i;
      f32x4 a = shifted4(p, l, t0 + row, C_WL + c8);
      f32x4 b = shifted4(p, l, t0 + row, C_WL + c8 + 4);
      if (c8 < 64) {
#pragma unroll
        for (int e = 0; e < 4; ++e) { a[e] = tanhf_(a[e]); b[e] = tanhf_(b[e]); }
      }
      u32x2 pa = pack4(a), pb = pack4(b);
      char* dst = (c8 < 64 ? sAw : sAa) + row * LDA + (c8 & 63) * 2;
      *(u32x4*)dst = u32x4{pa.x, pa.y, pb.x, pb.y};
    }
    const u16* w2 = (const u16*)(p.ws + WS_W2) + ((size_t)l * 512 + h * 64) * 64;
    const u16* a2 = (const u16*)(p.ws + WS_A2) + ((size_t)l * 512 + h * 64) * 64;
#pragma unroll
    for (int i = 0; i < 2; ++i) {
      const int row = (tid >> 3) + 32 * i, ch = tid & 7;
      const int crow = ((row >> 2) & 3) * 16 + (row >> 4) * 4 + (row & 3);
      *(u32x4*)(sBw + row * LDA + ch * 16) = *(const u32x4*)(w2 + crow * 64 + ch * 8);
      *(u32x4*)(sBa + row * LDA + ch * 16) = *(const u32x4*)(a2 + crow * 64 + ch * 8);
    }
  }
  __syncthreads();
  tid = opaque_tid(wv);
  const int lane = tid & 63, wave = tid >> 6, g = lane >> 4, c16 = lane & 15;
  f32x4 accw[2][4], acca[2][4];
#pragma unroll
  for (int mt = 0; mt < 2; ++mt)
#pragma unroll
    for (int nt = 0; nt < 4; ++nt) { accw[mt][nt] = f32x4{0, 0, 0, 0}; acca[mt][nt] = f32x4{0, 0, 0, 0}; }
  const int fo = c16 * LDA + g * 16;
#pragma unroll
  for (int ks = 0; ks < 2; ++ks) {
    bf16x8 xw[2], xa[2], ww[4], wa[4];
#pragma unroll
    for (int mt = 0; mt < 2; ++mt) {
      xw[mt] = *(const bf16x8*)(sAw + (wave * 32 + mt * 16) * LDA + fo + ks * 64);
      xa[mt] = *(const bf16x8*)(sAa + (wave * 32 + mt * 16) * LDA + fo + ks * 64);
    }
#pragma unroll
    for (int nt = 0; nt < 4; ++nt) {
      ww[nt] = *(const bf16x8*)(sBw + (nt * 16) * LDA + fo + ks * 64);
      wa[nt] = *(const bf16x8*)(sBa + (nt * 16) * LDA + fo + ks * 64);
    }
#pragma unroll
    for (int mt = 0; mt < 2; ++mt)
#pragma unroll
      for (int nt = 0; nt < 4; ++nt) {
        accw[mt][nt] = __builtin_amdgcn_mfma_f32_16x16x32_bf16(ww[nt], xw[mt], accw[mt][nt], 0, 0, 0);
        acca[mt][nt] = __builtin_amdgcn_mfma_f32_16x16x32_bf16(wa[nt], xa[mt], acca[mt][nt], 0, 0, 0);
      }
  }
  float* DEC = (float*)(p.ws + WS_DEC);
  u16* R = (u16*)(p.ws + WS_R);
  u16* KM = (u16*)(p.ws + WS_KM);
  u16* V = (u16*)(p.ws + WS_V);
  u16* NKK = (u16*)(p.ws + WS_NKK);
  u16* KKA = (u16*)(p.ws + WS_KKA);
#pragma unroll
  for (int mt = 0; mt < 2; ++mt) {
    const int t = t0 + wave * 32 + mt * 16 + c16;
    const int cb = h * 64 + g * 16;
    const size_t o = (size_t)t * 512 + cb;
    f32x4 k4[4], kk[4];
    {
      f32x4 r4[4];
      shifted16(p, l, t, C_R + cb, r4);
      u32x2 a = pack4(r4[0]), b = pack4(r4[1]), c = pack4(r4[2]), d = pack4(r4[3]);
      *(u32x4*)(R + o) = u32x4{a.x, a.y, b.x, b.y};
      *(u32x4*)(R + o + 8) = u32x4{c.x, c.y, d.x, d.y};
    }
    {
      f32x4 v4[4];
      shifted16(p, l, t, C_V + cb, v4);
      u32x2 a = pack4(v4[0]), b = pack4(v4[1]), c = pack4(v4[2]), d = pack4(v4[3]);
      *(u32x4*)(V + o) = u32x4{a.x, a.y, b.x, b.y};
      *(u32x4*)(V + o + 8) = u32x4{c.x, c.y, d.x, d.y};
    }
    shifted16(p, l, t, C_K + cb, k4);
    float ssq = 0.f;
#pragma unroll
    for (int nt = 0; nt < 4; ++nt) {
      const int c = cb + nt * 4;
      f32x4 a0 = ld4(p.in[I_A0] + l * 512 + c), w0 = ld4(p.in[I_W0] + l * 512 + c);
      f32x4 a, dec;
#pragma unroll
      for (int e = 0; e < 4; ++e) {
        a[e] = sigmoidf_(a0[e] + acca[mt][nt][e]);
        float x = -(w0[e] + accw[mt][nt][e]);
        float sp = fmaxf(x, 0.f) + __logf(1.f + __expf(-fabsf(x)));
        float w = -sp - 0.5f;
        dec[e] = __expf(-__expf(w));
      }
      acca[mt][nt] = a;
      *(f32x4*)(DEC + o + nt * 4) = dec;
      f32x4 k_k = ld4(p.in[I_KK] + l * 512 + c);
      kk[nt] = k4[nt] * k_k;
      ssq += sum4sq(kk[nt]);
    }
    ssq = xor_sum(ssq, 16);
    ssq = xor_sum(ssq, 32);
    const float inv = rsqrtf(fmaxf(ssq, 1e-24f));
    u32x2 pn[4], pa[4], pk[4];
#pragma unroll
    for (int nt = 0; nt < 4; ++nt) {
      const int c = cb + nt * 4;
      f32x4 k_a = ld4(p.in[I_KA] + l * 512 + c);
      f32x4 kn = kk[nt] * inv;
      f32x4 av = acca[mt][nt];
      f32x4 one = f32x4{1.f, 1.f, 1.f, 1.f};
      pn[nt] = pack4(-kn);
      pa[nt] = pack4(kn * av);
      pk[nt] = pack4(k4[nt] * (one + (av - one) * k_a));
    }
    *(u32x4*)(NKK + o) = u32x4{pn[0].x, pn[0].y, pn[1].x, pn[1].y};
    *(u32x4*)(NKK + o + 8) = u32x4{pn[2].x, pn[2].y, pn[3].x, pn[3].y};
    *(u32x4*)(KKA + o) = u32x4{pa[0].x, pa[0].y, pa[1].x, pa[1].y};
    *(u32x4*)(KKA + o + 8) = u32x4{pa[2].x, pa[2].y, pa[3].x, pa[3].y};
    *(u32x4*)(KM + o) = u32x4{pk[0].x, pk[0].y, pk[1].x, pk[1].y};
    *(u32x4*)(KM + o + 8) = u32x4{pk[2].x, pk[2].y, pk[3].x, pk[3].y};
    __builtin_amdgcn_sched_barrier(0);
  }
}

DI void q_tile(const int tid_, const Params& p, int l, int mtile, int h, char* s0, char* s1, char* s2) {
  const int tid = tid_, lane = tid & 63, wave = tid >> 6, g = lane >> 4, c16 = lane & 15;
  const int m0 = mtile * 128;
  f32x4 acc[2][8];
  gemm_ring<128, 128, 4, 1, 8>(tid_, (const u16*)(p.ws + WS_Z) + (size_t)m0 * ZC + C_QC, ZC,
                             (const u16*)(p.ws + WS_WUQ) + ((size_t)l * 768 + h * 96) * 384, 384, 767 - h * 96, 12, s0, s1, s2, acc);
  u16* Q = (u16*)(p.ws + WS_Q);
  const float qscale = 0.14724576f;
#pragma unroll
  for (int mt = 0; mt < 2; ++mt) {
    const int ml = wave * 32 + mt * 16 + c16;
    const int t = m0 + ml;
    float rs;
    {
      const float* sq = (const float*)(p.ws + WS_SSQ) + (size_t)t * 8;
      rs = rsqrtf((sq[0] + sq[1] + sq[2]) * (1.f / 384.f) + 1e-6f);
    }
    float ssn = 0.f, ssr = 0.f;
#pragma unroll
    for (int nt = 0; nt < 6; ++nt) {
      acc[mt][nt] *= rs;
      float s = acc[mt][nt][0] * acc[mt][nt][0] + acc[mt][nt][1] * acc[mt][nt][1] + acc[mt][nt][2] * acc[mt][nt][2] + acc[mt][nt][3] * acc[mt][nt][3];
      if (nt < 4) ssn += s; else ssr += s;
    }
    ssn = xor_sum(ssn, 16); ssn = xor_sum(ssn, 32);
    ssr = xor_sum(ssr, 16); ssr = xor_sum(ssr, 32);
    const float rn = rsqrtf(ssn * (1.f / 64.f) + 1e-6f) * qscale;
    const float rr = rsqrtf(ssr * (1.f / 32.f) + 1e-6f) * qscale;
    u16* qrow = Q + (size_t)t * 768 + h * 96;
#pragma unroll
    for (int nt = 0; nt < 4; ++nt) {
      const int n = nt * 16 + g * 4;
      f32x4 gw = ld4(p.in[I_QNN] + l * 64 + n);
      *(u32x2*)(qrow + n) = pack4(acc[mt][nt] * gw * rn);
    }
    const int pos = tok_pos(t);
    const int j0 = g * 4;
    f32x4 g1 = ld4(p.in[I_QNR] + l * 32 + j0), g2 = ld4(p.in[I_QNR] + l * 32 + 16 + j0);
    f32x4 o1, o2;
#pragma unroll
    for (int e = 0; e < 4; ++e) {
      float c, s;
      rope_cs(pos, j0 + e, c, s);
      float x1 = acc[mt][4][e] * g1[e] * rr, x2 = acc[mt][5][e] * g2[e] * rr;
      o1[e] = x1 * c - x2 * s;
      o2[e] = x1 * s + x2 * c;
    }
    *(u32x2*)(qrow + 64 + j0) = pack4(o1);
    *(u32x2*)(qrow + 80 + j0) = pack4(o2);
  }
}

DI void kv_tile(const int tid_, const Params& p, int l, int mtile, int h, char* s0, char* s1, char* s2) {
  const int tid = tid_, lane = tid & 63, wave = tid >> 6, g = lane >> 4, c16 = lane & 15;
  f32x4 acc[2][8];
  const bool past = mtile >= 261;
  const int m0 = past ? (mtile - 261) * 128 : mtile * 128;
  if (!past) {
    gemm_ring<128, 128, 4, 1, 4>(tid_, (const u16*)(p.ws + WS_Z) + (size_t)m0 * ZC + C_CKV, ZC,
                               (const u16*)(p.ws + WS_WKVF) + ((size_t)l * 1024 + h * 128) * 256, 256, 127, 8, s0, s1, s2, acc);
  } else {
    gemm_ring<128, 128, 4, 1, 4>(tid_, (const u16*)(p.ws + WS_LATB) + (size_t)m0 * 256, 256,
                               (const u16*)(p.ws + WS_WKVP) + ((size_t)l * 1024 + h * 128) * 256, 256, 127, 8, s0, s1, s2, acc);
  }
  u16 *KN, *VT;
  int skv;
  if (!past && m0 < TP) { KN = (u16*)(p.ws + WS_KP); VT = (u16*)(p.ws + WS_VTP); skv = LP; }
  else { KN = (u16*)(p.ws + WS_KS); VT = (u16*)(p.ws + WS_VTS); skv = SK; }
#pragma unroll
  for (int mt = 0; mt < 2; ++mt) {
    {
      const int ml = wave * 32 + mt * 16 + c16;
      const int r = m0 + ml;
      float rs = 1.f;
      if (!past) { f32x4 s0 = ld4((const float*)(p.ws + WS_SSKV) + (size_t)r * 4); rs = rsqrtf((s0[0] + s0[1]) * (1.f / 256.f) + 1e-6f); }
      size_t krow;
      if (past) krow = (size_t)(r >> 11) * SK + (r & 2047);
      else if (r < TP) krow = r;
      else { int s = r - TP; krow = (size_t)(s >> 4) * SK + 2048 + (s & 15); }
      float ss = 0.f;
#pragma unroll
      for (int nt = 0; nt < 4; ++nt) {
        acc[mt][nt] *= rs;
        ss += acc[mt][nt][0] * acc[mt][nt][0] + acc[mt][nt][1] * acc[mt][nt][1] + acc[mt][nt][2] * acc[mt][nt][2] + acc[mt][nt][3] * acc[mt][nt][3];
      }
      ss = xor_sum(ss, 16); ss = xor_sum(ss, 32);
      const float rn = rsqrtf(ss * (1.f / 64.f) + 1e-6f);
#pragma unroll
      for (int nt = 0; nt < 4; ++nt) {
        const int n = nt * 16 + g * 4;
        f32x4 gw = ld4(p.in[I_KNN] + l * 64 + n);
        *(u32x2*)(KN + krow * 512 + h * 64 + n) = pack4(acc[mt][nt] * gw * rn);
      }
    }
    {
      const int mlb = wave * 32 + mt * 16 + g * 4;
      const int r = m0 + mlb;
      f32x4 rs4 = f32x4{1.f, 1.f, 1.f, 1.f};
      if (!past) {
        const float* sk = (const float*)(p.ws + WS_SSKV) + (size_t)r * 4;
#pragma unroll
        for (int e = 0; e < 4; ++e) { f32x4 s0 = ld4(sk + e * 4); rs4[e] = rsqrtf((s0[0] + s0[1]) * (1.f / 256.f) + 1e-6f); }
      }
      size_t vrow;
      if (past) vrow = ((size_t)((r >> 11) * 8 + h) * 64) * SK + (r & 2047);
      else if (r < TP) { int b = r / LP; vrow = ((size_t)(b * 8 + h) * 64) * LP + (r - b * LP); }
      else { int s = r - TP; vrow = ((size_t)((s >> 4) * 8 + h) * 64) * SK + 2048 + (s & 15); }
#pragma unroll
      for (int nt = 4; nt < 8; ++nt) {
        const int dv = (nt - 4) * 16 + c16;
        *(u32x2*)(VT + vrow + (size_t)dv * skv) = pack4(acc[mt][nt] * rs4);
      }
    }
  }
}

DI void lat_job(const int tid_, const Params& p, int l, int job) {
  const int tid = tid_, lane = tid & 63, wave = tid >> 6;
  const u16* z = (const u16*)(p.ws + WS_Z);
  for (int q = 0; q < 8; ++q) {
    const int t = job * 32 + wave * 8 + q;
    float* lat_out; float* kr_out; u16* kr_bf;
    if (t < TP) {
      int b = t / LP, i = t - b * LP;
      lat_out = p.out + O_LATP + ((size_t)(l * 8 + b) * LP + i) * 256;
      kr_out = p.out + O_KRP + ((size_t)(l * 8 + b) * LP + i) * 32;
      kr_bf = (u16*)(p.ws + WS_KRP) + (size_t)t * 32;
    } else {
      int s = t - TP, sb = s >> 4, j = s & 15;
      lat_out = p.out + O_LATN + ((size_t)(l * 32 + sb) * 16 + j) * 256;
      kr_out = p.out + O_KRN + ((size_t)(l * 32 + sb) * 16 + j) * 32;
      kr_bf = (u16*)(p.ws + WS_KRS) + ((size_t)sb * SK + 2048 + j) * 32;
    }
    f32x4 x = unpack4(*(const u32x2*)(z + (size_t)t * ZC + C_CKV + lane * 4));
    float ss = x[0] * x[0] + x[1] * x[1] + x[2] * x[2] + x[3] * x[3];
#pragma unroll
    for (int m = 1; m < 64; m <<= 1) ss = xor_sum(ss, m);
    float rs = rsqrtf(ss * (1.f / 256.f) + 1e-6f);
    f32x4 gw = ld4(p.in[I_KVNORM] + l * 256 + lane * 4);
    *(f32x4*)(lat_out + lane * 4) = x * rs * gw;
    float x1 = 0.f, x2 = 0.f;
    if (lane < 16) { x1 = bf2f(z[(size_t)t * ZC + C_KR + lane]); x2 = bf2f(z[(size_t)t * ZC + C_KR + 16 + lane]); }
    float s2 = x1 * x1 + x2 * x2;
#pragma unroll
    for (int m = 1; m < 64; m <<= 1) s2 = xor_sum(s2, m);
    float r2 = rsqrtf(s2 * (1.f / 32.f) + 1e-6f);
    if (lane < 16) {
      float y1 = x1 * r2 * p.in[I_KNR][l * 32 + lane], y2 = x2 * r2 * p.in[I_KNR][l * 32 + 16 + lane];
      float c, s;
      rope_cs(tok_pos(t), lane, c, s);
      float o1 = y1 * c - y2 * s, o2 = y1 * s + y2 * c;
      kr_out[lane] = o1; kr_out[16 + lane] = o2;
      kr_bf[lane] = (u16)(pack2(o1, 0.f) & 0xffffu);
      kr_bf[16 + lane] = (u16)(pack2(o2, 0.f) & 0xffffu);
    }
  }
}
DI void pastkr_job(const int tid_, const Params& p, int l, int job) {
  const int tid = tid_;
  const int r = job * 64 + (tid >> 2), c = (tid & 3) * 8;
  const float* src = p.in[I_CKR] + ((size_t)l * 65536 + r) * 32 + c;
  f32x4 a = ld4(src), b = ld4(src + 4);
  u32x2 pa = pack4(a), pb = pack4(b);
  u16* dst = (u16*)(p.ws + WS_KRS) + ((size_t)(r >> 11) * SK + (r & 2047)) * 32 + c;
  *(u32x4*)dst = u32x4{pa.x, pa.y, pb.x, pb.y};
}
DI void shiftrow_job(const int tid_, const Params& p, int l, int job) {
  const u16* z = (const u16*)(p.ws + WS_Z);
  int t; float* dst;
  if (job < 8) { t = job * LP + LP - 1; dst = p.out + O_SHP + (size_t)(l * 8 + job) * 2176; }
  else { int sb = job - 8; t = TP + sb * 16 + 15; dst = p.out + O_SHS + (size_t)(l * 32 + sb) * 2176; }
  for (int c = tid_; c < 2176; c += 256) dst[c] = bf2f(z[(size_t)t * ZC + c]);
}

DI void phase2(const XcdMap xm, const int wv, const Params& p0, int l, char* s0, char* s1, char* s2, int mask = 12) {
  if (mask & 4) { const int tid_ = opaque_tid(wv); const Params p = load_params(p0);
    int m_start, m_cnt; const int total = xcd_total(xm, 261, 8, m_start, m_cnt);
    for (int t = xm.rank; t < total; t += xm.nlb) { int mt_, nt_; xcd_tile(t, m_start, m_cnt, 8, mt_, nt_); rwkv_prep_tile(wv, p, l, mt_, nt_, s0, s1, s2); } }
  if (mask & 8) { const int tid_ = opaque_tid(wv); const Params p = load_params(p0);
#pragma unroll 1
    for (int job = opaque_bid(); job < 1044; job += gridDim.x) lat_job(tid_, p, l, job);
#pragma unroll 1
    for (int job = opaque_bid(); job < 1024; job += gridDim.x) pastkr_job(tid_, p, l, job);
#pragma unroll 1
    for (int job = opaque_bid(); job < 40; job += gridDim.x) shiftrow_job(tid_, p, l, job);
    if (l < 3) {
      unsigned* wq = (unsigned*)(p.ws + WS_CTR) + 24 + l;
      int* sjob = (int*)(s2 + 24576 - 16);
      while (true) {
        __syncthreads();
        if (tid_ == 0) *sjob = (int)atomicAdd(wq, 1u);
        __syncthreads();
        const int j = *sjob;
        if (j >= 2040) break;
        wprep_job(opaque_tid(wv), p, l + 1, j, s0, s1, s2);
      }
    } }
}

DI float row_allreduce(float x) {
  x += __int_as_float(__builtin_amdgcn_update_dpp(0, __float_as_int(x), 0x128, 0xf, 0xf, false));
  x += __int_as_float(__builtin_amdgcn_update_dpp(0, __float_as_int(x), 0x124, 0xf, 0xf, false));
  x += __int_as_float(__builtin_amdgcn_update_dpp(0, __float_as_int(x), 0x122, 0xf, 0xf, false));
  x += __int_as_float(__builtin_amdgcn_update_dpp(0, __float_as_int(x), 0x121, 0xf, 0xf, false));
  return x;
}

struct ScanRegs { f32x4 d; u32x4 a0, a1; u16 v; };

DI void scan_gload(const int tid_, ScanRegs& r, const Params& p, int tokc, int h, int rg) {
  const int tid = tid_;
  const float* DEC = (const float*)(p.ws + WS_DEC);
  const u16* V = (const u16*)(p.ws + WS_V);
  {
    int st = tid >> 4, c = tid & 15;
    r.d = ld4(DEC + (size_t)(tokc + st) * 512 + h * 64 + c * 4);
    r.v = V[(size_t)(tokc + st) * 512 + h * 64 + rg * 16 + c];
  }
  {
    int arr = tid >> 7, idx = tid & 127, st = idx >> 3, c8 = idx & 7;
    size_t off = (size_t)(tokc + st) * 512 + h * 64 + c8 * 8;
    const u16* s0 = (const u16*)(p.ws + (arr ? WS_KKA : WS_NKK));
    const u16* s1 = (const u16*)(p.ws + (arr ? WS_R : WS_KM));
    r.a0 = *(const u32x4*)(s0 + off);
    r.a1 = *(const u32x4*)(s1 + off);
  }
}
DI void scan_lstore(const int tid_, const ScanRegs& r, float* buf) {
  const int tid = tid_;
  {
    int st = tid >> 4, c = tid & 15;
    *(f32x4*)(buf + st * 64 + c * 4) = r.d;
    buf[5120 + st * 16 + c] = bf2f(r.v);
  }
  {
    int arr = tid >> 7, idx = tid & 127, st = idx >> 3, c8 = idx & 7;
    float* d0 = buf + 1024 + arr * 1024 + st * 64 + c8 * 8;
    float* d1 = buf + 3072 + arr * 1024 + st * 64 + c8 * 8;
    *(f32x4*)(d0) = unpack4(u32x2{r.a0.x, r.a0.y});
    *(f32x4*)(d0 + 4) = unpack4(u32x2{r.a0.z, r.a0.w});
    *(f32x4*)(d1) = unpack4(u32x2{r.a1.x, r.a1.y});
    *(f32x4*)(d1 + 4) = unpack4(u32x2{r.a1.z, r.a1.w});
  }
}

template <int CTRL> DI float dpp_get(float x) { return __int_as_float(__builtin_amdgcn_update_dpp(0, __float_as_int(x), CTRL, 0xf, 0xf, false)); }
DI void scan_chunk(const float* buf, f32x4& S, int w, int rw, int kg, float& ys) {
  float yp[16];
#pragma unroll
  for (int s = 0; s < 16; ++s) {
    const float* b = buf + s * 64 + kg * 4;
    f32x4 d = *(const f32x4*)(b), n = *(const f32x4*)(b + 1024), a = *(const f32x4*)(b + 2048), k = *(const f32x4*)(b + 3072),
          r = *(const f32x4*)(b + 4096);
    float vv = buf[5120 + s * 16 + w * 4 + rw];
    float pp = S[0] * n[0];
    pp = fmaf(S[1], n[1], pp); pp = fmaf(S[2], n[2], pp); pp = fmaf(S[3], n[3], pp);
    float sa = row_allreduce(pp);
#pragma unroll
    for (int e = 0; e < 4; ++e) S[e] = fmaf(sa, a[e], fmaf(S[e], d[e], vv * k[e]));
    float y = S[0] * r[0];
    y = fmaf(S[1], r[1], y); y = fmaf(S[2], r[2], y); y = fmaf(S[3], r[3], y);
    yp[s] = y;
  }
  const bool b3 = (kg & 8) != 0, b2 = (kg & 4) != 0, b1 = (kg & 2) != 0, b0 = (kg & 1) != 0;
  float t[8], u[4], v2[2];
#pragma unroll
  for (int j = 0; j < 8; ++j) { float keep = b3 ? yp[j + 8] : yp[j], send = b3 ? yp[j] : yp[j + 8]; t[j] = keep + dpp_get<0x140>(send); }
#pragma unroll
  for (int j = 0; j < 4; ++j) { float keep = b2 ? t[j + 4] : t[j], send = b2 ? t[j] : t[j + 4]; u[j] = keep + dpp_get<0x141>(send); }
#pragma unroll
  for (int j = 0; j < 2; ++j) { float keep = b1 ? u[j + 2] : u[j], send = b1 ? u[j] : u[j + 2]; v2[j] = keep + dpp_get<0x4E>(send); }
  { float keep = b0 ? v2[1] : v2[0], send = b0 ? v2[0] : v2[1]; ys = keep + dpp_get<0xB1>(send); }
}

DI void scan_job(const int tid_, const Params& p, int l, int job, char* s0, char* s1, char* s2) {
  const int tid = tid_, lane = tid & 63, w = tid >> 6, rw = lane >> 4, kg = lane & 15;
  int h, tok0, nchunks, rg;
  float* sout;
  f32x4 S;
  rg = job & 3;
  const int row = rg * 16 + w * 4 + rw;
  if (job < 256) {
    int seq = job >> 2, b = seq >> 3; h = seq & 7;
    tok0 = b * LP; nchunks = LP / 16;
    sout = p.out + O_SRP + ((((size_t)l * 8 + b) * 8 + h) * 64 + row) * 64 + kg * 4;
    S = f32x4{0.f, 0.f, 0.f, 0.f};
  } else {
    int seq = (job - 256) >> 2, sb = seq >> 3; h = seq & 7;
    tok0 = TP + sb * 16; nchunks = 1;
    sout = p.out + O_SRS + ((((size_t)l * 32 + sb) * 8 + h) * 64 + row) * 64 + kg * 4;
    S = ld4(p.in[I_SRWKV] + ((((size_t)l * 32 + sb) * 8 + h) * 64 + row) * 64 + kg * 4);
  }
  float* buf0 = (float*)s0;
  float* buf1 = (float*)s1;
  float* Y = p.out + O_YP;
  ScanRegs A, B;
  __syncthreads();
  __builtin_amdgcn_s_setprio(3);
  scan_gload(tid_, A, p, tok0, h, rg);
  scan_lstore(tid_, A, buf0);
  if (nchunks > 1) scan_gload(tid_, A, p, tok0 + 16, h, rg);
  __syncthreads();
  for (int c = 0; c < nchunks; c += 2) {
    if (c + 2 < nchunks) scan_gload(tid_, B, p, tok0 + (c + 2) * 16, h, rg);
    float ys = 0.f;
    scan_chunk(buf0, S, w, rw, kg, ys);
    Y[(size_t)(tok0 + c * 16 + kg) * 512 + h * 64 + row] = ys;
    if (c + 1 < nchunks) scan_lstore(tid_, A, buf1);
    __syncthreads();
    if (c + 1 < nchunks) {
      if (c + 3 < nchunks) scan_gload(tid_, A, p, tok0 + (c + 3) * 16, h, rg);
      ys = 0.f;
      scan_chunk(buf1, S, w, rw, kg, ys);
      Y[(size_t)(tok0 + (c + 1) * 16 + kg) * 512 + h * 64 + row] = ys;
      if (c + 2 < nchunks) scan_lstore(tid_, B, buf0);
      __syncthreads();
    }
  }
  *(f32x4*)sout = S;
  __builtin_amdgcn_s_setprio(0);
}

DI void attn_item(const int tid_, const Params& p, int l, int item, char* s0, char* s1, char* s2) {
  const int tid = tid_, lane = tid & 63, w = tid >> 6, g = lane >> 4, c16 = lane & 15;
  int h, qtok0, nq, ntiles, vis, kmode, skv;
  const u16 *KN, *KR, *VT;
  if (item < 256) {
    int sb = item >> 3; h = item & 7;
    qtok0 = TP + sb * 16; nq = 16; ntiles = 33; vis = (w == 0) ? 33 : 0; kmode = 1; skv = SK;
    KN = (const u16*)(p.ws + WS_KS) + (size_t)sb * SK * 512;
    KR = (const u16*)(p.ws + WS_KRS) + (size_t)sb * SK * 32;
    VT = (const u16*)(p.ws + WS_VTS) + (size_t)(sb * 8 + h) * 64 * SK;
  } else {
    int b;
    if (item < 2304) {
      int idx = item - 256, m = 31 - (idx >> 6), bh = idx & 63;
      b = bh >> 3; h = bh & 7;
      qtok0 = b * LP + 16 + 128 * m; nq = 128; ntiles = 2 * m + 3; vis = (w < 2) ? 2 * m + 2 : 2 * m + 3;
    } else {
      int bh = item - 2304;
      b = bh >> 3; h = bh & 7;
      qtok0 = b * LP; nq = 16; ntiles = 1; vis = (w == 0) ? 1 : 0;
    }
    kmode = 0; skv = LP;
    KN = (const u16*)(p.ws + WS_KP) + (size_t)b * LP * 512;
    KR = (const u16*)(p.ws + WS_KRP) + (size_t)b * LP * 32;
    VT = (const u16*)(p.ws + WS_VTP) + (size_t)(b * 8 + h) * 64 * LP;
  }
  const u16* Q = (const u16*)(p.ws + WS_Q);
  bf16x8 qf[2][3];
#pragma unroll
  for (int nt = 0; nt < 2; ++nt) {
    int ql = w * 32 + nt * 16 + c16;
    ql = ql < nq ? ql : nq - 1;
#pragma unroll
    for (int ks = 0; ks < 3; ++ks) qf[nt][ks] = *(const bf16x8*)(Q + (size_t)(qtok0 + ql) * 768 + h * 96 + ks * 32 + g * 8);
  }
  u32x4 kr[3], vr[2];
  auto tile_info = [&](int kt, int& key0, int& nvalid) {
    if (kmode == 0) { if (kt == 0) { key0 = 0; nvalid = 16; } else { key0 = 16 + 64 * (kt - 1); nvalid = 64; } }
    else { key0 = 64 * kt; nvalid = (kt == 32) ? 16 : 64; }
  };
  auto gload = [&](int kt) {
    int key0, nvalid;
    tile_info(kt, key0, nvalid);
#pragma unroll
    for (int i = 0; i < 3; ++i) {
      int idx = tid + 256 * i, row = idx / 12, ch = idx - row * 12;
      const u16* src = (ch < 8) ? KN + (size_t)(key0 + row) * 512 + h * 64 + ch * 8 : KR + (size_t)(key0 + row) * 32 + (ch - 8) * 8;
      kr[i] = (row < nvalid) ? *(const u32x4*)src : u32x4{0, 0, 0, 0};
    }
#pragma unroll
    for (int i = 0; i < 2; ++i) {
      int idx = tid + 256 * i, dv = idx >> 3, ch = idx & 7;
      vr[i] = (ch * 8 < nvalid) ? *(const u32x4*)(VT + (size_t)dv * skv + key0 + ch * 8) : u32x4{0, 0, 0, 0};
    }
  };
  auto lstore = [&](char* buf) {
#pragma unroll
    for (int i = 0; i < 3; ++i) {
      int idx = tid + 256 * i, row = idx / 12, ch = idx - row * 12;
      *(u32x4*)(buf + row * 208 + ch * 16) = kr[i];
    }
#pragma unroll
    for (int i = 0; i < 2; ++i) {
      int idx = tid + 256 * i, dv = idx >> 3, ch = idx & 7;
      *(u32x4*)(buf + 64 * 208 + dv * LDA + ch * 16) = vr[i];
    }
  };
  constexpr int BUFSZ = 64 * 208 + 64 * LDA;
  f32x4 o[4][2];
  float mrow[2], lsum[2];
#pragma unroll
  for (int nt = 0; nt < 2; ++nt) {
    mrow[nt] = -1e30f; lsum[nt] = 0.f;
#pragma unroll
    for (int dt = 0; dt < 4; ++dt) o[dt][nt] = f32x4{0, 0, 0, 0};
  }
  __syncthreads();
  gload(0);
  lstore(s0);
  if (ntiles > 1) gload(1);
  __syncthreads();
  for (int kt = 0; kt < ntiles; ++kt) {
    char* cur = (kt & 1) ? s1 : s0;
    if (kt + 1 < ntiles) {
      lstore(((kt + 1) & 1) ? s1 : s0);
      if (kt + 2 < ntiles) gload(kt + 2);
    }
    if (kt < vis) {
      int key0, nvalid;
      tile_info(kt, key0, nvalid);
      f32x4 s[4][2];
#pragma unroll
      for (int mt = 0; mt < 4; ++mt)
#pragma unroll
        for (int nt = 0; nt < 2; ++nt) s[mt][nt] = f32x4{0, 0, 0, 0};
#pragma unroll
      for (int ks = 0; ks < 3; ++ks)
#pragma unroll
        for (int mt = 0; mt < 4; ++mt) {
          bf16x8 kf = *(const bf16x8*)(cur + (mt * 16 + c16) * 208 + ks * 64 + g * 16);
#pragma unroll
          for (int nt = 0; nt < 2; ++nt) s[mt][nt] = __builtin_amdgcn_mfma_f32_16x16x32_bf16(kf, qf[nt][ks], s[mt][nt], 0, 0, 0);
        }
      if (nvalid < 64) {
#pragma unroll
        for (int mt = 0; mt < 4; ++mt)
#pragma unroll
          for (int nt = 0; nt < 2; ++nt)
#pragma unroll
            for (int e = 0; e < 4; ++e)
              if (mt * 16 + g * 4 + e >= nvalid) s[mt][nt][e] = -1e30f;
      }
      bf16x8 pf[2][2];
#pragma unroll
      for (int nt = 0; nt < 2; ++nt) {
        float mx = -1e30f;
#pragma unroll
        for (int mt = 0; mt < 4; ++mt)
#pragma unroll
          for (int e = 0; e < 4; ++e) mx = fmaxf(mx, s[mt][nt][e]);
        mx = xmax16(mx);
        mx = xmax32(mx);
        const float mnew = fmaxf(mrow[nt], mx);
        const float alpha = __builtin_amdgcn_exp2f(mrow[nt] - mnew);
        mrow[nt] = mnew;
        float ps = 0.f;
#pragma unroll
        for (int mt = 0; mt < 4; ++mt)
#pragma unroll
          for (int e = 0; e < 4; ++e) {
            float pv = __builtin_amdgcn_exp2f(s[mt][nt][e] - mnew);
            s[mt][nt][e] = pv;
            ps += pv;
          }
        lsum[nt] = lsum[nt] * alpha + ps;
        if (__builtin_amdgcn_ballot_w64(alpha != 1.f) != 0ull) {
#pragma unroll
          for (int dt = 0; dt < 4; ++dt) o[dt][nt] *= alpha;
        }
#pragma unroll
        for (int kk = 0; kk < 2; ++kk) {
          u32x2 lo = pack4(s[2 * kk][nt]), hi = pack4(s[2 * kk + 1][nt]);
          u32x4 pk = u32x4{lo.x, lo.y, hi.x, hi.y};
          pf[nt][kk] = __builtin_bit_cast(bf16x8, pk);
        }
      }
      const char* sV = cur + 64 * 208;
#pragma unroll
      for (int dt = 0; dt < 4; ++dt)
#pragma unroll
        for (int kk = 0; kk < 2; ++kk) {
          u32x2 lo = *(const u32x2*)(sV + (dt * 16 + c16) * LDA + (kk * 32 + g * 4) * 2);
          u32x2 hi = *(const u32x2*)(sV + (dt * 16 + c16) * LDA + (kk * 32 + 16 + g * 4) * 2);
          u32x4 pk = u32x4{lo.x, lo.y, hi.x, hi.y};
          bf16x8 vf = __builtin_bit_cast(bf16x8, pk);
#pragma unroll
          for (int nt = 0; nt < 2; ++nt) o[dt][nt] = __builtin_amdgcn_mfma_f32_16x16x32_bf16(vf, pf[nt][kk], o[dt][nt], 0, 0, 0);
        }
    }
    __syncthreads();
  }
  const u16* z = (const u16*)(p.ws + WS_Z);
  u16* YB = (u16*)(p.ws + WS_YB);
#pragma unroll
  for (int nt = 0; nt < 2; ++nt) {
    float lt = lsum[nt];
    lt = xsum16(lt);
    lt = xsum32(lt);
    const int ql = w * 32 + nt * 16 + c16;
    if (ql < nq && vis > 0) {
      const float il = 1.f / lt;
      const int tok = qtok0 + ql;
#pragma unroll
      for (int dt = 0; dt < 4; ++dt) {
        const int dv = dt * 16 + g * 4;
        f32x4 gt = unpack4(*(const u32x2*)(z + (size_t)tok * ZC + C_GB + h * 64 + dv));
        f32x4 ov = o[dt][nt] * il;
#pragma unroll
        for (int e = 0; e < 4; ++e) ov[e] *= siluf_(gt[e]);
        *(u32x2*)(YB + (size_t)tok * 512 + h * 64 + dv) = pack4(ov);
      }
    }
  }
}

DI void phase3(const int wv, const Params& p0, int l, char* s0, char* s1, char* s2, int coff, int mode = 0) {
  const Params p = load_params(p0);
  const int tid_ = opaque_tid(wv);
  unsigned* ctr = (unsigned*)(p.ws + WS_CTR) + l + coff;
  unsigned* done = (unsigned*)(p.ws + WS_CTR) + 8 + l + coff;
  unsigned* scanq = (unsigned*)(p.ws + WS_CTR) + 16 + l + coff;
  int* sjob = (int*)(s2 + 24576 - 16);
  __syncthreads();
  if (tid_ == 0) {
    const unsigned hw = (unsigned)__builtin_amdgcn_s_getreg((31 << 11) | 4);
    const unsigned key = ((xb_xcc_id_early() & 15u) << 8) | ((hw >> 8) & 0xffu);
    unsigned* cue = (unsigned*)(p.ws + WS_CUE) + (size_t)(l + coff) * 4096 + key;
    int j = -1;
    if (add_agent(cue, 1u) == 0u) { const unsigned q = add_agent(scanq, 1u); if (q < 256u) j = (int)q; }
    *sjob = j;
  }
  __syncthreads();
  {
    const int j = *sjob;
    if (j >= 0 && mode != 2) scan_job(opaque_tid(wv), p, l, j, s0, s1, s2);
  }
  constexpr int NQJ = 261 * 2;
  constexpr int J_Q = 773, J_AT = J_Q + NQJ, J_LS = J_AT + 2368, J_SS = J_LS + 256, NJ = J_SS + 1024;
  bool ready = false;
  while (true) {
    __syncthreads();
    if (tid_ == 0) *sjob = (int)atomicAdd(ctr, 1u);
    __syncthreads();
    const int job = *sjob;
    if (job >= NJ) break;
    const int tj = opaque_tid(wv);
    if (job < J_AT) {
      if (job < J_Q) {
#pragma unroll 1
        for (int h = 0; h < 8; ++h) kv_tile(opaque_tid(wv), p, l, job, h, s0, s1, s2);
      } else {
        const int jq = job - J_Q;
#pragma unroll 1
        for (int h = 0; h < 4; ++h) q_tile(opaque_tid(wv), p, l, jq >> 1, (jq & 1) * 4 + h, s0, s1, s2);
      }
      asm volatile("s_waitcnt vmcnt(0)" ::: "memory");
      __syncthreads();
      if (tj == 0) {
        __builtin_amdgcn_fence(__ATOMIC_RELEASE, "agent");
        asm volatile("s_waitcnt vmcnt(0)" ::: "memory");
        add_agent(done, 1u);
      }
    } else if (job < J_LS) {
      if (!ready) {
        if (tj == 0) { while (ld_agent(done) < (unsigned)(773 + NQJ)) __builtin_amdgcn_s_sleep(4); }
        __syncthreads();
        __builtin_amdgcn_fence(__ATOMIC_ACQUIRE, "agent");
        asm volatile("s_waitcnt vmcnt(0)" ::: "memory");
        ready = true;
      }
      if (mode != 1) attn_item(tj, p, l, job - J_AT, s0, s1, s2);
    } else if (job < J_SS) {
      __syncthreads();
      if (tj == 0) { const unsigned q = add_agent(scanq, 1u); *sjob = (q < 256u) ? (int)q : -1; }
      __syncthreads();
      const int j = *sjob;
      if (j >= 0 && mode != 2) scan_job(opaque_tid(wv), p, l, j, s0, s1, s2);
    } else { if (mode != 2) scan_job(tj, p, l, 256 + (job - J_SS), s0, s1, s2); }
  }
}

DI void phase3b(const int wv, const Params& p0, int l) {
  const Params p = load_params(p0);
  const int tid_ = opaque_tid(wv);
  const int tid = tid_, lane = tid & 63, wave = tid >> 6;
  const float* Y = p.out + O_YP;
  const u16* R = (const u16*)(p.ws + WS_R);
  const u16* KM = (const u16*)(p.ws + WS_KM);
  const u16* V = (const u16*)(p.ws + WS_V);
  u16* YA = (u16*)(p.ws + WS_YA);
  for (int job = opaque_bid(); job < 1044; job += gridDim.x) {
    for (int q = 0; q < 8; ++q) {
      const int t = job * 32 + wave * 8 + q;
      const int c = lane * 8;
      const size_t o = (size_t)t * 512 + c;
      f32x4 y0 = ld4(Y + o), y1 = ld4(Y + o + 4);
      float s = y0[0] + y0[1] + y0[2] + y0[3] + y1[0] + y1[1] + y1[2] + y1[3];
      s = xor_sum(s, 1); s = xor_sum(s, 2); s = xor_sum(s, 4);
      const float mu = s * (1.f / 64.f);
      f32x4 d0 = y0 - mu, d1 = y1 - mu;
      float vs = d0[0] * d0[0] + d0[1] * d0[1] + d0[2] * d0[2] + d0[3] * d0[3] + d1[0] * d1[0] + d1[1] * d1[1] + d1[2] * d1[2] + d1[3] * d1[3];
      vs = xor_sum(vs, 1); vs = xor_sum(vs, 2); vs = xor_sum(vs, 4);
      const float rstd = rsqrtf(vs * (1.f / 64.f) + 64e-5f);
      u32x4 rw = *(const u32x4*)(R + o), kw = *(const u32x4*)(KM + o), vw = *(const u32x4*)(V + o);
      f32x4 r0 = unpack4(u32x2{rw.x, rw.y}), r1 = unpack4(u32x2{rw.z, rw.w});
      f32x4 k0 = unpack4(u32x2{kw.x, kw.y}), k1 = unpack4(u32x2{kw.z, kw.w});
      f32x4 v0 = unpack4(u32x2{vw.x, vw.y}), v1 = unpack4(u32x2{vw.z, vw.w});
      f32x4 rk0 = ld4(p.in[I_RK] + l * 512 + c), rk1 = ld4(p.in[I_RK] + l * 512 + c + 4);
      f32x4 b0 = r0 * k0 * rk0, b1 = r1 * k1 * rk1;
      float bs = b0[0] + b0[1] + b0[2] + b0[3] + b1[0] + b1[1] + b1[2] + b1[3];
      bs = xor_sum(bs, 1); bs = xor_sum(bs, 2); bs = xor_sum(bs, 4);
      f32x4 lw0 = ld4(p.in[I_LNW] + l * 512 + c), lw1 = ld4(p.in[I_LNW] + l * 512 + c + 4);
      f32x4 lb0 = ld4(p.in[I_LNB] + l * 512 + c), lb1 = ld4(p.in[I_LNB] + l * 512 + c + 4);
      f32x4 g0 = shifted4(p, l, t, C_G + c), g1 = shifted4(p, l, t, C_G + c + 4);
      f32x4 o0 = d0 * rstd * lw0 + lb0 + v0 * bs;
      f32x4 o1 = d1 * rstd * lw1 + lb1 + v1 * bs;
#pragma unroll
      for (int e = 0; e < 4; ++e) { o0[e] *= siluf_(g0[e]); o1[e] *= siluf_(g1[e]); }
      u32x2 pa = pack4(o0), pb = pack4(o1);
      *(u32x4*)(YA + o) = u32x4{pa.x, pa.y, pb.x, pb.y};
    }
  }
}

DI void phase4(const XcdMap xm, const int wv, const Params& p0, int l, char* s0, char* s1, char* s2) {
  const Params p = load_params(p0);
  const int tid_ = opaque_tid(wv);
  const u16* z = (const u16*)(p.ws + WS_Z);
  u16* U = (u16*)(p.ws + WS_U);
  int m_start, m_cnt;
  const int total = xcd_total(xm, 174, 8, m_start, m_cnt);
#pragma unroll 1
  for (int t = xm.rank; t < total; t += xm.nlb) {
    int mtile, ntile;
    xcd_tile(t, m_start, m_cnt, 8, mtile, ntile);
    const int tl = opaque_tid(wv);
    const int lane = tl & 63, wave = tl >> 6, g = lane >> 4, c16 = lane & 15;
    const int m0 = mtile * 192, n0 = ntile * 128;
    f32x4 acc[6][4];
    {
      gemm_ring<192, 128, 2, 2, 4, true>(tl, (const u16*)(p.ws + WS_YA) + (size_t)m0 * 512, 512,
                                 (const u16*)(p.ws + WS_WA) + ((size_t)l * 1024 + n0) * 512, 512, 127, 16, s0, s1, s2, acc);
    }
    const int wr = wave >> 1, wc = wave & 1;
#pragma unroll
    for (int mt = 0; mt < 6; ++mt) {
      const int m = m0 + wr * 96 + mt * 16 + c16;
#pragma unroll
      for (int nt = 0; nt < 4; nt += 2) {
        const int n = n0 + wc * 64 + g * 16 + nt * 4;
        u32x4 gw = *(const u32x4*)(z + (size_t)m * ZC + C_GA1 + n);
        f32x4 ga0 = unpack4(u32x2{gw.x, gw.y}), ga1 = unpack4(u32x2{gw.z, gw.w});
        f32x4 r0 = acc[mt][nt], r1 = acc[mt][nt + 1];
#pragma unroll
        for (int e = 0; e < 4; ++e) { r0[e] *= sigmoidf_(ga0[e]); r1[e] *= sigmoidf_(ga1[e]); }
        u32x2 a = pack4(r0), b = pack4(r1);
        *(u32x4*)(U + (size_t)m * 1024 + n) = u32x4{a.x, a.y, b.x, b.y};
        __builtin_amdgcn_sched_barrier(0);
      }
    }
    {
      gemm_ring<192, 128, 2, 2, 4, true>(tl, (const u16*)(p.ws + WS_YB) + (size_t)m0 * 512, 512,
                                 (const u16*)(p.ws + WS_WB) + ((size_t)l * 1024 + n0) * 512, 512, 127, 16, s0, s1, s2, acc);
    }
#pragma unroll
    for (int mt = 0; mt < 6; ++mt) {
      const int m = m0 + wr * 96 + mt * 16 + c16;
#pragma unroll
      for (int nt = 0; nt < 4; nt += 2) {
        const int n = n0 + wc * 64 + g * 16 + nt * 4;
        u32x4 gw = *(const u32x4*)(z + (size_t)m * ZC + C_GB1 + n);
        u32x4 uw = *(const u32x4*)(U + (size_t)m * 1024 + n);
        f32x4 gb0 = unpack4(u32x2{gw.x, gw.y}), gb1 = unpack4(u32x2{gw.z, gw.w});
        f32x4 r0 = unpack4(u32x2{uw.x, uw.y}), r1 = unpack4(u32x2{uw.z, uw.w});
#pragma unroll
        for (int e = 0; e < 4; ++e) { r0[e] += acc[mt][nt][e] * sigmoidf_(gb0[e]); r1[e] += acc[mt][nt + 1][e] * sigmoidf_(gb1[e]); }
        u32x2 a = pack4(r0), b = pack4(r1);
        *(u32x4*)(U + (size_t)m * 1024 + n) = u32x4{a.x, a.y, b.x, b.y};
        __builtin_amdgcn_sched_barrier(0);
      }
    }
  }
}

DI void phase5(const XcdMap xm, const int wv, const Params& p0, int l, char* s0, char* s1, char* s2) {
  const Params p = load_params(p0);
  const int tid_ = opaque_tid(wv);
  u16* xb = (u16*)(p.ws + WS_XB);
  int m_start, m_cnt;
  const int total = xcd_total(xm, 174, 8, m_start, m_cnt);
#pragma unroll 1
  for (int t = xm.rank; t < total; t += xm.nlb) {
    int mtile, ntile;
    xcd_tile(t, m_start, m_cnt, 8, mtile, ntile);
    const int tl = opaque_tid(wv);
    const int lane = tl & 63, wave = tl >> 6, g = lane >> 4, c16 = lane & 15;
    const int m0 = mtile * 192, n0 = ntile * 128;
    f32x4 acc[6][4];
    {
      gemm_ring<192, 128, 2, 2, 4, true>(tl, (const u16*)(p.ws + WS_U) + (size_t)m0 * 1024, 1024,
                                 (const u16*)(p.ws + WS_WOUT) + ((size_t)l * 1024 + n0) * 1024, 1024, 127, 32, s0, s1, s2, acc);
    }
    const int wr = wave >> 1, wc = wave & 1;
#pragma unroll
    for (int mt = 0; mt < 6; ++mt) {
      const int m = m0 + wr * 96 + mt * 16 + c16;
      float* xd = x_dst(p, m);
      float psum = 0.f;
#pragma unroll
      for (int nt = 0; nt < 4; nt += 2) {
        const int n = n0 + wc * 64 + g * 16 + nt * 4;
        u32x4 xw = *(const u32x4*)(xb + (size_t)m * 1024 + n);
        f32x4 x0 = unpack4(u32x2{xw.x, xw.y}) + acc[mt][nt], x1 = unpack4(u32x2{xw.z, xw.w}) + acc[mt][nt + 1];
        psum += sum4sq(x0) + sum4sq(x1);
        if (l == 3) { *(f32x4*)(xd + n) = x0; *(f32x4*)(xd + n + 4) = x1; }
        else { u32x2 a = pack4(x0), b = pack4(x1); *(u32x4*)(xb + (size_t)m * 1024 + n) = u32x4{a.x, a.y, b.x, b.y}; }
      }
      psum = xor_sum(psum, 16);
      psum = xor_sum(psum, 32);
      if (g == 0) ((float*)(p.ws + WS_SSX))[(size_t)m * 16 + ntile * 2 + wc] = psum;
    }
  }
}

#define XB_TMO      128
#define XB_XCNT(j)  (256  + 64 * (j))
#define XB_XSUB(j)  (1280 + 64 * (j))
#define XB_XGEN(j)  (2304 + 64 * (j))
#define XB_TOP      3328
#define XB_TOPGEN   3392
#define XCD_BAR_WORDS 3456
#define XB_SPIN_CAP (1u << 22)
DI unsigned xb_ld(unsigned* p) { return __hip_atomic_load(p, __ATOMIC_RELAXED, __HIP_MEMORY_SCOPE_AGENT); }
DI unsigned xb_add(unsigned* p, unsigned v) { return __hip_atomic_fetch_add(p, v, __ATOMIC_RELAXED, __HIP_MEMORY_SCOPE_AGENT); }
DI unsigned xb_xcc_id() { return (unsigned)__builtin_amdgcn_s_getreg((3 << 11) | 20) & 0xFu; }
#define XB_SPIN(cond, bar) do { unsigned _sp = 0; while (cond) { __builtin_amdgcn_s_sleep(1); \
    if ((++_sp & 255u) == 0u) { if (xb_ld(&(bar)[XB_TMO])) break; if (_sp > XB_SPIN_CAP) { atomicAdd(&(bar)[XB_TMO], 1u); break; } } } } while (0)
struct XcdBarrier { unsigned* bar; unsigned x; volatile LAS unsigned* st; };
DI void xcd_barrier_complete(unsigned* bar, unsigned x, unsigned& nloc, unsigned& nx) {
  const unsigned G = gridDim.x;
  unsigned sum, cnt, mine, sp = 0u;
  for (;;) {
    sum = 0u; cnt = 0u; mine = 0u;
#pragma unroll
    for (unsigned j = 0; j < 16; ++j) { const unsigned c = xb_ld(&bar[XB_XCNT(j)]); sum += c; cnt += (c > 0u) ? 1u : 0u; mine = (j == x) ? c : mine; }
    if (sum == G) break;
    __builtin_amdgcn_s_sleep(1);
    if ((++sp & 255u) == 0u) { if (xb_ld(&bar[XB_TMO])) break; if (sp > XB_SPIN_CAP) { atomicAdd(&bar[XB_TMO], 1u); break; } }
  }
  nloc = mine > 0u ? mine : 1u; nx = cnt > 0u ? cnt : 1u;
}
DI void xcd_barrier(const XcdBarrier& b, const int tid) {
  asm volatile("s_waitcnt vmcnt(0)" ::: "memory");
  __syncthreads();
  if (tid == 0) {
    unsigned* bar = b.bar;
    __builtin_amdgcn_s_waitcnt(0);
    unsigned nloc = b.st[0], nx = b.st[1];
    if (nloc == 0u) { xcd_barrier_complete(bar, b.x, nloc, nx); b.st[0] = nloc; b.st[1] = nx; }
    const unsigned old = xb_add(&bar[XB_XSUB(b.x)], 1u);
    const unsigned gen = old / nloc;
    if (old + 1u == (gen + 1u) * nloc) {
      __builtin_amdgcn_fence(__ATOMIC_RELEASE, "agent");
      asm volatile("s_waitcnt vmcnt(0)" ::: "memory");
      const unsigned og = xb_add(&bar[XB_TOP], 1u);
      const unsigned tg = og / nx;
      if (og + 1u == (tg + 1u) * nx) xb_add(&bar[XB_TOPGEN], 1u);
      else XB_SPIN(xb_ld(&bar[XB_TOPGEN]) == tg, bar);
      __builtin_amdgcn_fence(__ATOMIC_ACQUIRE, "agent");
      xb_add(&bar[XB_XGEN(b.x)], 1u);
      asm volatile("s_waitcnt vmcnt(0)" ::: "memory");
    } else {
      XB_SPIN(xb_ld(&bar[XB_XGEN(b.x)]) == gen, bar);
      __builtin_amdgcn_fence(__ATOMIC_ACQUIRE, "agent");
      asm volatile("s_waitcnt vmcnt(0)" ::: "memory");
    }
  }
  __syncthreads();
}

__global__ void __launch_bounds__(256, 2) mega_kernel(Params p) {
  __shared__ __attribute__((aligned(1024))) char lds0[24576];
  __shared__ __attribute__((aligned(1024))) char lds1[24576];
  __shared__ __attribute__((aligned(1024))) char lds2[24576];
  __shared__ __attribute__((aligned(16))) unsigned xbw[4];
  cg::grid_group grid = cg::this_grid();
  const int wv = __builtin_amdgcn_readfirstlane((int)(threadIdx.x >> 6));
  XcdBarrier xb;
  {
    const int t0 = opaque_tid(wv);
    if (t0 == 0) { xbw[0] = 0u; xbw[1] = 0u; xbw[2] = 0u; xbw[3] = 0u; }
    __syncthreads();
    xb.bar = (unsigned*)(p.ws + WS_BAR); xb.x = xb_xcc_id(); xb.st = (volatile LAS unsigned*)xbw;
    if (t0 == 0) xbw[2] = xb_add(&xb.bar[XB_XCNT(xb.x)], 1u);
    __syncthreads();
  }
  XcdMap xm;
  xm.rank = __builtin_amdgcn_readfirstlane((int)xbw[2]);
  xm.xcc = 0; xm.nlb = 1; xm.nx = 1;
  for (int ph = 0; ph < NPH; ++ph) {
    if (ph == 1) {
      if (p.ph_hi < 0) grid.sync();
      xcd_barrier(xb, opaque_tid(wv));
      const int t0 = opaque_tid(wv);
      if (t0 == 0) {
        unsigned mine = 0u, cnt = 0u, idx = 0u;
#pragma unroll
        for (unsigned j = 0; j < 16; ++j) {
          const unsigned c = xb_ld(&xb.bar[XB_XCNT(j)]);
          cnt += (c > 0u) ? 1u : 0u;
          idx += (c > 0u && j < xb.x) ? 1u : 0u;
          mine = (j == xb.x) ? c : mine;
        }
        xbw[0] = mine; xbw[1] = cnt; xbw[3] = idx;
      }
      __syncthreads();
      xm.nlb = __builtin_amdgcn_readfirstlane((int)xbw[0]);
      xm.nx = __builtin_amdgcn_readfirstlane((int)xbw[1]);
      xm.xcc = __builtin_amdgcn_readfirstlane((int)xbw[3]);
    } else if (ph > 1) xcd_barrier(xb, opaque_tid(wv));
    if (ph == 0) phase0(wv, p, lds0, lds1, lds2);
    else {
      const int l = (ph - 1) / 6, s = (ph - 1) - l * 6;
      if (s == 0) phase1(xm, wv, p, l, lds0, lds1, lds2);
      else if (s == 1) phase2(xm, wv, p, l, lds0, lds1, lds2);
      else if (s == 2) phase3(wv, p, l, lds0, lds1, lds2, 0);
      else if (s == 3) phase3b(wv, p, l);
      else if (s == 4) phase4(xm, wv, p, l, lds0, lds1, lds2);
      else phase5(xm, wv, p, l, lds0, lds1, lds2);
#if PROBE_PHASE >= 0
      if (s == PROBE_PHASE) {
        xcd_barrier(xb, opaque_tid(wv));
        if (s == 0) phase1(xm, wv, p, l, lds0, lds1, lds2);
        else if (s == 1) phase2(xm, wv, p, l, lds0, lds1, lds2, PROBE_MODE);
        else if (s == 2) phase3(wv, p, l, lds0, lds1, lds2, 4, PROBE_MODE);
        else if (s == 3) phase3b(wv, p, l);
        else if (s == 4) phase4(xm, wv, p, l, lds0, lds1, lds2);
      }
#endif
    }
  }
}

extern "C" void kernel_launch(void* const* d_in, const int* in_sizes, int n_in, void* d_out, int out_size, void* d_ws, size_t ws_size,
                              hipStream_t stream) {
  static int grid_blocks = 0;
  if (!grid_blocks) {
    int dev = 0, cus = 0, per_cu = 0;
    hipGetDevice(&dev);
    hipDeviceGetAttribute(&cus, hipDeviceAttributeMultiprocessorCount, dev);
    hipOccupancyMaxActiveBlocksPerMultiprocessor(&per_cu, mega_kernel, 256, 0);
    if (per_cu > 2) per_cu = 2;
    if (per_cu < 1) per_cu = 1;
    grid_blocks = cus * per_cu;
  }
  if (ws_size < WS_END) { fprintf(stderr, "workspace too small: %zu < %zu\n", ws_size, (size_t)WS_END); return; }
  Params p{};
  for (int i = 0; i < 30; ++i) p.in[i] = (const float*)d_in[i];
  p.out = (float*)d_out;
  p.ws = (char*)d_ws;
  hipMemsetAsync((char*)d_ws + WS_BAR, 0, 16384, stream);
  hipMemsetAsync((char*)d_ws + WS_CUE, 0, (size_t)8 * 4096 * 4, stream);
  p.ph_lo = 0; p.ph_hi = NPH;
  void* args[] = {&p};
  hipError_t e = hipLaunchCooperativeKernel((void*)mega_kernel, dim3(grid_blocks), dim3(256), args, 0, stream);
  if (e != hipSuccess) fprintf(stderr, "cooperative launch failed: %s (grid %d)\n", hipGetErrorString(e), grid_blocks);
}
```

```cpp
#include <hip/hip_runtime.h>
#include <hip/hip_cooperative_groups.h>
#include <stdint.h>
#include <cstdio>
namespace cg = cooperative_groups;

#ifndef PROBE_MODE
#define PROBE_MODE 0
#endif
#ifndef PROBE_PHASE
#define PROBE_PHASE -1
#endif
#ifndef MULTI_LAUNCH
#define MULTI_LAUNCH 0
#endif

typedef unsigned short u16;
typedef __attribute__((ext_vector_type(4))) unsigned u32x4;
typedef __attribute__((ext_vector_type(2))) unsigned u32x2;
typedef __attribute__((ext_vector_type(8))) short bf16x8;
typedef __attribute__((ext_vector_type(4))) float f32x4;
typedef __attribute__((ext_vector_type(2))) float f32x2;
typedef __attribute__((ext_vector_type(2))) __bf16 bf16x2v;
#define DI __device__ __forceinline__
#define LAS __attribute__((address_space(3)))

constexpr int LP = 4112, TP = 8 * LP, TS = 512, T = TP + TS;
constexpr int SK = 2064;
constexpr int ZC = 5408;
constexpr int C_R = 0, C_K = 512, C_V = 1024, C_G = 1536, C_WL = 2048, C_QC = 2176, C_CKV = 2560, C_KR = 2816,
              C_GB = 2848, C_GA1 = 3360, C_GB1 = 4384;
constexpr int NPH = 25;

enum { I_XP = 0, I_XS, I_SRWKV, I_SSHIFT, I_CLAT, I_CKR, I_META, I_NORMW, I_WIN, I_MIX, I_W0, I_W2, I_A0, I_A2, I_KK, I_KA,
       I_RK, I_LNW, I_LNB, I_QNORM, I_WUQ, I_KVNORM, I_WUKV, I_QNN, I_KNN, I_QNR, I_KNR, I_WA, I_WB, I_WOUT };

constexpr size_t O_YP = 0;
constexpr size_t O_YS = O_YP + (size_t)8 * 4096 * 1024;
constexpr size_t O_SRP = O_YS + (size_t)512 * 1024;
constexpr size_t O_SHP = O_SRP + (size_t)4 * 8 * 8 * 64 * 64;
constexpr size_t O_LATP = O_SHP + (size_t)4 * 8 * 2176;
constexpr size_t O_KRP = O_LATP + (size_t)4 * 8 * LP * 256;
constexpr size_t O_SRS = O_KRP + (size_t)4 * 8 * LP * 32;
constexpr size_t O_SHS = O_SRS + (size_t)4 * 32 * 8 * 64 * 64;
constexpr size_t O_LATN = O_SHS + (size_t)4 * 32 * 2176;
constexpr size_t O_KRN = O_LATN + (size_t)4 * 32 * 16 * 256;

constexpr size_t al256(size_t x) { return (x + 255) & ~(size_t)255; }
constexpr size_t WS_WIN = 0;
constexpr size_t WS_W2 = al256(WS_WIN + (size_t)4 * 5504 * 1024 * 2);
constexpr size_t WS_A2 = al256(WS_W2 + (size_t)4 * 512 * 64 * 2);
constexpr size_t WS_WUQ = al256(WS_A2 + (size_t)4 * 512 * 64 * 2);
constexpr size_t WS_WKVF = al256(WS_WUQ + (size_t)4 * 768 * 384 * 2);
constexpr size_t WS_WKVP = al256(WS_WKVF + (size_t)4 * 1024 * 256 * 2);
constexpr size_t WS_WA = al256(WS_WKVP + (size_t)4 * 1024 * 256 * 2);
constexpr size_t WS_WB = al256(WS_WA + (size_t)4 * 1024 * 512 * 2);
constexpr size_t WS_WOUT = al256(WS_WB + (size_t)4 * 1024 * 512 * 2);
constexpr size_t WS_XMETA = al256(WS_WOUT + (size_t)4 * 1024 * 1024 * 2);
constexpr size_t WS_CTR = al256(WS_XMETA + (size_t)128 * 1024 * 4);
constexpr size_t WS_Z = al256(WS_CTR + 1024);
constexpr size_t WS_DEC = al256(WS_Z + (size_t)T * ZC * 2);
constexpr size_t WS_R = al256(WS_DEC + (size_t)T * 512 * 4);
constexpr size_t WS_KM = al256(WS_R + (size_t)T * 512 * 2);
constexpr size_t WS_V = al256(WS_KM + (size_t)T * 512 * 2);
constexpr size_t WS_NKK = al256(WS_V + (size_t)T * 512 * 2);
constexpr size_t WS_KKA = al256(WS_NKK + (size_t)T * 512 * 2);
constexpr size_t WS_Y = al256(WS_KKA + (size_t)T * 512 * 2);
constexpr size_t WS_Q = al256(WS_Y + (size_t)T * 512 * 4);
constexpr size_t WS_KP = al256(WS_Q + (size_t)T * 768 * 2);
constexpr size_t WS_VTP = al256(WS_KP + (size_t)TP * 512 * 2);
constexpr size_t WS_KRP = al256(WS_VTP + (size_t)TP * 512 * 2);
constexpr size_t WS_KS = al256(WS_KRP + (size_t)TP * 32 * 2);
constexpr size_t WS_VTS = al256(WS_KS + (size_t)32 * SK * 512 * 2);
constexpr size_t WS_KRS = al256(WS_VTS + (size_t)32 * SK * 512 * 2 + 4096);
constexpr size_t WS_YB = al256(WS_KRS + (size_t)32 * SK * 32 * 2);
constexpr size_t WS_LATB = al256(WS_YB + (size_t)T * 512 * 2);
constexpr size_t WS_BAR = al256(WS_LATB + (size_t)65536 * 256 * 2);
constexpr size_t WS_TAB = al256(WS_BAR + 16384);
constexpr size_t WS_SSX = al256(WS_TAB + 512);
constexpr size_t WS_SSQ = al256(WS_SSX + (size_t)T * 16 * 4);
constexpr size_t WS_SSKV = al256(WS_SSQ + (size_t)T * 8 * 4);
constexpr size_t WS_CUE = al256(WS_SSKV + (size_t)T * 4 * 4);
constexpr size_t WS_END = al256(WS_CUE + (size_t)8 * 4096 * 4);
constexpr size_t WS_U = WS_DEC;
constexpr size_t WS_YA = WS_Q;
constexpr size_t WS_XB = WS_Y;

struct Params {
  const float* in[30];
  float* out;
  char* ws;
  int ph_lo, ph_hi;
};

DI uint32_t pack2(float a, float b) {
  f32x2 v = {a, b};
  bf16x2v r = __builtin_convertvector(v, bf16x2v);
  return __builtin_bit_cast(uint32_t, r);
}
DI float bflo(uint32_t w) { return __uint_as_float(w << 16); }
DI float bfhi(uint32_t w) { return __uint_as_float(w & 0xffff0000u); }
DI float bf2f(u16 h) { return __uint_as_float(((uint32_t)h) << 16); }
DI f32x4 unpack4(u32x2 w) { return f32x4{bflo(w.x), bfhi(w.x), bflo(w.y), bfhi(w.y)}; }
DI u32x2 pack4(f32x4 v) { return u32x2{pack2(v[0], v[1]), pack2(v[2], v[3])}; }
DI int opaque_tid(const int wv) {
  int lane;
  asm volatile("v_mbcnt_lo_u32_b32 %0, -1, 0\n\tv_mbcnt_hi_u32_b32 %0, -1, %0" : "=v"(lane));
  return (wv << 6) | lane;
}
DI int opaque_bid() { int b = blockIdx.x; asm volatile("" : "+s"(b)); return b; }
DI unsigned xb_xcc_id_early() { return (unsigned)__builtin_amdgcn_s_getreg((3 << 11) | 20) & 0xFu; }
DI unsigned ld_agent(unsigned* p) { return __hip_atomic_load(p, __ATOMIC_RELAXED, __HIP_MEMORY_SCOPE_AGENT); }
DI unsigned add_agent(unsigned* p, unsigned v) { return __hip_atomic_fetch_add(p, v, __ATOMIC_RELAXED, __HIP_MEMORY_SCOPE_AGENT); }
DI float sigmoidf_(float x) { return __builtin_amdgcn_rcpf(1.f + __expf(-x)); }
DI float siluf_(float x) { return x * __builtin_amdgcn_rcpf(1.f + __expf(-x)); }
DI float tanhf_(float x) { return 1.f - 2.f * __builtin_amdgcn_rcpf(__expf(2.f * x) + 1.f); }
DI float xsum16(float x) { u32x2 r = __builtin_amdgcn_permlane16_swap(__float_as_uint(x), __float_as_uint(x), false, false); return __uint_as_float(r.x) + __uint_as_float(r.y); }
DI float xsum32(float x) { u32x2 r = __builtin_amdgcn_permlane32_swap(__float_as_uint(x), __float_as_uint(x), false, false); return __uint_as_float(r.x) + __uint_as_float(r.y); }
DI float xmax16(float x) { u32x2 r = __builtin_amdgcn_permlane16_swap(__float_as_uint(x), __float_as_uint(x), false, false); return fmaxf(__uint_as_float(r.x), __uint_as_float(r.y)); }
DI float xmax32(float x) { u32x2 r = __builtin_amdgcn_permlane32_swap(__float_as_uint(x), __float_as_uint(x), false, false); return fmaxf(__uint_as_float(r.x), __uint_as_float(r.y)); }
DI float xor_sum(float v, int m) {
  if (m == 1) return v + __int_as_float(__builtin_amdgcn_update_dpp(0, __float_as_int(v), 0xB1, 0xf, 0xf, false));
  if (m == 2) return v + __int_as_float(__builtin_amdgcn_update_dpp(0, __float_as_int(v), 0x4E, 0xf, 0xf, false));
  if (m == 4) return v + __int_as_float(__builtin_amdgcn_update_dpp(0, __float_as_int(v), 0x141, 0xf, 0xf, false));
  if (m == 8) return v + __int_as_float(__builtin_amdgcn_update_dpp(0, __float_as_int(v), 0x140, 0xf, 0xf, false));
  if (m == 16) return xsum16(v);
  if (m == 32) return xsum32(v);
  return v + __shfl_xor(v, m);
}
DI f32x4 ld4(const float* p) { return *(const f32x4*)p; }

DI void rope_cs(int pos, int j, float& c, float& s) {
  float inv = exp2f(-(float)j * 0.8304820237218405f);
  float ang = (float)pos * inv;
  double a = (double)ang;
  double k = rint(a * 0.15915494309189535);
  float r = (float)(a - k * 6.283185307179586);
  c = __cosf(r);
  s = __sinf(r);
}
DI int tok_pos(int t) { return (t < TP) ? (t % LP) - 16 : 2048 + ((t - TP) & 15); }

DI const float* x_src(const Params& p, int l, int t) {
  if (t < TP) {
    int b = t / LP, i = t - b * LP;
    if (i < 16) return (l == 0) ? p.in[I_META] + (size_t)i * 1024 : (const float*)(p.ws + WS_XMETA) + (size_t)(b * 16 + i) * 1024;
    return ((l == 0) ? p.in[I_XP] : (const float*)(p.out + O_YP)) + ((size_t)b * 4096 + (i - 16)) * 1024;
  }
  return ((l == 0) ? p.in[I_XS] : (const float*)(p.out + O_YS)) + (size_t)(t - TP) * 1024;
}
DI float* x_dst(const Params& p, int t) {
  if (t < TP) {
    int b = t / LP, i = t - b * LP;
    if (i < 16) return (float*)(p.ws + WS_XMETA) + (size_t)(b * 16 + i) * 1024;
    return p.out + O_YP + ((size_t)b * 4096 + (i - 16)) * 1024;
  }
  return p.out + O_YS + (size_t)(t - TP) * 1024;
}

DI void shifted16(const Params& p, int l, int t, int col, f32x4 (&out)[4]) {
  const u16* z = (const u16*)(p.ws + WS_Z);
  const u16* zc = z + (size_t)t * ZC + col;
  u32x4 c0 = *(const u32x4*)zc, c1 = *(const u32x4*)(zc + 8);
  f32x4 cur[4] = {unpack4(u32x2{c0.x, c0.y}), unpack4(u32x2{c0.z, c0.w}), unpack4(u32x2{c1.x, c1.y}), unpack4(u32x2{c1.z, c1.w})};
  f32x4 prv[4];
  bool first;
  int sb = 0;
  if (t < TP) first = (t % LP) == 0;
  else { int s = t - TP; sb = s >> 4; first = (s & 15) == 0; }
  if (!first) {
    u32x4 q0 = *(const u32x4*)(zc - ZC), q1 = *(const u32x4*)(zc - ZC + 8);
    prv[0] = unpack4(u32x2{q0.x, q0.y}); prv[1] = unpack4(u32x2{q0.z, q0.w});
    prv[2] = unpack4(u32x2{q1.x, q1.y}); prv[3] = unpack4(u32x2{q1.z, q1.w});
  } else if (t < TP) {
#pragma unroll
    for (int j = 0; j < 4; ++j) prv[j] = f32x4{0.f, 0.f, 0.f, 0.f};
  } else {
    const float* ss = p.in[I_SSHIFT] + ((size_t)l * 32 + sb) * 2176 + col;
#pragma unroll
    for (int j = 0; j < 4; ++j) prv[j] = ld4(ss + 4 * j);
  }
  const float* m0 = p.in[I_MIX] + ((size_t)l * 2 + 0) * 2176 + col;
  const float* m1 = p.in[I_MIX] + ((size_t)l * 2 + 1) * 2176 + col;
#pragma unroll
  for (int j = 0; j < 4; ++j) out[j] = cur[j] * ld4(m0 + 4 * j) + prv[j] * ld4(m1 + 4 * j);
}

DI Params load_params(const Params& k) {
  typedef const volatile unsigned long long __attribute__((address_space(4))) * kptr_t;
  kptr_t kp = (kptr_t)__builtin_amdgcn_kernarg_segment_ptr();
  Params q;
#pragma unroll
  for (int i = 0; i < 30; ++i) q.in[i] = (const float*)kp[i];
  q.out = (float*)kp[30];
  q.ws = (char*)kp[31];
  q.ph_lo = 0; q.ph_hi = 0;
  return q;
}

DI f32x4 shifted4(const Params& p, int l, int t, int col) {
  const u16* z = (const u16*)(p.ws + WS_Z);
  f32x4 cur = unpack4(*(const u32x2*)(z + (size_t)t * ZC + col));
  f32x4 prv;
  bool first;
  int sb = 0;
  if (t < TP) first = (t % LP) == 0;
  else { int s = t - TP; sb = s >> 4; first = (s & 15) == 0; }
  if (!first) prv = unpack4(*(const u32x2*)(z + (size_t)(t - 1) * ZC + col));
  else if (t < TP) prv = f32x4{0.f, 0.f, 0.f, 0.f};
  else prv = ld4(p.in[I_SSHIFT] + ((size_t)l * 32 + sb) * 2176 + col);
  f32x4 m0 = ld4(p.in[I_MIX] + ((size_t)l * 2 + 0) * 2176 + col);
  f32x4 m1 = ld4(p.in[I_MIX] + ((size_t)l * 2 + 1) * 2176 + col);
  return cur * m0 + prv * m1;
}

struct XcdMap { int xcc, rank, nlb, nx; };
DI int xcd_total(const XcdMap& xm, int MT, int NT, int& m_start, int& m_cnt) {
  const int base = MT / xm.nx, rem = MT - base * xm.nx;
  m_start = xm.xcc * base + (xm.xcc < rem ? xm.xcc : rem);
  m_cnt = base + (xm.xcc < rem ? 1 : 0);
  return m_cnt * NT;
}
DI void xcd_tile(int t, int m_start, int m_cnt, int NT, int& mtile, int& ntile) {
  const int band = t / (8 * NT);
  const int r = t - band * 8 * NT;
  int bh = m_cnt - band * 8;
  bh = bh < 8 ? bh : 8;
  const int ni = r / bh;
  mtile = m_start + band * 8 + (r - ni * bh);
  ntile = ni;
}

constexpr int LDA = 144;

DI void glds16(const void* g, char* l) {
  __builtin_amdgcn_global_load_lds((const __attribute__((address_space(1))) unsigned*)g, (LAS unsigned*)l, 16, 0, 0);
}
#define WAIT_V(n) asm volatile("s_waitcnt vmcnt(%0)" ::"n"(n) : "memory")
DI void raw_barrier() { asm volatile("s_waitcnt lgkmcnt(0)" ::: "memory"); __builtin_amdgcn_s_barrier(); }
DI int swz4(int q) { return (0x78 >> (2 * q)) & 3; }
template <int OFF> DI bf16x8 ldsr(unsigned a) {
  bf16x8 r;
  asm volatile("ds_read_b128 %0, %1 offset:%2" : "=v"(r) : "v"(a), "n"(OFF));
  return r;
}

template <int BM, int BN, int WR, int WC, int NSWAP, bool PERM = false>
DI void gemm_ring(const int tid_, const u16* __restrict__ Ab, int lda, const u16* __restrict__ Bt, int ldb, int brow_max, int nk,
                  char* s0, char* s1, char* s2, f32x4 (&acc)[BM / WR / 16][BN / WC / 16]) {
  constexpr int MT = BM / WR / 16, NT = BN / WC / 16;
  constexpr int WM = BM / WR, WN = BN / WC;
  constexpr int SA = BM * 64;
  constexpr int LA = BM / 64, LB = BN / 64, LPW = LA + LB;
  static_assert(SA + BN * 64 <= 24576, "stage too large");
  const int tid = tid_, lane = tid & 63, wave = tid >> 6;
  const int wr = wave / WC, wc = wave % WC;
  const int lrow = lane >> 2, lc = (lane & 3) ^ swz4(lane >> 4);
  const u16* ap = Ab + (size_t)(wave * 16 + lrow) * lda + lc * 8;
  const u16* bp[LB];
#pragma unroll
  for (int i = 0; i < LB; ++i) {
    int r = i * 64 + wave * 16 + lrow;
    if (PERM) {
      const int wcg = r / WN, np = r - wcg * WN;
      r = wcg * WN + ((np >> 2) & 3) * (WN / 4) + (np >> 4) * 4 + (np & 3);
    }
    r = r < brow_max ? r : brow_max;
    bp[i] = Bt + (size_t)r * ldb + lc * 8;
  }
#pragma unroll
  for (int mt = 0; mt < MT; ++mt)
#pragma unroll
    for (int nt = 0; nt < NT; ++nt) acc[mt][nt] = f32x4{0.f, 0.f, 0.f, 0.f};
  const int g = lane >> 4;
  const int fo = (lane & 15) * 64 + ((g ^ swz4((lane & 15) >> 2)) * 16);
  auto issue = [&](char* sa, int kt) {
    const int ko = kt * 32;
#pragma unroll
    for (int i = 0; i < LA; ++i) glds16(ap + (size_t)(i * 64) * lda + ko, sa + (i * 4 + wave) * 1024);
#pragma unroll
    for (int i = 0; i < LB; ++i) glds16(bp[i] + ko, sa + SA + (i * 4 + wave) * 1024);
  };
  auto step = [&](int kt, char* cur, char* nxt) {
    if (kt + 1 < nk) WAIT_V(LPW); else WAIT_V(0);
    raw_barrier();
    if (kt + 2 < nk) issue(nxt, kt + 2);
    const unsigned aA = (unsigned)(size_t)cur + (unsigned)((wr * WM) * 64 + fo);
    const unsigned aB = (unsigned)(size_t)cur + (unsigned)(SA + (wc * WN) * 64 + fo);
    bf16x8 xf[MT], wf[NT];
    xf[0] = ldsr<0>(aA);
    if constexpr (MT > 1) xf[1] = ldsr<1024>(aA);
    if constexpr (MT > 2) xf[2] = ldsr<2048>(aA);
    if constexpr (MT > 3) xf[3] = ldsr<3072>(aA);
    if constexpr (MT > 4) xf[4] = ldsr<4096>(aA);
    if constexpr (MT > 5) xf[5] = ldsr<5120>(aA);
    wf[0] = ldsr<0>(aB);
    if constexpr (NT > 1) wf[1] = ldsr<1024>(aB);
    if constexpr (NT > 2) wf[2] = ldsr<2048>(aB);
    if constexpr (NT > 3) wf[3] = ldsr<3072>(aB);
    if constexpr (NT > 4) wf[4] = ldsr<4096>(aB);
    if constexpr (NT > 5) wf[5] = ldsr<5120>(aB);
    if constexpr (NT > 6) wf[6] = ldsr<6144>(aB);
    if constexpr (NT > 7) wf[7] = ldsr<7168>(aB);
    constexpr int NH = NT / 2;
    asm volatile("s_waitcnt lgkmcnt(%0)" ::"n"(NT - NH) : "memory");
#pragma unroll
    for (int mt = 0; mt < MT; ++mt) asm volatile("" : "+v"(xf[mt]));
#pragma unroll
    for (int nt = 0; nt < NH; ++nt) asm volatile("" : "+v"(wf[nt]));
#pragma unroll
    for (int nt = 0; nt < NH; ++nt) {
#pragma unroll
      for (int mt = 0; mt < MT; ++mt) {
        if (nt < NSWAP) acc[mt][nt] = __builtin_amdgcn_mfma_f32_16x16x32_bf16(wf[nt], xf[mt], acc[mt][nt], 0, 0, 0);
        else acc[mt][nt] = __builtin_amdgcn_mfma_f32_16x16x32_bf16(xf[mt], wf[nt], acc[mt][nt], 0, 0, 0);
      }
    }
    asm volatile("s_waitcnt lgkmcnt(0)" ::: "memory");
#pragma unroll
    for (int nt = NH; nt < NT; ++nt) asm volatile("" : "+v"(wf[nt]));
#pragma unroll
    for (int nt = NH; nt < NT; ++nt) {
#pragma unroll
      for (int mt = 0; mt < MT; ++mt) {
        if (nt < NSWAP) acc[mt][nt] = __builtin_amdgcn_mfma_f32_16x16x32_bf16(wf[nt], xf[mt], acc[mt][nt], 0, 0, 0);
        else acc[mt][nt] = __builtin_amdgcn_mfma_f32_16x16x32_bf16(xf[mt], wf[nt], acc[mt][nt], 0, 0, 0);
      }
    }
  };
  WAIT_V(0);
  __syncthreads();
  issue(s0, 0);
  issue(s1, 1);
  for (int kt = 0; kt < nk; kt += 3) {
    step(kt, s0, s2);
    if (kt + 1 < nk) step(kt + 1, s1, s0);
    if (kt + 2 < nk) step(kt + 2, s2, s1);
  }
}

DI float sum4sq(f32x4 v) { return v[0] * v[0] + v[1] * v[1] + v[2] * v[2] + v[3] * v[3]; }

DI void transpose_job(const int tid_, const float* __restrict__ src, const float* __restrict__ scale, u16* __restrict__ dst, u16* __restrict__ dst2,
                      int K, int N, int kt, int nt, char* s0, char* s1, char* s2) {
  float* tile = (float*)s0;
  const int tid = tid_;
  __syncthreads();
#pragma unroll
  for (int i = 0; i < 16; ++i) {
    int kl = (tid >> 6) + 4 * i, nl = tid & 63;
    int k = kt * 64 + kl, n = nt * 64 + nl;
    tile[kl * 65 + nl] = (n < N) ? src[(size_t)k * N + n] : 0.f;
  }
  __syncthreads();
#pragma unroll
  for (int i = 0; i < 16; ++i) {
    int nl = (tid >> 6) + 4 * i, kl = tid & 63;
    int k = kt * 64 + kl, n = nt * 64 + nl;
    float v = tile[kl * 65 + nl];
    float sc = scale ? scale[k] : 1.f;
    dst[(size_t)n * K + k] = (u16)(pack2(v * sc, 0.f) & 0xffffu);
    if (dst2) dst2[(size_t)n * K + k] = (u16)(pack2(v, 0.f) & 0xffffu);
  }
}

DI void wprep_job(const int tid_, const Params& p, int l, int j, char* s0, char* s1, char* s2) {
  if (j < 1376) {
    transpose_job(tid_, p.in[I_WIN] + (size_t)l * 1024 * ZC, p.in[I_NORMW] + l * 1024, (u16*)(p.ws + WS_WIN) + (size_t)l * 5504 * 1024, nullptr,
                  1024, ZC, j / 86, j % 86, s0, s1, s2);
  } else if (j < 1384) {
    transpose_job(tid_, p.in[I_W2] + (size_t)l * 64 * 512, nullptr, (u16*)(p.ws + WS_W2) + (size_t)l * 512 * 64, nullptr, 64, 512, 0, j - 1376, s0, s1, s2);
  } else if (j < 1392) {
    transpose_job(tid_, p.in[I_A2] + (size_t)l * 64 * 512, nullptr, (u16*)(p.ws + WS_A2) + (size_t)l * 512 * 64, nullptr, 64, 512, 0, j - 1384, s0, s1, s2);
  } else if (j < 1464) {
    int q = j - 1392;
    transpose_job(tid_, p.in[I_WUQ] + (size_t)l * 384 * 768, p.in[I_QNORM] + l * 384, (u16*)(p.ws + WS_WUQ) + (size_t)l * 768 * 384, nullptr,
                  384, 768, q / 12, q % 12, s0, s1, s2);
  } else if (j < 1528) {
    int q = j - 1464;
    transpose_job(tid_, p.in[I_WUKV] + (size_t)l * 256 * 1024, p.in[I_KVNORM] + l * 256, (u16*)(p.ws + WS_WKVF) + (size_t)l * 1024 * 256,
                  (u16*)(p.ws + WS_WKVP) + (size_t)l * 1024 * 256, 256, 1024, q / 16, q % 16, s0, s1, s2);
  } else if (j < 1656) {
    int q = j - 1528;
    transpose_job(tid_, p.in[I_WA] + (size_t)l * 512 * 1024, nullptr, (u16*)(p.ws + WS_WA) + (size_t)l * 1024 * 512, nullptr, 512, 1024, q / 16, q % 16, s0, s1, s2);
  } else if (j < 1784) {
    int q = j - 1656;
    transpose_job(tid_, p.in[I_WB] + (size_t)l * 512 * 1024, nullptr, (u16*)(p.ws + WS_WB) + (size_t)l * 1024 * 512, nullptr, 512, 1024, q / 16, q % 16, s0, s1, s2);
  } else {
    int q = j - 1784;
    transpose_job(tid_, p.in[I_WOUT] + (size_t)l * 1024 * 1024, nullptr, (u16*)(p.ws + WS_WOUT) + (size_t)l * 1024 * 1024, nullptr, 1024, 1024, q / 16, q % 16, s0, s1, s2);
  }
}

DI void phase0(const int wv, const Params& p0, char* s0, char* s1, char* s2) {
  const Params p = load_params(p0);
  const int tid_ = opaque_tid(wv);
  if (opaque_bid() == 0 && tid_ < 64) ((unsigned*)(p.ws + WS_CTR))[tid_] = 0u;
  {
    u16* xb = (u16*)(p.ws + WS_XB);
#pragma unroll 1
    for (int job = opaque_bid(); job < T; job += gridDim.x) {
      const float* xs = x_src(p, 0, job);
      f32x4 xv = ld4(xs + tid_ * 4);
      *(u32x2*)(xb + (size_t)job * 1024 + tid_ * 4) = pack4(xv);
      float ss = sum4sq(xv);
#pragma unroll
      for (int m = 1; m < 64; m <<= 1) ss = xor_sum(ss, m);
      float* ssx = (float*)(p.ws + WS_SSX) + (size_t)job * 16;
      if ((tid_ & 63) == 0) ssx[tid_ >> 6] = ss;
      if (tid_ >= 4 && tid_ < 16) ssx[tid_] = 0.f;
    }
  }
#pragma unroll 1
  for (int j = opaque_bid(); j < 2040; j += gridDim.x) wprep_job(tid_, p, 0, j, s0, s1, s2);
}

DI void phase1(const XcdMap xm, const int wv, const Params& p0, int l, char* s0, char* s1, char* s2) {
  const Params p = load_params(p0);
  const int tid_ = opaque_tid(wv);
  const int tid = tid_, lane = tid & 63, wave = tid >> 6, g = lane >> 4, c16 = lane & 15;
  u16* z = (u16*)(p.ws + WS_Z);
  int m_start, m_cnt;
  const int total = xcd_total(xm, 261, 22, m_start, m_cnt);
#pragma unroll 1
  for (int t = xm.rank; t < total; t += xm.nlb) {
    int mtile, ntile;
    xcd_tile(t, m_start, m_cnt, 22, mtile, ntile);
    const int m0 = mtile * 128, n0 = ntile * 256;
    if (ntile == 21) {
      const int tl = opaque_tid(wv);
      const int lane = tl & 63, wave = tl >> 6, g = lane >> 4, c16 = lane & 15;
      f32x4 acc2[2][4];
      gemm_ring<128, 64, 4, 1, 4>(tl, (const u16*)(p.ws + WS_XB) + (size_t)m0 * 1024, 1024,
                                  (const u16*)(p.ws + WS_WIN) + ((size_t)l * 5504 + n0) * 1024, 1024, ZC - 1 - n0, 32, s0, s1, s2, acc2);
      const float* ssx = (const float*)(p.ws + WS_SSX);
#pragma unroll
      for (int mt = 0; mt < 2; ++mt) {
        const int m = m0 + wave * 32 + mt * 16 + c16;
        f32x4 s0_ = ld4(ssx + (size_t)m * 16), s1_ = ld4(ssx + (size_t)m * 16 + 4), s2_ = ld4(ssx + (size_t)m * 16 + 8), s3_ = ld4(ssx + (size_t)m * 16 + 12);
        f32x4 st = s0_ + s1_ + s2_ + s3_;
        const float rs = rsqrtf((st[0] + st[1] + st[2] + st[3]) * (1.f / 1024.f) + 1e-6f);
#pragma unroll
        for (int nt = 0; nt < 2; ++nt) {
          const int n = n0 + nt * 16 + g * 4;
          *(u32x2*)(z + (size_t)m * ZC + n) = pack4(acc2[mt][nt] * rs);
        }
      }
      continue;
    }
    f32x4 acc[4][8];
    gemm_ring<128, 256, 2, 2, 8, true>(tid_, (const u16*)(p.ws + WS_XB) + (size_t)m0 * 1024, 1024,
                               (const u16*)(p.ws + WS_WIN) + ((size_t)l * 5504 + n0) * 1024, 1024, ZC - 1 - n0, 32, s0, s1, s2, acc);
    const int wr = wave >> 1, wc = wave & 1;
    const float* ssx = (const float*)(p.ws + WS_SSX);
#pragma unroll
    for (int mt = 0; mt < 4; ++mt) {
      const int m = m0 + wr * 64 + mt * 16 + c16;
      f32x4 s0 = ld4(ssx + (size_t)m * 16), s1 = ld4(ssx + (size_t)m * 16 + 4), s2 = ld4(ssx + (size_t)m * 16 + 8), s3 = ld4(ssx + (size_t)m * 16 + 12);
      f32x4 st = s0 + s1 + s2 + s3;
      const float rs = rsqrtf((st[0] + st[1] + st[2] + st[3]) * (1.f / 1024.f) + 1e-6f);
      float psum = 0.f;
#pragma unroll
      for (int nt = 0; nt < 8; nt += 2) {
        const int n = n0 + wc * 128 + g * 32 + nt * 4;
        f32x4 v0 = acc[mt][nt] * rs, v1 = acc[mt][nt + 1] * rs;
        psum += sum4sq(v0) + sum4sq(v1);
        u32x2 a = pack4(v0), b = pack4(v1);
        *(u32x4*)(z + (size_t)m * ZC + n) = u32x4{a.x, a.y, b.x, b.y};
      }
      const bool isq = (ntile == 8 && wc == 1) || ntile == 9;
      if (isq || ntile == 10) {
        psum = xor_sum(psum, 16);
        psum = xor_sum(psum, 32);
        if (g == 0) {
          if (isq) ((float*)(p.ws + WS_SSQ))[(size_t)m * 8 + (ntile == 8 ? 0 : 1 + wc)] = psum;
          else ((float*)(p.ws + WS_SSKV))[(size_t)m * 4 + wc] = psum;
        }
      }
    }
  }
  {
    const float* srcp = p.in[I_CLAT] + (size_t)l * 65536 * 256;
    u16* dst = (u16*)(p.ws + WS_LATB);
    unsigned* cq = (unsigned*)(p.ws + WS_CTR) + 28 + l;
    int* sjob = (int*)(s2 + 24576 - 16);
    const int tq = opaque_tid(wv);
    while (true) {
      WAIT_V(0);
      __syncthreads();
      if (tq == 0) *sjob = (int)atomicAdd(cq, 1u);
      __syncthreads();
      const int j = *sjob;
      if (j >= 1024) break;
#pragma unroll 1
      for (int it = 0; it < 8; ++it) {
        const size_t e = (((size_t)j * 8 + it) * 256 + tq) * 8;
        f32x4 a = ld4(srcp + e), b = ld4(srcp + e + 4);
        u32x2 pa = pack4(a), pb = pack4(b);
        *(u32x4*)(dst + e) = u32x4{pa.x, pa.y, pb.x, pb.y};
      }
    }
  }
}

DI void rwkv_prep_tile(const int wv, const Params& p, int l, int mtile, int h, char* s0, char* s1, char* s2) {
  int tid = opaque_tid(wv);
  const u16* z = (const u16*)(p.ws + WS_Z);
  char* sAw = s0;
  char* sAa = s1;
  char* sBw = s2;
  char* sBa = s2 + 64 * LDA;
  const int t0 = mtile * 128;
  __syncthreads();
  {
    const int c8 = (tid & 15) * 8;
#pragma unroll 1
    for (int i = 0; i < 8; ++i) {
      const int row = (tid >> 4) + 16 * i;
      f32x4 a = shifted4(p, l, t0 + row, C_WL + c8);
      f32x4 b = shifted4(p, l, t0 + row, C_WL + c8 + 4);
      if (c8 < 64) {
#pragma unroll
        for (int e = 0; e < 4; ++e) { a[e] = tanhf_(a[e]); b[e] = tanhf_(b[e]); }
      }
      u32x2 pa = pack4(a), pb = pack4(b);
      char* dst = (c8 < 64 ? sAw : sAa) + row * LDA + (c8 & 63) * 2;
      *(u32x4*)dst = u32x4{pa.x, pa.y, pb.x, pb.y};
    }
    const u16* w2 = (const u16*)(p.ws + WS_W2) + ((size_t)l * 512 + h * 64) * 64;
    const u16* a2 = (const u16*)(p.ws + WS_A2) + ((size_t)l * 512 + h * 64) * 64;
#pragma unroll
    for (int i = 0; i < 2; ++i) {
      const int row = (tid >> 3) + 32 * i, ch = tid & 7;
      const int crow = ((row >> 2) & 3) * 16 + (row >> 4) * 4 + (row & 3);
      *(u32x4*)(sBw + row * LDA + ch * 16) = *(const u32x4*)(w2 + crow * 64 + ch * 8);
      *(u32x4*)(sBa + row * LDA + ch * 16) = *(const u32x4*)(a2 + crow * 64 + ch * 8);
    }
  }
  __syncthreads();
  tid = opaque_tid(wv);
  const int lane = tid & 63, wave = tid >> 6, g = lane >> 4, c16 = lane & 15;
  f32x4 accw[2][4], acca[2][4];
#pragma unroll
  for (int mt = 0; mt < 2; ++mt)
#pragma unroll
    for (int nt = 0; nt < 4; ++nt) { accw[mt][nt] = f32x4{0, 0, 0, 0}; acca[mt][nt] = f32x4{0, 0, 0, 0}; }
  const int fo = c16 * LDA + g * 16;
#pragma unroll
  for (int ks = 0; ks < 2; ++ks) {
    bf16x8 xw[2], xa[2], ww[4], wa[4];
#pragma unroll
    for (int mt = 0; mt < 2; ++mt) {
      xw[mt] = *(const bf16x8*)(sAw + (wave * 32 + mt * 16) * LDA + fo + ks * 64);
      xa[mt] = *(const bf16x8*)(sAa + (wave * 32 + mt * 16) * LDA + fo + ks * 64);
    }
#pragma unroll
    for (int nt = 0; nt < 4; ++nt) {
      ww[nt] = *(const bf16x8*)(sBw + (nt * 16) * LDA + fo + ks * 64);
      wa[nt] = *(const bf16x8*)(sBa + (nt * 16) * LDA + fo + ks * 64);
    }
#pragma unroll
    for (int mt = 0; mt < 2; ++mt)
#pragma unroll
      for (int nt = 0; nt < 4; ++nt) {
        accw[mt][nt] = __builtin_amdgcn_mfma_f32_16x16x32_bf16(ww[nt], xw[mt], accw[mt][nt], 0, 0, 0);
        acca[mt][nt] = __builtin_amdgcn_mfma_f32_16x16x32_bf16(wa[nt], xa[mt], acca[mt][nt], 0, 0, 0);
      }
  }
  float* DEC = (float*)(p.ws + WS_DEC);
  u16* R = (u16*)(p.ws + WS_R);
  u16* KM = (u16*)(p.ws + WS_KM);
  u16* V = (u16*)(p.ws + WS_V);
  u16* NKK = (u16*)(p.ws + WS_NKK);
  u16* KKA = (u16*)(p.ws + WS_KKA);
#pragma unroll
  for (int mt = 0; mt < 2; ++mt) {
    const int t = t0 + wave * 32 + mt * 16 + c16;
    const int cb = h * 64 + g * 16;
    const size_t o = (size_t)t * 512 + cb;
    f32x4 k4[4], kk[4];
    {
      f32x4 r4[4];
      shifted16(p, l, t, C_R + cb, r4);
      u32x2 a = pack4(r4[0]), b = pack4(r4[1]), c = pack4(r4[2]), d = pack4(r4[3]);
      *(u32x4*)(R + o) = u32x4{a.x, a.y, b.x, b.y};
      *(u32x4*)(R + o + 8) = u32x4{c.x, c.y, d.x, d.y};
    }
    {
      f32x4 v4[4];
      shifted16(p, l, t, C_V + cb, v4);
      u32x2 a = pack4(v4[0]), b = pack4(v4[1]), c = pack4(v4[2]), d = pack4(v4[3]);
      *(u32x4*)(V + o) = u32x4{a.x, a.y, b.x, b.y};
      *(u32x4*)(V + o + 8) = u32x4{c.x, c.y, d.x, d.y};
    }
    shifted16(p, l, t, C_K + cb, k4);
    float ssq = 0.f;
#pragma unroll
    for (int nt = 0; nt < 4; ++nt) {
      const int c = cb + nt * 4;
      f32x4 a0 = ld4(p.in[I_A0] + l * 512 + c), w0 = ld4(p.in[I_W0] + l * 512 + c);
      f32x4 a, dec;
#pragma unroll
      for (int e = 0; e < 4; ++e) {
        a[e] = sigmoidf_(a0[e] + acca[mt][nt][e]);
        float x = -(w0[e] + accw[mt][nt][e]);
        float sp = fmaxf(x, 0.f) + __logf(1.f + __expf(-fabsf(x)));
        float w = -sp - 0.5f;
        dec[e] = __expf(-__expf(w));
      }
      acca[mt][nt] = a;
      *(f32x4*)(DEC + o + nt * 4) = dec;
      f32x4 k_k = ld4(p.in[I_KK] + l * 512 + c);
      kk[nt] = k4[nt] * k_k;
      ssq += sum4sq(kk[nt]);
    }
    ssq = xor_sum(ssq, 16);
    ssq = xor_sum(ssq, 32);
    const float inv = rsqrtf(fmaxf(ssq, 1e-24f));
    u32x2 pn[4], pa[4], pk[4];
#pragma unroll
    for (int nt = 0; nt < 4; ++nt) {
      const int c = cb + nt * 4;
      f32x4 k_a = ld4(p.in[I_KA] + l * 512 + c);
      f32x4 kn = kk[nt] * inv;
      f32x4 av = acca[mt][nt];
      f32x4 one = f32x4{1.f, 1.f, 1.f, 1.f};
      pn[nt] = pack4(-kn);
      pa[nt] = pack4(kn * av);
      pk[nt] = pack4(k4[nt] * (one + (av - one) * k_a));
    }
    *(u32x4*)(NKK + o) = u32x4{pn[0].x, pn[0].y, pn[1].x, pn[1].y};
    *(u32x4*)(NKK + o + 8) = u32x4{pn[2].x, pn[2].y, pn[3].x, pn[3].y};
    *(u32x4*)(KKA + o) = u32x4{pa[0].x, pa[0].y, pa[1].x, pa[1].y};
    *(u32x4*)(KKA + o + 8) = u32x4{pa[2].x, pa[2].y, pa[3].x, pa[3].y};
    *(u32x4*)(KM + o) = u32x4{pk[0].x, pk[0].y, pk[1].x, pk[1].y};
    *(u32x4*)(KM + o + 8) = u32x4{pk[2].x, pk[2].y, pk[3].x, pk[3].y};
    __builtin_amdgcn_sched_barrier(0);
  }
}

DI void q_tile(const int tid_, const Params& p, int l, int mtile, int h, char* s0, char* s1, char* s2) {
  const int tid = tid_, lane = tid & 63, wave = tid >> 6, g = lane >> 4, c16 = lane & 15;
  const int m0 = mtile * 128;
  f32x4 acc[2][8];
  gemm_ring<128, 128, 4, 1, 8>(tid_, (const u16*)(p.ws + WS_Z) + (size_t)m0 * ZC + C_QC, ZC,
                             (const u16*)(p.ws + WS_WUQ) + ((size_t)l * 768 + h * 96) * 384, 384, 767 - h * 96, 12, s0, s1, s2, acc);
  u16* Q = (u16*)(p.ws + WS_Q);
  const float qscale = 0.14724576f;
#pragma unroll
  for (int mt = 0; mt < 2; ++mt) {
    const int ml = wave * 32 + mt * 16 + c16;
    const int t = m0 + ml;
    float rs;
    {
      const float* sq = (const float*)(p.ws + WS_SSQ) + (size_t)t * 8;
      rs = rsqrtf((sq[0] + sq[1] + sq[2]) * (1.f / 384.f) + 1e-6f);
    }
    float ssn = 0.f, ssr = 0.f;
#pragma unroll
    for (int nt = 0; nt < 6; ++nt) {
      acc[mt][nt] *= rs;
      float s = acc[mt][nt][0] * acc[mt][nt][0] + acc[mt][nt][1] * acc[mt][nt][1] + acc[mt][nt][2] * acc[mt][nt][2] + acc[mt][nt][3] * acc[mt][nt][3];
      if (nt < 4) ssn += s; else ssr += s;
    }
    ssn = xor_sum(ssn, 16); ssn = xor_sum(ssn, 32);
    ssr = xor_sum(ssr, 16); ssr = xor_sum(ssr, 32);
    const float rn = rsqrtf(ssn * (1.f / 64.f) + 1e-6f) * qscale;
    const float rr = rsqrtf(ssr * (1.f / 32.f) + 1e-6f) * qscale;
    u16* qrow = Q + (size_t)t * 768 + h * 96;
#pragma unroll
    for (int nt = 0; nt < 4; ++nt) {
      const int n = nt * 16 + g * 4;
      f32x4 gw = ld4(p.in[I_QNN] + l * 64 + n);
      *(u32x2*)(qrow + n) = pack4(acc[mt][nt] * gw * rn);
    }
    const int pos = tok_pos(t);
    const int j0 = g * 4;
    f32x4 g1 = ld4(p.in[I_QNR] + l * 32 + j0), g2 = ld4(p.in[I_QNR] + l * 32 + 16 + j0);
    f32x4 o1, o2;
#pragma unroll
    for (int e = 0; e < 4; ++e) {
      float c, s;
      rope_cs(pos, j0 + e, c, s);
      float x1 = acc[mt][4][e] * g1[e] * rr, x2 = acc[mt][5][e] * g2[e] * rr;
      o1[e] = x1 * c - x2 * s;
      o2[e] = x1 * s + x2 * c;
    }
    *(u32x2*)(qrow + 64 + j0) = pack4(o1);
    *(u32x2*)(qrow + 80 + j0) = pack4(o2);
  }
}

DI void kv_tile(const int tid_, const Params& p, int l, int mtile, int h, char* s0, char* s1, char* s2) {
  const int tid = tid_, lane = tid & 63, wave = tid >> 6, g = lane >> 4, c16 = lane & 15;
  f32x4 acc[2][8];
  const bool past = mtile >= 261;
  const int m0 = past ? (mtile - 261) * 128 : mtile * 128;
  if (!past) {
    gemm_ring<128, 128, 4, 1, 4>(tid_, (const u16*)(p.ws + WS_Z) + (size_t)m0 * ZC + C_CKV, ZC,
                               (const u16*)(p.ws + WS_WKVF) + ((size_t)l * 1024 + h * 128) * 256, 256, 127, 8, s0, s1, s2, acc);
  } else {
    gemm_ring<128, 128, 4, 1, 4>(tid_, (const u16*)(p.ws + WS_LATB) + (size_t)m0 * 256, 256,
                               (const u16*)(p.ws + WS_WKVP) + ((size_t)l * 1024 + h * 128) * 256, 256, 127, 8, s0, s1, s2, acc);
  }
  u16 *KN, *VT;
  int skv;
  if (!past && m0 < TP) { KN = (u16*)(p.ws + WS_KP); VT = (u16*)(p.ws + WS_VTP); skv = LP; }
  else { KN = (u16*)(p.ws + WS_KS); VT = (u16*)(p.ws + WS_VTS); skv = SK; }
#pragma unroll
  for (int mt = 0; mt < 2; ++mt) {
    {
      const int ml = wave * 32 + mt * 16 + c16;
      const int r = m0 + ml;
      float rs = 1.f;
      if (!past) { f32x4 s0 = ld4((const float*)(p.ws + WS_SSKV) + (size_t)r * 4); rs = rsqrtf((s0[0] + s0[1]) * (1.f / 256.f) + 1e-6f); }
      size_t krow;
      if (past) krow = (size_t)(r >> 11) * SK + (r & 2047);
      else if (r < TP) krow = r;
      else { int s = r - TP; krow = (size_t)(s >> 4) * SK + 2048 + (s & 15); }
      float ss = 0.f;
#pragma unroll
      for (int nt = 0; nt < 4; ++nt) {
        acc[mt][nt] *= rs;
        ss += acc[mt][nt][0] * acc[mt][nt][0] + acc[mt][nt][1] * acc[mt][nt][1] + acc[mt][nt][2] * acc[mt][nt][2] + acc[mt][nt][3] * acc[mt][nt][3];
      }
      ss = xor_sum(ss, 16); ss = xor_sum(ss, 32);
      const float rn = rsqrtf(ss * (1.f / 64.f) + 1e-6f);
#pragma unroll
      for (int nt = 0; nt < 4; ++nt) {
        const int n = nt * 16 + g * 4;
        f32x4 gw = ld4(p.in[I_KNN] + l * 64 + n);
        *(u32x2*)(KN + krow * 512 + h * 64 + n) = pack4(acc[mt][nt] * gw * rn);
      }
    }
    {
      const int mlb = wave * 32 + mt * 16 + g * 4;
      const int r = m0 + mlb;
      f32x4 rs4 = f32x4{1.f, 1.f, 1.f, 1.f};
      if (!past) {
        const float* sk = (const float*)(p.ws + WS_SSKV) + (size_t)r * 4;
#pragma unroll
        for (int e = 0; e < 4; ++e) { f32x4 s0 = ld4(sk + e * 4); rs4[e] = rsqrtf((s0[0] + s0[1]) * (1.f / 256.f) + 1e-6f); }
      }
      size_t vrow;
      if (past) vrow = ((size_t)((r >> 11) * 8 + h) * 64) * SK + (r & 2047);
      else if (r < TP) { int b = r / LP; vrow = ((size_t)(b * 8 + h) * 64) * LP + (r - b * LP); }
      else { int s = r - TP; vrow = ((size_t)((s >> 4) * 8 + h) * 64) * SK + 2048 + (s & 15); }
#pragma unroll
      for (int nt = 4; nt < 8; ++nt) {
        const int dv = (nt - 4) * 16 + c16;
        *(u32x2*)(VT + vrow + (size_t)dv * skv) = pack4(acc[mt][nt] * rs4);
      }
    }
  }
}

DI void lat_job(const int tid_, const Params& p, int l, int job) {
  const int tid = tid_, lane = tid & 63, wave = tid >> 6;
  const u16* z = (const u16*)(p.ws + WS_Z);
  for (int q = 0; q < 8; ++q) {
    const int t = job * 32 + wave * 8 + q;
    float* lat_out; float* kr_out; u16* kr_bf;
    if (t < TP) {
      int b = t / LP, i = t - b * LP;
      lat_out = p.out + O_LATP + ((size_t)(l * 8 + b) * LP + i) * 256;
      kr_out = p.out + O_KRP + ((size_t)(l * 8 + b) * LP + i) * 32;
      kr_bf = (u16*)(p.ws + WS_KRP) + (size_t)t * 32;
    } else {
      int s = t - TP, sb = s >> 4, j = s & 15;
      lat_out = p.out + O_LATN + ((size_t)(l * 32 + sb) * 16 + j) * 256;
      kr_out = p.out + O_KRN + ((size_t)(l * 32 + sb) * 16 + j) * 32;
      kr_bf = (u16*)(p.ws + WS_KRS) + ((size_t)sb * SK + 2048 + j) * 32;
    }
    f32x4 x = unpack4(*(const u32x2*)(z + (size_t)t * ZC + C_CKV + lane * 4));
    float ss = x[0] * x[0] + x[1] * x[1] + x[2] * x[2] + x[3] * x[3];
#pragma unroll
    for (int m = 1; m < 64; m <<= 1) ss = xor_sum(ss, m);
    float rs = rsqrtf(ss * (1.f / 256.f) + 1e-6f);
    f32x4 gw = ld4(p.in[I_KVNORM] + l * 256 + lane * 4);
    *(f32x4*)(lat_out + lane * 4) = x * rs * gw;
    float x1 = 0.f, x2 = 0.f;
    if (lane < 16) { x1 = bf2f(z[(size_t)t * ZC + C_KR + lane]); x2 = bf2f(z[(size_t)t * ZC + C_KR + 16 + lane]); }
    float s2 = x1 * x1 + x2 * x2;
#pragma unroll
    for (int m = 1; m < 64; m <<= 1) s2 = xor_sum(s2, m);
    float r2 = rsqrtf(s2 * (1.f / 32.f) + 1e-6f);
    if (lane < 16) {
      float y1 = x1 * r2 * p.in[I_KNR][l * 32 + lane], y2 = x2 * r2 * p.in[I_KNR][l * 32 + 16 + lane];
      float c, s;
      rope_cs(tok_pos(t), lane, c, s);
      float o1 = y1 * c - y2 * s, o2 = y1 * s + y2 * c;
      kr_out[lane] = o1; kr_out[16 + lane] = o2;
      kr_bf[lane] = (u16)(pack2(o1, 0.f) & 0xffffu);
      kr_bf[16 + lane] = (u16)(pack2(o2, 0.f) & 0xffffu);
    }
  }
}
DI void pastkr_job(const int tid_, const Params& p, int l, int job) {
  const int tid = tid_;
  const int r = job * 64 + (tid >> 2), c = (tid & 3) * 8;
  const float* src = p.in[I_CKR] + ((size_t)l * 65536 + r) * 32 + c;
  f32x4 a = ld4(src), b = ld4(src + 4);
  u32x2 pa = pack4(a), pb = pack4(b);
  u16* dst = (u16*)(p.ws + WS_KRS) + ((size_t)(r >> 11) * SK + (r & 2047)) * 32 + c;
  *(u32x4*)dst = u32x4{pa.x, pa.y, pb.x, pb.y};
}
DI void shiftrow_job(const int tid_, const Params& p, int l, int job) {
  const u16* z = (const u16*)(p.ws + WS_Z);
  int t; float* dst;
  if (job < 8) { t = job * LP + LP - 1; dst = p.out + O_SHP + (size_t)(l * 8 + job) * 2176; }
  else { int sb = job - 8; t = TP + sb * 16 + 15; dst = p.out + O_SHS + (size_t)(l * 32 + sb) * 2176; }
  for (int c = tid_; c < 2176; c += 256) dst[c] = bf2f(z[(size_t)t * ZC + c]);
}

DI void phase2(const XcdMap xm, const int wv, const Params& p0, int l, char* s0, char* s1, char* s2, int mask = 12) {
  if (mask & 4) { const int tid_ = opaque_tid(wv); const Params p = load_params(p0);
    int m_start, m_cnt; const int total = xcd_total(xm, 261, 8, m_start, m_cnt);
    for (int t = xm.rank; t < total; t += xm.nlb) { int mt_, nt_; xcd_tile(t, m_start, m_cnt, 8, mt_, nt_); rwkv_prep_tile(wv, p, l, mt_, nt_, s0, s1, s2); } }
  if (mask & 8) { const int tid_ = opaque_tid(wv); const Params p = load_params(p0);
#pragma unroll 1
    for (int job = opaque_bid(); job < 1044; job += gridDim.x) lat_job(tid_, p, l, job);
#pragma unroll 1
    for (int job = opaque_bid(); job < 1024; job += gridDim.x) pastkr_job(tid_, p, l, job);
#pragma unroll 1
    for (int job = opaque_bid(); job < 40; job += gridDim.x) shiftrow_job(tid_, p, l, job);
    if (l < 3) {
      unsigned* wq = (unsigned*)(p.ws + WS_CTR) + 24 + l;
      int* sjob = (int*)(s2 + 24576 - 16);
      while (true) {
        __syncthreads();
        if (tid_ == 0) *sjob = (int)atomicAdd(wq, 1u);
        __syncthreads();
        const int j = *sjob;
        if (j >= 2040) break;
        wprep_job(opaque_tid(wv), p, l + 1, j, s0, s1, s2);
      }
    } }
}

DI float row_allreduce(float x) {
  x += __int_as_float(__builtin_amdgcn_update_dpp(0, __float_as_int(x), 0x128, 0xf, 0xf, false));
  x += __int_as_float(__builtin_amdgcn_update_dpp(0, __float_as_int(x), 0x124, 0xf, 0xf, false));
  x += __int_as_float(__builtin_amdgcn_update_dpp(0, __float_as_int(x), 0x122, 0xf, 0xf, false));
  x += __int_as_float(__builtin_amdgcn_update_dpp(0, __float_as_int(x), 0x121, 0xf, 0xf, false));
  return x;
}

struct ScanRegs { f32x4 d; u32x4 a0, a1; u16 v; };

DI void scan_gload(const int tid_, ScanRegs& r, const Params& p, int tokc, int h, int rg) {
  const int tid = tid_;
  const float* DEC = (const float*)(p.ws + WS_DEC);
  const u16* V = (const u16*)(p.ws + WS_V);
  {
    int st = tid >> 4, c = tid & 15;
    r.d = ld4(DEC + (size_t)(tokc + st) * 512 + h * 64 + c * 4);
    r.v = V[(size_t)(tokc + st) * 512 + h * 64 + rg * 16 + c];
  }
  {
    int arr = tid >> 7, idx = tid & 127, st = idx >> 3, c8 = idx & 7;
    size_t off = (size_t)(tokc + st) * 512 + h * 64 + c8 * 8;
    const u16* s0 = (const u16*)(p.ws + (arr ? WS_KKA : WS_NKK));
    const u16* s1 = (const u16*)(p.ws + (arr ? WS_R : WS_KM));
    r.a0 = *(const u32x4*)(s0 + off);
    r.a1 = *(const u32x4*)(s1 + off);
  }
}
DI void scan_lstore(const int tid_, const ScanRegs& r, float* buf) {
  const int tid = tid_;
  {
    int st = tid >> 4, c = tid & 15;
    *(f32x4*)(buf + st * 64 + c * 4) = r.d;
    buf[5120 + st * 16 + c] = bf2f(r.v);
  }
  {
    int arr = tid >> 7, idx = tid & 127, st = idx >> 3, c8 = idx & 7;
    float* d0 = buf + 1024 + arr * 1024 + st * 64 + c8 * 8;
    float* d1 = buf + 3072 + arr * 1024 + st * 64 + c8 * 8;
    *(f32x4*)(d0) = unpack4(u32x2{r.a0.x, r.a0.y});
    *(f32x4*)(d0 + 4) = unpack4(u32x2{r.a0.z, r.a0.w});
    *(f32x4*)(d1) = unpack4(u32x2{r.a1.x, r.a1.y});
    *(f32x4*)(d1 + 4) = unpack4(u32x2{r.a1.z, r.a1.w});
  }
}

template <int CTRL> DI float dpp_get(float x) { return __int_as_float(__builtin_amdgcn_update_dpp(0, __float_as_int(x), CTRL, 0xf, 0xf, false)); }
DI void scan_chunk(const float* buf, f32x4& S, int w, int rw, int kg, float& ys) {
  float yp[16];
#pragma unroll
  for (int s = 0; s < 16; ++s) {
    const float* b = buf + s * 64 + kg * 4;
    f32x4 d = *(const f32x4*)(b), n = *(const f32x4*)(b + 1024), a = *(const f32x4*)(b + 2048), k = *(const f32x4*)(b + 3072),
          r = *(const f32x4*)(b + 4096);
    float vv = buf[5120 + s * 16 + w * 4 + rw];
    float pp = S[0] * n[0];
    pp = fmaf(S[1], n[1], pp); pp = fmaf(S[2], n[2], pp); pp = fmaf(S[3], n[3], pp);
    float sa = row_allreduce(pp);
#pragma unroll
    for (int e = 0; e < 4; ++e) S[e] = fmaf(sa, a[e], fmaf(S[e], d[e], vv * k[e]));
    float y = S[0] * r[0];
    y = fmaf(S[1], r[1], y); y = fmaf(S[2], r[2], y); y = fmaf(S[3], r[3], y);
    yp[s] = y;
  }
  const bool b3 = (kg & 8) != 0, b2 = (kg & 4) != 0, b1 = (kg & 2) != 0, b0 = (kg & 1) != 0;
  float t[8], u[4], v2[2];
#pragma unroll
  for (int j = 0; j < 8; ++j) { float keep = b3 ? yp[j + 8] : yp[j], send = b3 ? yp[j] : yp[j + 8]; t[j] = keep + dpp_get<0x140>(send); }
#pragma unroll
  for (int j = 0; j < 4; ++j) { float keep = b2 ? t[j + 4] : t[j], send = b2 ? t[j] : t[j + 4]; u[j] = keep + dpp_get<0x141>(send); }
#pragma unroll
  for (int j = 0; j < 2; ++j) { float keep = b1 ? u[j + 2] : u[j], send = b1 ? u[j] : u[j + 2]; v2[j] = keep + dpp_get<0x4E>(send); }
  { float keep = b0 ? v2[1] : v2[0], send = b0 ? v2[0] : v2[1]; ys = keep + dpp_get<0xB1>(send); }
}

DI void scan_job(const int tid_, const Params& p, int l, int job, char* s0, char* s1, char* s2) {
  const int tid = tid_, lane = tid & 63, w = tid >> 6, rw = lane >> 4, kg = lane & 15;
  int h, tok0, nchunks, rg;
  float* sout;
  f32x4 S;
  rg = job & 3;
  const int row = rg * 16 + w * 4 + rw;
  if (job < 256) {
    int seq = job >> 2, b = seq >> 3; h = seq & 7;
    tok0 = b * LP; nchunks = LP / 16;
    sout = p.out + O_SRP + ((((size_t)l * 8 + b) * 8 + h) * 64 + row) * 64 + kg * 4;
    S = f32x4{0.f, 0.f, 0.f, 0.f};
  } else {
    int seq = (job - 256) >> 2, sb = seq >> 3; h = seq & 7;
    tok0 = TP + sb * 16; nchunks = 1;
    sout = p.out + O_SRS + ((((size_t)l * 32 + sb) * 8 + h) * 64 + row) * 64 + kg * 4;
    S = ld4(p.in[I_SRWKV] + ((((size_t)l * 32 + sb) * 8 + h) * 64 + row) * 64 + kg * 4);
  }
  float* buf0 = (float*)s0;
  float* buf1 = (float*)s1;
  float* Y = p.out + O_YP;
  ScanRegs A, B;
  __syncthreads();
  __builtin_amdgcn_s_setprio(3);
  scan_gload(tid_, A, p, tok0, h, rg);
  scan_lstore(tid_, A, buf0);
  if (nchunks > 1) scan_gload(tid_, A, p, tok0 + 16, h, rg);
  __syncthreads();
  for (int c = 0; c < nchunks; c += 2) {
    if (c + 2 < nchunks) scan_gload(tid_, B, p, tok0 + (c + 2) * 16, h, rg);
    float ys = 0.f;
    scan_chunk(buf0, S, w, rw, kg, ys);
    Y[(size_t)(tok0 + c * 16 + kg) * 512 + h * 64 + row] = ys;
    if (c + 1 < nchunks) scan_lstore(tid_, A, buf1);
    __syncthreads();
    if (c + 1 < nchunks) {
      if (c + 3 < nchunks) scan_gload(tid_, A, p, tok0 + (c + 3) * 16, h, rg);
      ys = 0.f;
      scan_chunk(buf1, S, w, rw, kg, ys);
      Y[(size_t)(tok0 + (c + 1) * 16 + kg) * 512 + h * 64 + row] = ys;
      if (c + 2 < nchunks) scan_lstore(tid_, B, buf0);
      __syncthreads();
    }
  }
  *(f32x4*)sout = S;
  __builtin_amdgcn_s_setprio(0);
}

DI void attn_item(const int tid_, const Params& p, int l, int item, char* s0, char* s1, char* s2) {
  const int tid = tid_, lane = tid & 63, w = tid >> 6, g = lane >> 4, c16 = lane & 15;
  int h, qtok0, nq, ntiles, vis, kmode, skv;
  const u16 *KN, *KR, *VT;
  if (item < 256) {
    int sb = item >> 3; h = item & 7;
    qtok0 = TP + sb * 16; nq = 16; ntiles = 33; vis = (w == 0) ? 33 : 0; kmode = 1; skv = SK;
    KN = (const u16*)(p.ws + WS_KS) + (size_t)sb * SK * 512;
    KR = (const u16*)(p.ws + WS_KRS) + (size_t)sb * SK * 32;
    VT = (const u16*)(p.ws + WS_VTS) + (size_t)(sb * 8 + h) * 64 * SK;
  } else {
    int b;
    if (item < 2304) {
      int idx = item - 256, m = 31 - (idx >> 6), bh = idx & 63;
      b = bh >> 3; h = bh & 7;
      qtok0 = b * LP + 16 + 128 * m; nq = 128; ntiles = 2 * m + 3; vis = (w < 2) ? 2 * m + 2 : 2 * m + 3;
    } else {
      int bh = item - 2304;
      b = bh >> 3; h = bh & 7;
      qtok0 = b * LP; nq = 16; ntiles = 1; vis = (w == 0) ? 1 : 0;
    }
    kmode = 0; skv = LP;
    KN = (const u16*)(p.ws + WS_KP) + (size_t)b * LP * 512;
    KR = (const u16*)(p.ws + WS_KRP) + (size_t)b * LP * 32;
    VT = (const u16*)(p.ws + WS_VTP) + (size_t)(b * 8 + h) * 64 * LP;
  }
  const u16* Q = (const u16*)(p.ws + WS_Q);
  bf16x8 qf[2][3];
#pragma unroll
  for (int nt = 0; nt < 2; ++nt) {
    int ql = w * 32 + nt * 16 + c16;
    ql = ql < nq ? ql : nq - 1;
#pragma unroll
    for (int ks = 0; ks < 3; ++ks) qf[nt][ks] = *(const bf16x8*)(Q + (size_t)(qtok0 + ql) * 768 + h * 96 + ks * 32 + g * 8);
  }
  u32x4 kr[3], vr[2];
  auto tile_info = [&](int kt, int& key0, int& nvalid) {
    if (kmode == 0) { if (kt == 0) { key0 = 0; nvalid = 16; } else { key0 = 16 + 64 * (kt - 1); nvalid = 64; } }
    else { key0 = 64 * kt; nvalid = (kt == 32) ? 16 : 64; }
  };
  auto gload = [&](int kt) {
    int key0, nvalid;
    tile_info(kt, key0, nvalid);
#pragma unroll
    for (int i = 0; i < 3; ++i) {
      int idx = tid + 256 * i, row = idx / 12, ch = idx - row * 12;
      const u16* src = (ch < 8) ? KN + (size_t)(key0 + row) * 512 + h * 64 + ch * 8 : KR + (size_t)(key0 + row) * 32 + (ch - 8) * 8;
      kr[i] = (row < nvalid) ? *(const u32x4*)src : u32x4{0, 0, 0, 0};
    }
#pragma unroll
    for (int i = 0; i < 2; ++i) {
      int idx = tid + 256 * i, dv = idx >> 3, ch = idx & 7;
      vr[i] = (ch * 8 < nvalid) ? *(const u32x4*)(VT + (size_t)dv * skv + key0 + ch * 8) : u32x4{0, 0, 0, 0};
    }
  };
  auto lstore = [&](char* buf) {
#pragma unroll
    for (int i = 0; i < 3; ++i) {
      int idx = tid + 256 * i, row = idx / 12, ch = idx - row * 12;
      *(u32x4*)(buf + row * 208 + ch * 16) = kr[i];
    }
#pragma unroll
    for (int i = 0; i < 2; ++i) {
      int idx = tid + 256 * i, dv = idx >> 3, ch = idx & 7;
      *(u32x4*)(buf + 64 * 208 + dv * LDA + ch * 16) = vr[i];
    }
  };
  constexpr int BUFSZ = 64 * 208 + 64 * LDA;
  f32x4 o[4][2];
  float mrow[2], lsum[2];
#pragma unroll
  for (int nt = 0; nt < 2; ++nt) {
    mrow[nt] = -1e30f; lsum[nt] = 0.f;
#pragma unroll
    for (int dt = 0; dt < 4; ++dt) o[dt][nt] = f32x4{0, 0, 0, 0};
  }
  __syncthreads();
  gload(0);
  lstore(s0);
  if (ntiles > 1) gload(1);
  __syncthreads();
  for (int kt = 0; kt < ntiles; ++kt) {
    char* cur = (kt & 1) ? s1 : s0;
    if (kt + 1 < ntiles) {
      lstore(((kt + 1) & 1) ? s1 : s0);
      if (kt + 2 < ntiles) gload(kt + 2);
    }
    if (kt < vis) {
      int key0, nvalid;
      tile_info(kt, key0, nvalid);
      f32x4 s[4][2];
#pragma unroll
      for (int mt = 0; mt < 4; ++mt)
#pragma unroll
        for (int nt = 0; nt < 2; ++nt) s[mt][nt] = f32x4{0, 0, 0, 0};
#pragma unroll
      for (int ks = 0; ks < 3; ++ks)
#pragma unroll
        for (int mt = 0; mt < 4; ++mt) {
          bf16x8 kf = *(const bf16x8*)(cur + (mt * 16 + c16) * 208 + ks * 64 + g * 16);
#pragma unroll
          for (int nt = 0; nt < 2; ++nt) s[mt][nt] = __builtin_amdgcn_mfma_f32_16x16x32_bf16(kf, qf[nt][ks], s[mt][nt], 0, 0, 0);
        }
      if (nvalid < 64) {
#pragma unroll
        for (int mt = 0; mt < 4; ++mt)
#pragma unroll
          for (int nt = 0; nt < 2; ++nt)
#pragma unroll
            for (int e = 0; e < 4; ++e)
              if (mt * 16 + g * 4 + e >= nvalid) s[mt][nt][e] = -1e30f;
      }
      bf16x8 pf[2][2];
#pragma unroll
      for (int nt = 0; nt < 2; ++nt) {
        float mx = -1e30f;
#pragma unroll
        for (int mt = 0; mt < 4; ++mt)
#pragma unroll
          for (int e = 0; e < 4; ++e) mx = fmaxf(mx, s[mt][nt][e]);
        mx = xmax16(mx);
        mx = xmax32(mx);
        const float mnew = fmaxf(mrow[nt], mx);
        const float alpha = __builtin_amdgcn_exp2f(mrow[nt] - mnew);
        mrow[nt] = mnew;
        float ps = 0.f;
#pragma unroll
        for (int mt = 0; mt < 4; ++mt)
#pragma unroll
          for (int e = 0; e < 4; ++e) {
            float pv = __builtin_amdgcn_exp2f(s[mt][nt][e] - mnew);
            s[mt][nt][e] = pv;
            ps += pv;
          }
        lsum[nt] = lsum[nt] * alpha + ps;
        if (__builtin_amdgcn_ballot_w64(alpha != 1.f) != 0ull) {
#pragma unroll
          for (int dt = 0; dt < 4; ++dt) o[dt][nt] *= alpha;
        }
#pragma unroll
        for (int kk = 0; kk < 2; ++kk) {
          u32x2 lo = pack4(s[2 * kk][nt]), hi = pack4(s[2 * kk + 1][nt]);
          u32x4 pk = u32x4{lo.x, lo.y, hi.x, hi.y};
          pf[nt][kk] = __builtin_bit_cast(bf16x8, pk);
        }
      }
      const char* sV = cur + 64 * 208;
#pragma unroll
      for (int dt = 0; dt < 4; ++dt)
#pragma unroll
        for (int kk = 0; kk < 2; ++kk) {
          u32x2 lo = *(const u32x2*)(sV + (dt * 16 + c16) * LDA + (kk * 32 + g * 4) * 2);
          u32x2 hi = *(const u32x2*)(sV + (dt * 16 + c16) * LDA + (kk * 32 + 16 + g * 4) * 2);
          u32x4 pk = u32x4{lo.x, lo.y, hi.x, hi.y};
          bf16x8 vf = __builtin_bit_cast(bf16x8, pk);
#pragma unroll
          for (int nt = 0; nt < 2; ++nt) o[dt][nt] = __builtin_amdgcn_mfma_f32_16x16x32_bf16(vf, pf[nt][kk], o[dt][nt], 0, 0, 0);
        }
    }
    __syncthreads();
  }
  const u16* z = (const u16*)(p.ws + WS_Z);
  u16* YB = (u16*)(p.ws + WS_YB);
#pragma unroll
  for (int nt = 0; nt < 2; ++nt) {
    float lt = lsum[nt];
    lt = xsum16(lt);
    lt = xsum32(lt);
    const int ql = w * 32 + nt * 16 + c16;
    if (ql < nq && vis > 0) {
      const float il = 1.f / lt;
      const int tok = qtok0 + ql;
#pragma unroll
      for (int dt = 0; dt < 4; ++dt) {
        const int dv = dt * 16 + g * 4;
        f32x4 gt = unpack4(*(const u32x2*)(z + (size_t)tok * ZC + C_GB + h * 64 + dv));
        f32x4 ov = o[dt][nt] * il;
#pragma unroll
        for (int e = 0; e < 4; ++e) ov[e] *= siluf_(gt[e]);
        *(u32x2*)(YB + (size_t)tok * 512 + h * 64 + dv) = pack4(ov);
      }
    }
  }
}

DI void phase3(const int wv, const Params& p0, int l, char* s0, char* s1, char* s2, int coff, int mode = 0) {
  const Params p = load_params(p0);
  const int tid_ = opaque_tid(wv);
  unsigned* ctr = (unsigned*)(p.ws + WS_CTR) + l + coff;
  unsigned* done = (unsigned*)(p.ws + WS_CTR) + 8 + l + coff;
  unsigned* scanq = (unsigned*)(p.ws + WS_CTR) + 16 + l + coff;
  int* sjob = (int*)(s2 + 24576 - 16);
  __syncthreads();
  if (tid_ == 0) {
    const unsigned hw = (unsigned)__builtin_amdgcn_s_getreg((31 << 11) | 4);
    const unsigned key = ((xb_xcc_id_early() & 15u) << 8) | ((hw >> 8) & 0xffu);
    unsigned* cue = (unsigned*)(p.ws + WS_CUE) + (size_t)(l + coff) * 4096 + key;
    int j = -1;
    if (add_agent(cue, 1u) == 0u) { const unsigned q = add_agent(scanq, 1u); if (q < 256u) j = (int)q; }
    *sjob = j;
  }
  __syncthreads();
  {
    const int j = *sjob;
    if (j >= 0 && mode != 2) scan_job(opaque_tid(wv), p, l, j, s0, s1, s2);
  }
  constexpr int NQJ = 261 * 2;
  constexpr int J_Q = 773, J_AT = J_Q + NQJ, J_LS = J_AT + 2368, J_SS = J_LS + 256, NJ = J_SS + 1024;
  bool ready = false;
  while (true) {
    __syncthreads();
    if (tid_ == 0) *sjob = (int)atomicAdd(ctr, 1u);
    __syncthreads();
    const int job = *sjob;
    if (job >= NJ) break;
    const int tj = opaque_tid(wv);
    if (job < J_AT) {
      if (job < J_Q) {
#pragma unroll 1
        for (int h = 0; h < 8; ++h) kv_tile(opaque_tid(wv), p, l, job, h, s0, s1, s2);
      } else {
        const int jq = job - J_Q;
#pragma unroll 1
        for (int h = 0; h < 4; ++h) q_tile(opaque_tid(wv), p, l, jq >> 1, (jq & 1) * 4 + h, s0, s1, s2);
      }
      asm volatile("s_waitcnt vmcnt(0)" ::: "memory");
      __syncthreads();
      if (tj == 0) {
        __builtin_amdgcn_fence(__ATOMIC_RELEASE, "agent");
        asm volatile("s_waitcnt vmcnt(0)" ::: "memory");
        add_agent(done, 1u);
      }
    } else if (job < J_LS) {
      if (!ready) {
        if (tj == 0) { while (ld_agent(done) < (unsigned)(773 + NQJ)) __builtin_amdgcn_s_sleep(4); }
        __syncthreads();
        __builtin_amdgcn_fence(__ATOMIC_ACQUIRE, "agent");
        asm volatile("s_waitcnt vmcnt(0)" ::: "memory");
        ready = true;
      }
      if (mode != 1) attn_item(tj, p, l, job - J_AT, s0, s1, s2);
    } else if (job < J_SS) {
      __syncthreads();
      if (tj == 0) { const unsigned q = add_agent(scanq, 1u); *sjob = (q < 256u) ? (int)q : -1; }
      __syncthreads();
      const int j = *sjob;
      if (j >= 0 && mode != 2) scan_job(opaque_tid(wv), p, l, j, s0, s1, s2);
    } else { if (mode != 2) scan_job(tj, p, l, 256 + (job - J_SS), s0, s1, s2); }
  }
}

DI void phase3b(const int wv, const Params& p0, int l) {
  const Params p = load_params(p0);
  const int tid_ = opaque_tid(wv);
  const int tid = tid_, lane = tid & 63, wave = tid >> 6;
  const float* Y = p.out + O_YP;
  const u16* R = (const u16*)(p.ws + WS_R);
  const u16* KM = (const u16*)(p.ws + WS_KM);
  const u16* V = (const u16*)(p.ws + WS_V);
  u16* YA = (u16*)(p.ws + WS_YA);
  for (int job = opaque_bid(); job < 1044; job += gridDim.x) {
    for (int q = 0; q < 8; ++q) {
      const int t = job * 32 + wave * 8 + q;
      const int c = lane * 8;
      const size_t o = (size_t)t * 512 + c;
      f32x4 y0 = ld4(Y + o), y1 = ld4(Y + o + 4);
      float s = y0[0] + y0[1] + y0[2] + y0[3] + y1[0] + y1[1] + y1[2] + y1[3];
      s = xor_sum(s, 1); s = xor_sum(s, 2); s = xor_sum(s, 4);
      const float mu = s * (1.f / 64.f);
      f32x4 d0 = y0 - mu, d1 = y1 - mu;
      float vs = d0[0] * d0[0] + d0[1] * d0[1] + d0[2] * d0[2] + d0[3] * d0[3] + d1[0] * d1[0] + d1[1] * d1[1] + d1[2] * d1[2] + d1[3] * d1[3];
      vs = xor_sum(vs, 1); vs = xor_sum(vs, 2); vs = xor_sum(vs, 4);
      const float rstd = rsqrtf(vs * (1.f / 64.f) + 64e-5f);
      u32x4 rw = *(const u32x4*)(R + o), kw = *(const u32x4*)(KM + o), vw = *(const u32x4*)(V + o);
      f32x4 r0 = unpack4(u32x2{rw.x, rw.y}), r1 = unpack4(u32x2{rw.z, rw.w});
      f32x4 k0 = unpack4(u32x2{kw.x, kw.y}), k1 = unpack4(u32x2{kw.z, kw.w});
      f32x4 v0 = unpack4(u32x2{vw.x, vw.y}), v1 = unpack4(u32x2{vw.z, vw.w});
      f32x4 rk0 = ld4(p.in[I_RK] + l * 512 + c), rk1 = ld4(p.in[I_RK] + l * 512 + c + 4);
      f32x4 b0 = r0 * k0 * rk0, b1 = r1 * k1 * rk1;
      float bs = b0[0] + b0[1] + b0[2] + b0[3] + b1[0] + b1[1] + b1[2] + b1[3];
      bs = xor_sum(bs, 1); bs = xor_sum(bs, 2); bs = xor_sum(bs, 4);
      f32x4 lw0 = ld4(p.in[I_LNW] + l * 512 + c), lw1 = ld4(p.in[I_LNW] + l * 512 + c + 4);
      f32x4 lb0 = ld4(p.in[I_LNB] + l * 512 + c), lb1 = ld4(p.in[I_LNB] + l * 512 + c + 4);
      f32x4 g0 = shifted4(p, l, t, C_G + c), g1 = shifted4(p, l, t, C_G + c + 4);
      f32x4 o0 = d0 * rstd * lw0 + lb0 + v0 * bs;
      f32x4 o1 = d1 * rstd * lw1 + lb1 + v1 * bs;
#pragma unroll
      for (int e = 0; e < 4; ++e) { o0[e] *= siluf_(g0[e]); o1[e] *= siluf_(g1[e]); }
      u32x2 pa = pack4(o0), pb = pack4(o1);
      *(u32x4*)(YA + o) = u32x4{pa.x, pa.y, pb.x, pb.y};
    }
  }
}

DI void phase4(const XcdMap xm, const int wv, const Params& p0, int l, char* s0, char* s1, char* s2) {
  const Params p = load_params(p0);
  const int tid_ = opaque_tid(wv);
  const u16* z = (const u16*)(p.ws + WS_Z);
  u16* U = (u16*)(p.ws + WS_U);
  int m_start, m_cnt;
  const int total = xcd_total(xm, 174, 8, m_start, m_cnt);
#pragma unroll 1
  for (int t = xm.rank; t < total; t += xm.nlb) {
    int mtile, ntile;
    xcd_tile(t, m_start, m_cnt, 8, mtile, ntile);
    const int tl = opaque_tid(wv);
    const int lane = tl & 63, wave = tl >> 6, g = lane >> 4, c16 = lane & 15;
    const int m0 = mtile * 192, n0 = ntile * 128;
    f32x4 acc[6][4];
    {
      gemm_ring<192, 128, 2, 2, 4, true>(tl, (const u16*)(p.ws + WS_YA) + (size_t)m0 * 512, 512,
                                 (const u16*)(p.ws + WS_WA) + ((size_t)l * 1024 + n0) * 512, 512, 127, 16, s0, s1, s2, acc);
    }
    const int wr = wave >> 1, wc = wave & 1;
#pragma unroll
    for (int mt = 0; mt < 6; ++mt) {
      const int m = m0 + wr * 96 + mt * 16 + c16;
#pragma unroll
      for (int nt = 0; nt < 4; nt += 2) {
        const int n = n0 + wc * 64 + g * 16 + nt * 4;
        u32x4 gw = *(const u32x4*)(z + (size_t)m * ZC + C_GA1 + n);
        f32x4 ga0 = unpack4(u32x2{gw.x, gw.y}), ga1 = unpack4(u32x2{gw.z, gw.w});
        f32x4 r0 = acc[mt][nt], r1 = acc[mt][nt + 1];
#pragma unroll
        for (int e = 0; e < 4; ++e) { r0[e] *= sigmoidf_(ga0[e]); r1[e] *= sigmoidf_(ga1[e]); }
        u32x2 a = pack4(r0), b = pack4(r1);
        *(u32x4*)(U + (size_t)m * 1024 + n) = u32x4{a.x, a.y, b.x, b.y};
        __builtin_amdgcn_sched_barrier(0);
      }
    }
    {
      gemm_ring<192, 128, 2, 2, 4, true>(tl, (const u16*)(p.ws + WS_YB) + (size_t)m0 * 512, 512,
                                 (const u16*)(p.ws + WS_WB) + ((size_t)l * 1024 + n0) * 512, 512, 127, 16, s0, s1, s2, acc);
    }
#pragma unroll
    for (int mt = 0; mt < 6; ++mt) {
      const int m = m0 + wr * 96 + mt * 16 + c16;
#pragma unroll
      for (int nt = 0; nt < 4; nt += 2) {
        const int n = n0 + wc * 64 + g * 16 + nt * 4;
        u32x4 gw = *(const u32x4*)(z + (size_t)m * ZC + C_GB1 + n);
        u32x4 uw = *(const u32x4*)(U + (size_t)m * 1024 + n);
        f32x4 gb0 = unpack4(u32x2{gw.x, gw.y}), gb1 = unpack4(u32x2{gw.z, gw.w});
        f32x4 r0 = unpack4(u32x2{uw.x, uw.y}), r1 = unpack4(u32x2{uw.z, uw.w});
#pragma unroll
        for (int e = 0; e < 4; ++e) { r0[e] += acc[mt][nt][e] * sigmoidf_(gb0[e]); r1[e] += acc[mt][nt + 1][e] * sigmoidf_(gb1[e]); }
        u32x2 a = pack4(r0), b = pack4(r1);
        *(u32x4*)(U + (size_t)m * 1024 + n) = u32x4{a.x, a.y, b.x, b.y};
        __builtin_amdgcn_sched_barrier(0);
      }
    }
  }
}

DI void phase5(const XcdMap xm, const int wv, const Params& p0, int l, char* s0, char* s1, char* s2) {
  const Params p = load_params(p0);
  const int tid_ = opaque_tid(wv);
  u16* xb = (u16*)(p.ws + WS_XB);
  int m_start, m_cnt;
  const int total = xcd_total(xm, 174, 8, m_start, m_cnt);
#pragma unroll 1
  for (int t = xm.rank; t < total; t += xm.nlb) {
    int mtile, ntile;
    xcd_tile(t, m_start, m_cnt, 8, mtile, ntile);
    const int tl = opaque_tid(wv);
    const int lane = tl & 63, wave = tl >> 6, g = lane >> 4, c16 = lane & 15;
    const int m0 = mtile * 192, n0 = ntile * 128;
    f32x4 acc[6][4];
    {
      gemm_ring<192, 128, 2, 2, 4, true>(tl, (const u16*)(p.ws + WS_U) + (size_t)m0 * 1024, 1024,
                                 (const u16*)(p.ws + WS_WOUT) + ((size_t)l * 1024 + n0) * 1024, 1024, 127, 32, s0, s1, s2, acc);
    }
    const int wr = wave >> 1, wc = wave & 1;
#pragma unroll
    for (int mt = 0; mt < 6; ++mt) {
      const int m = m0 + wr * 96 + mt * 16 + c16;
      float* xd = x_dst(p, m);
      float psum = 0.f;
#pragma unroll
      for (int nt = 0; nt < 4; nt += 2) {
        const int n = n0 + wc * 64 + g * 16 + nt * 4;
        u32x4 xw = *(const u32x4*)(xb + (size_t)m * 1024 + n);
        f32x4 x0 = unpack4(u32x2{xw.x, xw.y}) + acc[mt][nt], x1 = unpack4(u32x2{xw.z, xw.w}) + acc[mt][nt + 1];
        psum += sum4sq(x0) + sum4sq(x1);
        if (l == 3) { *(f32x4*)(xd + n) = x0; *(f32x4*)(xd + n + 4) = x1; }
        else { u32x2 a = pack4(x0), b = pack4(x1); *(u32x4*)(xb + (size_t)m * 1024 + n) = u32x4{a.x, a.y, b.x, b.y}; }
      }
      psum = xor_sum(psum, 16);
      psum = xor_sum(psum, 32);
      if (g == 0) ((float*)(p.ws + WS_SSX))[(size_t)m * 16 + ntile * 2 + wc] = psum;
    }
  }
}

#define XB_TMO      128
#define XB_XCNT(j)  (256  + 64 * (j))
#define XB_XSUB(j)  (1280 + 64 * (j))
#define XB_XGEN(j)  (2304 + 64 * (j))
#define XB_TOP      3328
#define XB_TOPGEN   3392
#define XCD_BAR_WORDS 3456
#define XB_SPIN_CAP (1u << 22)
DI unsigned xb_ld(unsigned* p) { return __hip_atomic_load(p, __ATOMIC_RELAXED, __HIP_MEMORY_SCOPE_AGENT); }
DI unsigned xb_add(unsigned* p, unsigned v) { return __hip_atomic_fetch_add(p, v, __ATOMIC_RELAXED, __HIP_MEMORY_SCOPE_AGENT); }
DI unsigned xb_xcc_id() { return (unsigned)__builtin_amdgcn_s_getreg((3 << 11) | 20) & 0xFu; }
#define XB_SPIN(cond, bar) do { unsigned _sp = 0; while (cond) { __builtin_amdgcn_s_sleep(1); \
    if ((++_sp & 255u) == 0u) { if (xb_ld(&(bar)[XB_TMO])) break; if (_sp > XB_SPIN_CAP) { atomicAdd(&(bar)[XB_TMO], 1u); break; } } } } while (0)
struct XcdBarrier { unsigned* bar; unsigned x; volatile LAS unsigned* st; };
DI void xcd_barrier_complete(unsigned* bar, unsigned x, unsigned& nloc, unsigned& nx) {
  const unsigned G = gridDim.x;
  unsigned sum, cnt, mine, sp = 0u;
  for (;;) {
    sum = 0u; cnt = 0u; mine = 0u;
#pragma unroll
    for (unsigned j = 0; j < 16; ++j) { const unsigned c = xb_ld(&bar[XB_XCNT(j)]); sum += c; cnt += (c > 0u) ? 1u : 0u; mine = (j == x) ? c : mine; }
    if (sum == G) break;
    __builtin_amdgcn_s_sleep(1);
    if ((++sp & 255u) == 0u) { if (xb_ld(&bar[XB_TMO])) break; if (sp > XB_SPIN_CAP) { atomicAdd(&bar[XB_TMO], 1u); break; } }
  }
  nloc = mine > 0u ? mine : 1u; nx = cnt > 0u ? cnt : 1u;
}
DI void xcd_barrier(const XcdBarrier& b, const int tid) {
  asm volatile("s_waitcnt vmcnt(0)" ::: "memory");
  __syncthreads();
  if (tid == 0) {
    unsigned* bar = b.bar;
    __builtin_amdgcn_s_waitcnt(0);
    unsigned nloc = b.st[0], nx = b.st[1];
    if (nloc == 0u) { xcd_barrier_complete(bar, b.x, nloc, nx); b.st[0] = nloc; b.st[1] = nx; }
    const unsigned old = xb_add(&bar[XB_XSUB(b.x)], 1u);
    const unsigned gen = old / nloc;
    if (old + 1u == (gen + 1u) * nloc) {
      __builtin_amdgcn_fence(__ATOMIC_RELEASE, "agent");
      asm volatile("s_waitcnt vmcnt(0)" ::: "memory");
      const unsigned og = xb_add(&bar[XB_TOP], 1u);
      const unsigned tg = og / nx;
      if (og + 1u == (tg + 1u) * nx) xb_add(&bar[XB_TOPGEN], 1u);
      else XB_SPIN(xb_ld(&bar[XB_TOPGEN]) == tg, bar);
      __builtin_amdgcn_fence(__ATOMIC_ACQUIRE, "agent");
      xb_add(&bar[XB_XGEN(b.x)], 1u);
      asm volatile("s_waitcnt vmcnt(0)" ::: "memory");
    } else {
      XB_SPIN(xb_ld(&bar[XB_XGEN(b.x)]) == gen, bar);
      __builtin_amdgcn_fence(__ATOMIC_ACQUIRE, "agent");
      asm volatile("s_waitcnt vmcnt(0)" ::: "memory");
    }
  }
  __syncthreads();
}

__global__ void __launch_bounds__(256, 2) mega_kernel(Params p) {
  __shared__ __attribute__((aligned(1024))) char lds0[24576];
  __shared__ __attribute__((aligned(1024))) char lds1[24576];
  __shared__ __attribute__((aligned(1024))) char lds2[24576];
  __shared__ __attribute__((aligned(16))) unsigned xbw[4];
  cg::grid_group grid = cg::this_grid();
  const int wv = __builtin_amdgcn_readfirstlane((int)(threadIdx.x >> 6));
  XcdBarrier xb;
  {
    const int t0 = opaque_tid(wv);
    if (t0 == 0) { xbw[0] = 0u; xbw[1] = 0u; xbw[2] = 0u; xbw[3] = 0u; }
    __syncthreads();
    xb.bar = (unsigned*)(p.ws + WS_BAR); xb.x = xb_xcc_id(); xb.st = (volatile LAS unsigned*)xbw;
    if (t0 == 0) xbw[2] = xb_add(&xb.bar[XB_XCNT(xb.x)], 1u);
    __syncthreads();
  }
  XcdMap xm;
  xm.rank = __builtin_amdgcn_readfirstlane((int)xbw[2]);
  xm.xcc = 0; xm.nlb = 1; xm.nx = 1;
  for (int ph = 0; ph < NPH; ++ph) {
    if (ph == 1) {
      if (p.ph_hi < 0) grid.sync();
      xcd_barrier(xb, opaque_tid(wv));
      const int t0 = opaque_tid(wv);
      if (t0 == 0) {
        unsigned mine = 0u, cnt = 0u, idx = 0u;
#pragma unroll
        for (unsigned j = 0; j < 16; ++j) {
          const unsigned c = xb_ld(&xb.bar[XB_XCNT(j)]);
          cnt += (c > 0u) ? 1u : 0u;
          idx += (c > 0u && j < xb.x) ? 1u : 0u;
          mine = (j == xb.x) ? c : mine;
        }
        xbw[0] = mine; xbw[1] = cnt; xbw[3] = idx;
      }
      __syncthreads();
      xm.nlb = __builtin_amdgcn_readfirstlane((int)xbw[0]);
      xm.nx = __builtin_amdgcn_readfirstlane((int)xbw[1]);
      xm.xcc = __builtin_amdgcn_readfirstlane((int)xbw[3]);
    } else if (ph > 1) xcd_barrier(xb, opaque_tid(wv));
    if (ph == 0) phase0(wv, p, lds0, lds1, lds2);
    else {
      const int l = (ph - 1) / 6, s = (ph - 1) - l * 6;
      if (s == 0) phase1(xm, wv, p, l, lds0, lds1, lds2);
      else if (s == 1) phase2(xm, wv, p, l, lds0, lds1, lds2);
      else if (s == 2) phase3(wv, p, l, lds0, lds1, lds2, 0);
      else if (s == 3) phase3b(wv, p, l);
      else if (s == 4) phase4(xm, wv, p, l, lds0, lds1, lds2);
      else phase5(xm, wv, p, l, lds0, lds1, lds2);
#if PROBE_PHASE >= 0
      if (s == PROBE_PHASE) {
        xcd_barrier(xb, opaque_tid(wv));
        if (s == 0) phase1(xm, wv, p, l, lds0, lds1, lds2);
        else if (s == 1) phase2(xm, wv, p, l, lds0, lds1, lds2, PROBE_MODE);
        else if (s == 2) phase3(wv, p, l, lds0, lds1, lds2, 4, PROBE_MODE);
        else if (s == 3) phase3b(wv, p, l);
        else if (s == 4) phase4(xm, wv, p, l, lds0, lds1, lds2);
      }
#endif
    }
  }
}

extern "C" void kernel_launch(void* const* d_in, const int* in_sizes, int n_in, void* d_out, int out_size, void* d_ws, size_t ws_size,
                              hipStream_t stream) {
  static int grid_blocks = 0;
  if (!grid_blocks) {
    int dev = 0, cus = 0, per_cu = 0;
    hipGetDevice(&dev);
    hipDeviceGetAttribute(&cus, hipDeviceAttributeMultiprocessorCount, dev);
    hipOccupancyMaxActiveBlocksPerMultiprocessor(&per_cu, mega_kernel, 256, 0);
    if (per_cu > 2) per_cu = 2;
    if (per_cu < 1) per_cu = 1;
    grid_blocks = cus * per_cu;
  }
  if (ws_size < WS_END) { fprintf(stderr, "workspace too small: %zu < %zu\n", ws_size, (size_t)WS_END); return; }
  Params p{};
  for (int i = 0; i < 30; ++i) p.in[i] = (const float*)d_in[i];
  p.out = (float*)d_out;
  p.ws = (char*)d_ws;
  hipMemsetAsync((char*)d_ws + WS_BAR, 0, 16384, stream);
  hipMemsetAsync((char*)d_ws + WS_CUE, 0, (size_t)8 * 4096 * 4, stream);
  p.ph_lo = 0; p.ph_hi = NPH;
  void* args[] = {&p};
  hipError_t e = hipLaunchCooperativeKernel((void*)mega_kernel, dim3(grid_blocks), dim3(256), args, 0, stream);
  if (e != hipSuccess) fprintf(stderr, "cooperative launch failed: %s (grid %d)\n", hipGetErrorString(e), grid_blocks);
}
```

```cpp
#include <hip/hip_runtime.h>
#include <hip/hip_cooperative_groups.h>
#include <stdint.h>
#include <cstdio>
namespace cg = cooperative_groups;

#ifndef PROBE_MODE
#define PROBE_MODE 0
#endif
#ifndef PROBE_PHASE
#define PROBE_PHASE -1
#endif
#ifndef MULTI_LAUNCH
#define MULTI_LAUNCH 0
#endif

typedef unsigned short u16;
typedef __attribute__((ext_vector_type(4))) unsigned u32x4;
typedef __attribute__((ext_vector_type(2))) unsigned u32x2;
typedef __attribute__((ext_vector_type(8))) short bf16x8;
typedef __attribute__((ext_vector_type(4))) float f32x4;
typedef __attribute__((ext_vector_type(2))) float f32x2;
typedef __attribute__((ext_vector_type(2))) __bf16 bf16x2v;
#define DI __device__ __forceinline__
#define LAS __attribute__((address_space(3)))

constexpr int LP = 4112, TP = 8 * LP, TS = 512, T = TP + TS;
constexpr int SK = 2064;
constexpr int ZC = 5408;
constexpr int C_R = 0, C_K = 512, C_V = 1024, C_G = 1536, C_WL = 2048, C_QC = 2176, C_CKV = 2560, C_KR = 2816,
              C_GB = 2848, C_GA1 = 3360, C_GB1 = 4384;
constexpr int NPH = 25;

enum { I_XP = 0, I_XS, I_SRWKV, I_SSHIFT, I_CLAT, I_CKR, I_META, I_NORMW, I_WIN, I_MIX, I_W0, I_W2, I_A0, I_A2, I_KK, I_KA,
       I_RK, I_LNW, I_LNB, I_QNORM, I_WUQ, I_KVNORM, I_WUKV, I_QNN, I_KNN, I_QNR, I_KNR, I_WA, I_WB, I_WOUT };

constexpr size_t O_YP = 0;
constexpr size_t O_YS = O_YP + (size_t)8 * 4096 * 1024;
constexpr size_t O_SRP = O_YS + (size_t)512 * 1024;
constexpr size_t O_SHP = O_SRP + (size_t)4 * 8 * 8 * 64 * 64;
constexpr size_t O_LATP = O_SHP + (size_t)4 * 8 * 2176;
constexpr size_t O_KRP = O_LATP + (size_t)4 * 8 * LP * 256;
constexpr size_t O_SRS = O_KRP + (size_t)4 * 8 * LP * 32;
constexpr size_t O_SHS = O_SRS + (size_t)4 * 32 * 8 * 64 * 64;
constexpr size_t O_LATN = O_SHS + (size_t)4 * 32 * 2176;
constexpr size_t O_KRN = O_LATN + (size_t)4 * 32 * 16 * 256;

constexpr size_t al256(size_t x) { return (x + 255) & ~(size_t)255; }
constexpr size_t WS_WIN = 0;
constexpr size_t WS_W2 = al256(WS_WIN + (size_t)4 * 5504 * 1024 * 2);
constexpr size_t WS_A2 = al256(WS_W2 + (size_t)4 * 512 * 64 * 2);
constexpr size_t WS_WUQ = al256(WS_A2 + (size_t)4 * 512 * 64 * 2);
constexpr size_t WS_WKVF = al256(WS_WUQ + (size_t)4 * 768 * 384 * 2);
constexpr size_t WS_WKVP = al256(WS_WKVF + (size_t)4 * 1024 * 256 * 2);
constexpr size_t WS_WA = al256(WS_WKVP + (size_t)4 * 1024 * 256 * 2);
constexpr size_t WS_WB = al256(WS_WA + (size_t)4 * 1024 * 512 * 2);
constexpr size_t WS_WOUT = al256(WS_WB + (size_t)4 * 1024 * 512 * 2);
constexpr size_t WS_XMETA = al256(WS_WOUT + (size_t)4 * 1024 * 1024 * 2);
constexpr size_t WS_CTR = al256(WS_XMETA + (size_t)128 * 1024 * 4);
constexpr size_t WS_Z = al256(WS_CTR + 1024);
constexpr size_t WS_DEC = al256(WS_Z + (size_t)T * ZC * 2);
constexpr size_t WS_R = al256(WS_DEC + (size_t)T * 512 * 4);
constexpr size_t WS_KM = al256(WS_R + (size_t)T * 512 * 2);
constexpr size_t WS_V = al256(WS_KM + (size_t)T * 512 * 2);
constexpr size_t WS_NKK = al256(WS_V + (size_t)T * 512 * 2);
constexpr size_t WS_KKA = al256(WS_NKK + (size_t)T * 512 * 2);
constexpr size_t WS_Y = al256(WS_KKA + (size_t)T * 512 * 2);
constexpr size_t WS_Q = al256(WS_Y + (size_t)T * 512 * 4);
constexpr size_t WS_KP = al256(WS_Q + (size_t)T * 768 * 2);
constexpr size_t WS_VTP = al256(WS_KP + (size_t)TP * 512 * 2);
constexpr size_t WS_KRP = al256(WS_VTP + (size_t)TP * 512 * 2);
constexpr size_t WS_KS = al256(WS_KRP + (size_t)TP * 32 * 2);
constexpr size_t WS_VTS = al256(WS_KS + (size_t)32 * SK * 512 * 2);
constexpr size_t WS_KRS = al256(WS_VTS + (size_t)32 * SK * 512 * 2 + 4096);
constexpr size_t WS_YB = al256(WS_KRS + (size_t)32 * SK * 32 * 2);
constexpr size_t WS_LATB = al256(WS_YB + (size_t)T * 512 * 2);
constexpr size_t WS_BAR = al256(WS_LATB + (size_t)65536 * 256 * 2);
constexpr size_t WS_TAB = al256(WS_BAR + 16384);
constexpr size_t WS_SSX = al256(WS_TAB + 512);
constexpr size_t WS_SSQ = al256(WS_SSX + (size_t)T * 16 * 4);
constexpr size_t WS_SSKV = al256(WS_SSQ + (size_t)T * 8 * 4);
constexpr size_t WS_CUE = al256(WS_SSKV + (size_t)T * 4 * 4);
constexpr size_t WS_END = al256(WS_CUE + (size_t)8 * 4096 * 4);
constexpr size_t WS_U = WS_DEC;
constexpr size_t WS_YA = WS_Q;
constexpr size_t WS_XB = WS_Y;

struct Params {
  const float* in[30];
  float* out;
  char* ws;
  int ph_lo, ph_hi;
};

DI uint32_t pack2(float a, float b) {
  f32x2 v = {a, b};
  bf16x2v r = __builtin_convertvector(v, bf16x2v);
  return __builtin_bit_cast(uint32_t, r);
}
DI float bflo(uint32_t w) { return __uint_as_float(w << 16); }
DI float bfhi(uint32_t w) { return __uint_as_float(w & 0xffff0000u); }
DI float bf2f(u16 h) { return __uint_as_float(((uint32_t)h) << 16); }
DI f32x4 unpack4(u32x2 w) { return f32x4{bflo(w.x), bfhi(w.x), bflo(w.y), bfhi(w.y)}; }
DI u32x2 pack4(f32x4 v) { return u32x2{pack2(v[0], v[1]), pack2(v[2], v[3])}; }
DI int opaque_tid(const int wv) {
  int lane;
  asm volatile("v_mbcnt_lo_u32_b32 %0, -1, 0\n\tv_mbcnt_hi_u32_b32 %0, -1, %0" : "=v"(lane));
  return (wv << 6) | lane;
}
DI int opaque_bid() { int b = blockIdx.x; asm volatile("" : "+s"(b)); return b; }
DI unsigned xb_xcc_id_early() { return (unsigned)__builtin_amdgcn_s_getreg((3 << 11) | 20) & 0xFu; }
DI unsigned ld_agent(unsigned* p) { return __hip_atomic_load(p, __ATOMIC_RELAXED, __HIP_MEMORY_SCOPE_AGENT); }
DI unsigned add_agent(unsigned* p, unsigned v) { return __hip_atomic_fetch_add(p, v, __ATOMIC_RELAXED, __HIP_MEMORY_SCOPE_AGENT); }
DI float sigmoidf_(float x) { return __builtin_amdgcn_rcpf(1.f + __expf(-x)); }
DI float siluf_(float x) { return x * __builtin_amdgcn_rcpf(1.f + __expf(-x)); }
DI float tanhf_(float x) { return 1.f - 2.f * __builtin_amdgcn_rcpf(__expf(2.f * x) + 1.f); }
DI float xsum16(float x) { u32x2 r = __builtin_amdgcn_permlane16_swap(__float_as_uint(x), __float_as_uint(x), false, false); return __uint_as_float(r.x) + __uint_as_float(r.y); }
DI float xsum32(float x) { u32x2 r = __builtin_amdgcn_permlane32_swap(__float_as_uint(x), __float_as_uint(x), false, false); return __uint_as_float(r.x) + __uint_as_float(r.y); }
DI float xmax16(float x) { u32x2 r = __builtin_amdgcn_permlane16_swap(__float_as_uint(x), __float_as_uint(x), false, false); return fmaxf(__uint_as_float(r.x), __uint_as_float(r.y)); }
DI float xmax32(float x) { u32x2 r = __builtin_amdgcn_permlane32_swap(__float_as_uint(x), __float_as_uint(x), false, false); return fmaxf(__uint_as_float(r.x), __uint_as_float(r.y)); }
DI float xor_sum(float v, int m) {
  if (m == 1) return v + __int_as_float(__builtin_amdgcn_update_dpp(0, __float_as_int(v), 0xB1, 0xf, 0xf, false));
  if (m == 2) return v + __int_as_float(__builtin_amdgcn_update_dpp(0, __float_as_int(v), 0x4E, 0xf, 0xf, false));
  if (m == 4) return v + __int_as_float(__builtin_amdgcn_update_dpp(0, __float_as_int(v), 0x141, 0xf, 0xf, false));
  if (m == 8) return v + __int_as_float(__builtin_amdgcn_update_dpp(0, __float_as_int(v), 0x140, 0xf, 0xf, false));
  if (m == 16) return xsum16(v);
  if (m == 32) return xsum32(v);
  return v + __shfl_xor(v, m);
}
DI f32x4 ld4(const float* p) { return *(const f32x4*)p; }

DI void rope_cs(int pos, int j, float& c, float& s) {
  float inv = exp2f(-(float)j * 0.8304820237218405f);
  float ang = (float)pos * inv;
  double a = (double)ang;
  double k = rint(a * 0.15915494309189535);
  float r = (float)(a - k * 6.283185307179586);
  c = __cosf(r);
  s = __sinf(r);
}
DI int tok_pos(int t) { return (t < TP) ? (t % LP) - 16 : 2048 + ((t - TP) & 15); }

DI const float* x_src(const Params& p, int l, int t) {
  if (t < TP) {
    int b = t / LP, i = t - b * LP;
    if (i < 16) return (l == 0) ? p.in[I_META] + (size_t)i * 1024 : (const float*)(p.ws + WS_XMETA) + (size_t)(b * 16 + i) * 1024;
    return ((l == 0) ? p.in[I_XP] : (const float*)(p.out + O_YP)) + ((size_t)b * 4096 + (i - 16)) * 1024;
  }
  return ((l == 0) ? p.in[I_XS] : (const float*)(p.out + O_YS)) + (size_t)(t - TP) * 1024;
}
DI float* x_dst(const Params& p, int t) {
  if (t < TP) {
    int b = t / LP, i = t - b * LP;
    if (i < 16) return (float*)(p.ws + WS_XMETA) + (size_t)(b * 16 + i) * 1024;
    return p.out + O_YP + ((size_t)b * 4096 + (i - 16)) * 1024;
  }
  return p.out + O_YS + (size_t)(t - TP) * 1024;
}

DI void shifted16(const Params& p, int l, int t, int col, f32x4 (&out)[4]) {
  const u16* z = (const u16*)(p.ws + WS_Z);
  const u16* zc = z + (size_t)t * ZC + col;
  u32x4 c0 = *(const u32x4*)zc, c1 = *(const u32x4*)(zc + 8);
  f32x4 cur[4] = {unpack4(u32x2{c0.x, c0.y}), unpack4(u32x2{c0.z, c0.w}), unpack4(u32x2{c1.x, c1.y}), unpack4(u32x2{c1.z, c1.w})};
  f32x4 prv[4];
  bool first;
  int sb = 0;
  if (t < TP) first = (t % LP) == 0;
  else { int s = t - TP; sb = s >> 4; first = (s & 15) == 0; }
  if (!first) {
    u32x4 q0 = *(const u32x4*)(zc - ZC), q1 = *(const u32x4*)(zc - ZC + 8);
    prv[0] = unpack4(u32x2{q0.x, q0.y}); prv[1] = unpack4(u32x2{q0.z, q0.w});
    prv[2] = unpack4(u32x2{q1.x, q1.y}); prv[3] = unpack4(u32x2{q1.z, q1.w});
  } else if (t < TP) {
#pragma unroll
    for (int j = 0; j < 4; ++j) prv[j] = f32x4{0.f, 0.f, 0.f, 0.f};
  } else {
    const float* ss = p.in[I_SSHIFT] + ((size_t)l * 32 + sb) * 2176 + col;
#pragma unroll
    for (int j = 0; j < 4; ++j) prv[j] = ld4(ss + 4 * j);
  }
  const float* m0 = p.in[I_MIX] + ((size_t)l * 2 + 0) * 2176 + col;
  const float* m1 = p.in[I_MIX] + ((size_t)l * 2 + 1) * 2176 + col;
#pragma unroll
  for (int j = 0; j < 4; ++j) out[j] = cur[j] * ld4(m0 + 4 * j) + prv[j] * ld4(m1 + 4 * j);
}

DI Params load_params(const Params& k) {
  typedef const volatile unsigned long long __attribute__((address_space(4))) * kptr_t;
  kptr_t kp = (kptr_t)__builtin_amdgcn_kernarg_segment_ptr();
  Params q;
#pragma unroll
  for (int i = 0; i < 30; ++i) q.in[i] = (const float*)kp[i];
  q.out = (float*)kp[30];
  q.ws = (char*)kp[31];
  q.ph_lo = 0; q.ph_hi = 0;
  return q;
}

DI f32x4 shifted4(const Params& p, int l, int t, int col) {
  const u16* z = (const u16*)(p.ws + WS_Z);
  f32x4 cur = unpack4(*(const u32x2*)(z + (size_t)t * ZC + col));
  f32x4 prv;
  bool first;
  int sb = 0;
  if (t < TP) first = (t % LP) == 0;
  else { int s = t - TP; sb = s >> 4; first = (s & 15) == 0; }
  if (!first) prv = unpack4(*(const u32x2*)(z + (size_t)(t - 1) * ZC + col));
  else if (t < TP) prv = f32x4{0.f, 0.f, 0.f, 0.f};
  else prv = ld4(p.in[I_SSHIFT] + ((size_t)l * 32 + sb) * 2176 + col);
  f32x4 m0 = ld4(p.in[I_MIX] + ((size_t)l * 2 + 0) * 2176 + col);
  f32x4 m1 = ld4(p.in[I_MIX] + ((size_t)l * 2 + 1) * 2176 + col);
  return cur * m0 + prv * m1;
}

struct XcdMap { int xcc, rank, nlb, nx; };
DI int xcd_total(const XcdMap& xm, int MT, int NT, int& m_start, int& m_cnt) {
  const int base = MT / xm.nx, rem = MT - base * xm.nx;
  m_start = xm.xcc * base + (xm.xcc < rem ? xm.xcc : rem);
  m_cnt = base + (xm.xcc < rem ? 1 : 0);
  return m_cnt * NT;
}
DI void xcd_tile(int t, int m_start, int m_cnt, int NT, int& mtile, int& ntile) {
  const int band = t / (8 * NT);
  const int r = t - band * 8 * NT;
  int bh = m_cnt - band * 8;
  bh = bh < 8 ? bh : 8;
  const int ni = r / bh;
  mtile = m_start + band * 8 + (r - ni * bh);
  ntile = ni;
}

constexpr int LDA = 144;

DI void glds16(const void* g, char* l) {
  __builtin_amdgcn_global_load_lds((const __attribute__((address_space(1))) unsigned*)g, (LAS unsigned*)l, 16, 0, 0);
}
#define WAIT_V(n) asm volatile("s_waitcnt vmcnt(%0)" ::"n"(n) : "memory")
DI void raw_barrier() { asm volatile("s_waitcnt lgkmcnt(0)" ::: "memory"); __builtin_amdgcn_s_barrier(); }
DI int swz4(int q) { return (0x78 >> (2 * q)) & 3; }
template <int OFF> DI bf16x8 ldsr(unsigned a) {
  bf16x8 r;
  asm volatile("ds_read_b128 %0, %1 offset:%2" : "=v"(r) : "v"(a), "n"(OFF));
  return r;
}

template <int BM, int BN, int WR, int WC, int NSWAP, bool PERM = false>
DI void gemm_ring(const int tid_, const u16* __restrict__ Ab, int lda, const u16* __restrict__ Bt, int ldb, int brow_max, int nk,
                  char* s0, char* s1, char* s2, f32x4 (&acc)[BM / WR / 16][BN / WC / 16]) {
  constexpr int MT = BM / WR / 16, NT = BN / WC / 16;
  constexpr int WM = BM / WR, WN = BN / WC;
  constexpr int SA = BM * 64;
  constexpr int LA = BM / 64, LB = BN / 64, LPW = LA + LB;
  static_assert(SA + BN * 64 <= 24576, "stage too large");
  const int tid = tid_, lane = tid & 63, wave = tid >> 6;
  const int wr = wave / WC, wc = wave % WC;
  const int lrow = lane >> 2, lc = (lane & 3) ^ swz4(lane >> 4);
  const u16* ap = Ab + (size_t)(wave * 16 + lrow) * lda + lc * 8;
  const u16* bp[LB];
#pragma unroll
  for (int i = 0; i < LB; ++i) {
    int r = i * 64 + wave * 16 + lrow;
    if (PERM) {
      const int wcg = r / WN, np = r - wcg * WN;
      r = wcg * WN + ((np >> 2) & 3) * (WN / 4) + (np >> 4) * 4 + (np & 3);
    }
    r = r < brow_max ? r : brow_max;
    bp[i] = Bt + (size_t)r * ldb + lc * 8;
  }
#pragma unroll
  for (int mt = 0; mt < MT; ++mt)
#pragma unroll
    for (int nt = 0; nt < NT; ++nt) acc[mt][nt] = f32x4{0.f, 0.f, 0.f, 0.f};
  const int g = lane >> 4;
  const int fo = (lane & 15) * 64 + ((g ^ swz4((lane & 15) >> 2)) * 16);
  auto issue = [&](char* sa, int kt) {
    const int ko = kt * 32;
#pragma unroll
    for (int i = 0; i < LA; ++i) glds16(ap + (size_t)(i * 64) * lda + ko, sa + (i * 4 + wave) * 1024);
#pragma unroll
    for (int i = 0; i < LB; ++i) glds16(bp[i] + ko, sa + SA + (i * 4 + wave) * 1024);
  };
  auto step = [&](int kt, char* cur, char* nxt) {
    if (kt + 1 < nk) WAIT_V(LPW); else WAIT_V(0);
    raw_barrier();
    if (kt + 2 < nk) issue(nxt, kt + 2);
    const unsigned aA = (unsigned)(size_t)cur + (unsigned)((wr * WM) * 64 + fo);
    const unsigned aB = (unsigned)(size_t)cur + (unsigned)(SA + (wc * WN) * 64 + fo);
    bf16x8 xf[MT], wf[NT];
    xf[0] = ldsr<0>(aA);
    if constexpr (MT > 1) xf[1] = ldsr<1024>(aA);
    if constexpr (MT > 2) xf[2] = ldsr<2048>(aA);
    if constexpr (MT > 3) xf[3] = ldsr<3072>(aA);
    if constexpr (MT > 4) xf[4] = ldsr<4096>(aA);
    if constexpr (MT > 5) xf[5] = ldsr<5120>(aA);
    wf[0] = ldsr<0>(aB);
    if constexpr (NT > 1) wf[1] = ldsr<1024>(aB);
    if constexpr (NT > 2) wf[2] = ldsr<2048>(aB);
    if constexpr (NT > 3) wf[3] = ldsr<3072>(aB);
    if constexpr (NT > 4) wf[4] = ldsr<4096>(aB);
    if constexpr (NT > 5) wf[5] = ldsr<5120>(aB);
    if constexpr (NT > 6) wf[6] = ldsr<6144>(aB);
    if constexpr (NT > 7) wf[7] = ldsr<7168>(aB);
    constexpr int NH = NT / 2;
    asm volatile("s_waitcnt lgkmcnt(%0)" ::"n"(NT - NH) : "memory");
#pragma unroll
    for (int mt = 0; mt < MT; ++mt) asm volatile("" : "+v"(xf[mt]));
#pragma unroll
    for (int nt = 0; nt < NH; ++nt) asm volatile("" : "+v"(wf[nt]));
#pragma unroll
    for (int nt = 0; nt < NH; ++nt) {
#pragma unroll
      for (int mt = 0; mt < MT; ++mt) {
        if (nt < NSWAP) acc[mt][nt] = __builtin_amdgcn_mfma_f32_16x16x32_bf16(wf[nt], xf[mt], acc[mt][nt], 0, 0, 0);
        else acc[mt][nt] = __builtin_amdgcn_mfma_f32_16x16x32_bf16(xf[mt], wf[nt], acc[mt][nt], 0, 0, 0);
      }
    }
    asm volatile("s_waitcnt lgkmcnt(0)" ::: "memory");
#pragma unroll
    for (int nt = NH; nt < NT; ++nt) asm volatile("" : "+v"(wf[nt]));
#pragma unroll
    for (int nt = NH; nt < NT; ++nt) {
#pragma unroll
      for (int mt = 0; mt < MT; ++mt) {
        if (nt < NSWAP) acc[mt][nt] = __builtin_amdgcn_mfma_f32_16x16x32_bf16(wf[nt], xf[mt], acc[mt][nt], 0, 0, 0);
        else acc[mt][nt] = __builtin_amdgcn_mfma_f32_16x16x32_bf16(xf[mt], wf[nt], acc[mt][nt], 0, 0, 0);
      }
    }
  };
  WAIT_V(0);
  __syncthreads();
  issue(s0, 0);
  issue(s1, 1);
  for (int kt = 0; kt < nk; kt += 3) {
    step(kt, s0, s2);
    if (kt + 1 < nk) step(kt + 1, s1, s0);
    if (kt + 2 < nk) step(kt + 2, s2, s1);
  }
}

DI float sum4sq(f32x4 v) { return v[0] * v[0] + v[1] * v[1] + v[2] * v[2] + v[3] * v[3]; }

DI void transpose_job(const int tid_, const float* __restrict__ src, const float* __restrict__ scale, u16* __restrict__ dst, u16* __restrict__ dst2,
                      int K, int N, int kt, int nt, char* s0, char* s1, char* s2) {
  float* tile = (float*)s0;
  const int tid = tid_;
  __syncthreads();
#pragma unroll
  for (int i = 0; i < 16; ++i) {
    int kl = (tid >> 6) + 4 * i, nl = tid & 63;
    int k = kt * 64 + kl, n = nt * 64 + nl;
    tile[kl * 65 + nl] = (n < N) ? src[(size_t)k * N + n] : 0.f;
  }
  __syncthreads();
#pragma unroll
  for (int i = 0; i < 16; ++i) {
    int nl = (tid >> 6) + 4 * i, kl = tid & 63;
    int k = kt * 64 + kl, n = nt * 64 + nl;
    float v = tile[kl * 65 + nl];
    float sc = scale ? scale[k] : 1.f;
    dst[(size_t)n * K + k] = (u16)(pack2(v * sc, 0.f) & 0xffffu);
    if (dst2) dst2[(size_t)n * K + k] = (u16)(pack2(v, 0.f) & 0xffffu);
  }
}

DI void wprep_job(const int tid_, const Params& p, int l, int j, char* s0, char* s1, char* s2) {
  if (j < 1376) {
    transpose_job(tid_, p.in[I_WIN] + (size_t)l * 1024 * ZC, p.in[I_NORMW] + l * 1024, (u16*)(p.ws + WS_WIN) + (size_t)l * 5504 * 1024, nullptr,
                  1024, ZC, j / 86, j % 86, s0, s1, s2);
  } else if (j < 1384) {
    transpose_job(tid_, p.in[I_W2] + (size_t)l * 64 * 512, nullptr, (u16*)(p.ws + WS_W2) + (size_t)l * 512 * 64, nullptr, 64, 512, 0, j - 1376, s0, s1, s2);
  } else if (j < 1392) {
    transpose_job(tid_, p.in[I_A2] + (size_t)l * 64 * 512, nullptr, (u16*)(p.ws + WS_A2) + (size_t)l * 512 * 64, nullptr, 64, 512, 0, j - 1384, s0, s1, s2);
  } else if (j < 1464) {
    int q = j - 1392;
    transpose_job(tid_, p.in[I_WUQ] + (size_t)l * 384 * 768, p.in[I_QNORM] + l * 384, (u16*)(p.ws + WS_WUQ) + (size_t)l * 768 * 384, nullptr,
                  384, 768, q / 12, q % 12, s0, s1, s2);
  } else if (j < 1528) {
    int q = j - 1464;
    transpose_job(tid_, p.in[I_WUKV] + (size_t)l * 256 * 1024, p.in[I_KVNORM] + l * 256, (u16*)(p.ws + WS_WKVF) + (size_t)l * 1024 * 256,
                  (u16*)(p.ws + WS_WKVP) + (size_t)l * 1024 * 256, 256, 1024, q / 16, q % 16, s0, s1, s2);
  } else if (j < 1656) {
    int q = j - 1528;
    transpose_job(tid_, p.in[I_WA] + (size_t)l * 512 * 1024, nullptr, (u16*)(p.ws + WS_WA) + (size_t)l * 1024 * 512, nullptr, 512, 1024, q / 16, q % 16, s0, s1, s2);
  } else if (j < 1784) {
    int q = j - 1656;
    transpose_job(tid_, p.in[I_WB] + (size_t)l * 512 * 1024, nullptr, (u16*)(p.ws + WS_WB) + (size_t)l * 1024 * 512, nullptr, 512, 1024, q / 16, q % 16, s0, s1, s2);
  } else {
    int q = j - 1784;
    transpose_job(tid_, p.in[I_WOUT] + (size_t)l * 1024 * 1024, nullptr, (u16*)(p.ws + WS_WOUT) + (size_t)l * 1024 * 1024, nullptr, 1024, 1024, q / 16, q % 16, s0, s1, s2);
  }
}

DI void phase0(const int wv, const Params& p0, char* s0, char* s1, char* s2) {
  const Params p = load_params(p0);
  const int tid_ = opaque_tid(wv);
  if (opaque_bid() == 0 && tid_ < 64) ((unsigned*)(p.ws + WS_CTR))[tid_] = 0u;
  {
    u16* xb = (u16*)(p.ws + WS_XB);
#pragma unroll 1
    for (int job = opaque_bid(); job < T; job += gridDim.x) {
      const float* xs = x_src(p, 0, job);
      f32x4 xv = ld4(xs + tid_ * 4);
      *(u32x2*)(xb + (size_t)job * 1024 + tid_ * 4) = pack4(xv);
      float ss = sum4sq(xv);
#pragma unroll
      for (int m = 1; m < 64; m <<= 1) ss = xor_sum(ss, m);
      float* ssx = (float*)(p.ws + WS_SSX) + (size_t)job * 16;
      if ((tid_ & 63) == 0) ssx[tid_ >> 6] = ss;
      if (tid_ >= 4 && tid_ < 16) ssx[tid_] = 0.f;
    }
  }
#pragma unroll 1
  for (int j = opaque_bid(); j < 2040; j += gridDim.x) wprep_job(tid_, p, 0, j, s0, s1, s2);
}

DI void phase1(const XcdMap xm, const int wv, const Params& p0, int l, char* s0, char* s1, char* s2) {
  const Params p = load_params(p0);
  const int tid_ = opaque_tid(wv);
  const int tid = tid_, lane = tid & 63, wave = tid >> 6, g = lane >> 4, c16 = lane & 15;
  u16* z = (u16*)(p.ws + WS_Z);
  int m_start, m_cnt;
  const int total = xcd_total(xm, 261, 22, m_start, m_cnt);
#pragma unroll 1
  for (int t = xm.rank; t < total; t += xm.nlb) {
    int mtile, ntile;
    xcd_tile(t, m_start, m_cnt, 22, mtile, ntile);
    const int m0 = mtile * 128, n0 = ntile * 256;
    if (ntile == 21) {
      const int tl = opaque_tid(wv);
      const int lane = tl & 63, wave = tl >> 6, g = lane >> 4, c16 = lane & 15;
      f32x4 acc2[2][4];
      gemm_ring<128, 64, 4, 1, 4>(tl, (const u16*)(p.ws + WS_XB) + (size_t)m0 * 1024, 1024,
                                  (const u16*)(p.ws + WS_WIN) + ((size_t)l * 5504 + n0) * 1024, 1024, ZC - 1 - n0, 32, s0, s1, s2, acc2);
      const float* ssx = (const float*)(p.ws + WS_SSX);
#pragma unroll
      for (int mt = 0; mt < 2; ++mt) {
        const int m = m0 + wave * 32 + mt * 16 + c16;
        f32x4 s0_ = ld4(ssx + (size_t)m * 16), s1_ = ld4(ssx + (size_t)m * 16 + 4), s2_ = ld4(ssx + (size_t)m * 16 + 8), s3_ = ld4(ssx + (size_t)m * 16 + 12);
        f32x4 st = s0_ + s1_ + s2_ + s3_;
        const float rs = rsqrtf((st[0] + st[1] + st[2] + st[3]) * (1.f / 1024.f) + 1e-6f);
#pragma unroll
        for (int nt = 0; nt < 2; ++nt) {
          const int n = n0 + nt * 16 + g * 4;
          *(u32x2*)(z + (size_t)m * ZC + n) = pack4(acc2[mt][nt] * rs);
        }
      }
      continue;
    }
    f32x4 acc[4][8];
    gemm_ring<128, 256, 2, 2, 8, true>(tid_, (const u16*)(p.ws + WS_XB) + (size_t)m0 * 1024, 1024,
                               (const u16*)(p.ws + WS_WIN) + ((size_t)l * 5504 + n0) * 1024, 1024, ZC - 1 - n0, 32, s0, s1, s2, acc);
    const int wr = wave >> 1, wc = wave & 1;
    const float* ssx = (const float*)(p.ws + WS_SSX);
#pragma unroll
    for (int mt = 0; mt < 4; ++mt) {
      const int m = m0 + wr * 64 + mt * 16 + c16;
      f32x4 s0 = ld4(ssx + (size_t)m * 16), s1 = ld4(ssx + (size_t)m * 16 + 4), s2 = ld4(ssx + (size_t)m * 16 + 8), s3 = ld4(ssx + (size_t)m * 16 + 12);
      f32x4 st = s0 + s1 + s2 + s3;
      const float rs = rsqrtf((st[0] + st[1] + st[2] + st[3]) * (1.f / 1024.f) + 1e-6f);
      float psum = 0.f;
#pragma unroll
      for (int nt = 0; nt < 8; nt += 2) {
        const int n = n0 + wc * 128 + g * 32 + nt * 4;
        f32x4 v0 = acc[mt][nt] * rs, v1 = acc[mt][nt + 1] * rs;
        psum += sum4sq(v0) + sum4sq(v1);
        u32x2 a = pack4(v0), b = pack4(v1);
        *(u32x4*)(z + (size_t)m * ZC + n) = u32x4{a.x, a.y, b.x, b.y};
      }
      const bool isq = (ntile == 8 && wc == 1) || ntile == 9;
      if (isq || ntile == 10) {
        psum = xor_sum(psum, 16);
        psum = xor_sum(psum, 32);
        if (g == 0) {
          if (isq) ((float*)(p.ws + WS_SSQ))[(size_t)m * 8 + (ntile == 8 ? 0 : 1 + wc)] = psum;
          else ((float*)(p.ws + WS_SSKV))[(size_t)m * 4 + wc] = psum;
        }
      }
    }
  }
  {
    const float* srcp = p.in[I_CLAT] + (size_t)l * 65536 * 256;
    u16* dst = (u16*)(p.ws + WS_LATB);
    unsigned* cq = (unsigned*)(p.ws + WS_CTR) + 28 + l;
    int* sjob = (int*)(s2 + 24576 - 16);
    const int tq = opaque_tid(wv);
    while (true) {
      WAIT_V(0);
      __syncthreads();
      if (tq == 0) *sjob = (int)atomicAdd(cq, 1u);
      __syncthreads();
      const int j = *sjob;
      if (j >= 1024) break;
#pragma unroll 1
      for (int it = 0; it < 8; ++it) {
        const size_t e = (((size_t)j * 8 + it) * 256 + tq) * 8;
        f32x4 a = ld4(srcp + e), b = ld4(srcp + e + 4);
        u32x2 pa = pack4(a), pb = pack4(b);
        *(u32x4*)(dst + e) = u32x4{pa.x, pa.y, pb.x, pb.y};
      }
    }
  }
}

DI void rwkv_prep_tile(const int wv, const Params& p, int l, int mtile, int h, char* s0, char* s1, char* s2) {
  int tid = opaque_tid(wv);
  const u16* z = (const u16*)(p.ws + WS_Z);
  char* sAw = s0;
  char* sAa = s1;
  char* sBw = s2;
  char* sBa = s2 + 64 * LDA;
  const int t0 = mtile * 128;
  __syncthreads();
  {
    const int c8 = (tid & 15) * 8;
#pragma unroll 1
    for (int i = 0; i < 8; ++i) {
      const int row = (tid >> 4) + 16 * i;
      f32x4 a = shifted4(p, l, t0 + row, C_WL + c8);
      f32x4 b = shifted4(p, l, t0 + row, C_WL + c8 + 4);
      if (c8 < 64) {
#pragma unroll
        for (int e = 0; e < 4; ++e) { a[e] = tanhf_(a[e]); b[e] = tanhf_(b[e]); }
      }
      u32x2 pa = pack4(a), pb = pack4(b);
      char* dst = (c8 < 64 ? sAw : sAa) + row * LDA + (c8 & 63) * 2;
      *(u32x4*)dst = u32x4{pa.x, pa.y, pb.x, pb.y};
    }
    const u16* w2 = (const u16*)(p.ws + WS_W2) + ((size_t)l * 512 + h * 64) * 64;
    const u16* a2 = (const u16*)(p.ws + WS_A2) + ((size_t)l * 512 + h * 64) * 64;
#pragma unroll
    for (int i = 0; i < 2; ++i) {
      const int row = (tid >> 3) + 32 * i, ch = tid & 7;
      const int crow = ((row >> 2) & 3) * 16 + (row >> 4) * 4 + (row & 3);
      *(u32x4*)(sBw + row * LDA + ch * 16) = *(const u32x4*)(w2 + crow * 64 + ch * 8);
      *(u32x4*)(sBa + row * LDA + ch * 16) = *(const u32x4*)(a2 + crow * 64 + ch * 8);
    }
  }
  __syncthreads();
  tid = opaque_tid(wv);
  const int lane = tid & 63, wave = tid >> 6, g = lane >> 4, c16 = lane & 15;
  f32x4 accw[2][4], acca[2][4];
#pragma unroll
  for (int mt = 0; mt < 2; ++mt)
#pragma unroll
    for (int nt = 0; nt < 4; ++nt) { accw[mt][nt] = f32x4{0, 0, 0, 0}; acca[mt][nt] = f32x4{0, 0, 0, 0}; }
  const int fo = c16 * LDA + g * 16;
#pragma unroll
  for (int ks = 0; ks < 2; ++ks) {
    bf16x8 xw[2], xa[2], ww[4], wa[4];
#pragma unroll
    for (int mt = 0; mt < 2; ++mt) {
      xw[mt] = *(const bf16x8*)(sAw + (wave * 32 + mt * 16) * LDA + fo + ks * 64);
      xa[mt] = *(const bf16x8*)(sAa + (wave * 32 + mt * 16) * LDA + fo + ks * 64);
    }
#pragma unroll
    for (int nt = 0; nt < 4; ++nt) {
      ww[nt] = *(const bf16x8*)(sBw + (nt * 16) * LDA + fo + ks * 64);
      wa[nt] = *(const bf16x8*)(sBa + (nt * 16) * LDA + fo + ks * 64);
    }
#pragma unroll
    for (int mt = 0; mt < 2; ++mt)
#pragma unroll
      for (int nt = 0; nt < 4; ++nt) {
        accw[mt][nt] = __builtin_amdgcn_mfma_f32_16x16x32_bf16(ww[nt], xw[mt], accw[mt][nt], 0, 0, 0);
        acca[mt][nt] = __builtin_amdgcn_mfma_f32_16x16x32_bf16(wa[nt], xa[mt], acca[mt][nt], 0, 0, 0);
      }
  }
  float* DEC = (float*)(p.ws + WS_DEC);
  u16* R = (u16*)(p.ws + WS_R);
  u16* KM = (u16*)(p.ws + WS_KM);
  u16* V = (u16*)(p.ws + WS_V);
  u16* NKK = (u16*)(p.ws + WS_NKK);
  u16* KKA = (u16*)(p.ws + WS_KKA);
#pragma unroll
  for (int mt = 0; mt < 2; ++mt) {
    const int t = t0 + wave * 32 + mt * 16 + c16;
    const int cb = h * 64 + g * 16;
    const size_t o = (size_t)t * 512 + cb;
    f32x4 k4[4], kk[4];
    {
      f32x4 r4[4];
      shifted16(p, l, t, C_R + cb, r4);
      u32x2 a = pack4(r4[0]), b = pack4(r4[1]), c = pack4(r4[2]), d = pack4(r4[3]);
      *(u32x4*)(R + o) = u32x4{a.x, a.y, b.x, b.y};
      *(u32x4*)(R + o + 8) = u32x4{c.x, c.y, d.x, d.y};
    }
    {
      f32x4 v4[4];
      shifted16(p, l, t, C_V + cb, v4);
      u32x2 a = pack4(v4[0]), b = pack4(v4[1]), c = pack4(v4[2]), d = pack4(v4[3]);
      *(u32x4*)(V + o) = u32x4{a.x, a.y, b.x, b.y};
      *(u32x4*)(V + o + 8) = u32x4{c.x, c.y, d.x, d.y};
    }
    shifted16(p, l, t, C_K + cb, k4);
    float ssq = 0.f;
#pragma unroll
    for (int nt = 0; nt < 4; ++nt) {
      const int c = cb + nt * 4;
      f32x4 a0 = ld4(p.in[I_A0] + l * 512 + c), w0 = ld4(p.in[I_W0] + l * 512 + c);
      f32x4 a, dec;
#pragma unroll
      for (int e = 0; e < 4; ++e) {
        a[e] = sigmoidf_(a0[e] + acca[mt][nt][e]);
        float x = -(w0[e] + accw[mt][nt][e]);
        float sp = fmaxf(x, 0.f) + __logf(1.f + __expf(-fabsf(x)));
        float w = -sp - 0.5f;
        dec[e] = __expf(-__expf(w));
      }
      acca[mt][nt] = a;
      *(f32x4*)(DEC + o + nt * 4) = dec;
      f32x4 k_k = ld4(p.in[I_KK] + l * 512 + c);
      kk[nt] = k4[nt] * k_k;
      ssq += sum4sq(kk[nt]);
    }
    ssq = xor_sum(ssq, 16);
    ssq = xor_sum(ssq, 32);
    const float inv = rsqrtf(fmaxf(ssq, 1e-24f));
    u32x2 pn[4], pa[4], pk[4];
#pragma unroll
    for (int nt = 0; nt < 4; ++nt) {
      const int c = cb + nt * 4;
      f32x4 k_a = ld4(p.in[I_KA] + l * 512 + c);
      f32x4 kn = kk[nt] * inv;
      f32x4 av = acca[mt][nt];
      f32x4 one = f32x4{1.f, 1.f, 1.f, 1.f};
      pn[nt] = pack4(-kn);
      pa[nt] = pack4(kn * av);
      pk[nt] = pack4(k4[nt] * (one + (av - one) * k_a));
    }
    *(u32x4*)(NKK + o) = u32x4{pn[0].x, pn[0].y, pn[1].x, pn[1].y};
    *(u32x4*)(NKK + o + 8) = u32x4{pn[2].x, pn[2].y, pn[3].x, pn[3].y};
    *(u32x4*)(KKA + o) = u32x4{pa[0].x, pa[0].y, pa[1].x, pa[1].y};
    *(u32x4*)(KKA + o + 8) = u32x4{pa[2].x, pa[2].y, pa[3].x, pa[3].y};
    *(u32x4*)(KM + o) = u32x4{pk[0].x, pk[0].y, pk[1].x, pk[1].y};
    *(u32x4*)(KM + o + 8) = u32x4{pk[2].x, pk[2].y, pk[3].x, pk[3].y};
    __builtin_amdgcn_sched_barrier(0);
  }
}

DI void q_tile(const int tid_, const Params& p, int l, int mtile, int h, char* s0, char* s1, char* s2) {
  const int tid = tid_, lane = tid & 63, wave = tid >> 6, g = lane >> 4, c16 = lane & 15;
  const int m0 = mtile * 128;
  f32x4 acc[2][8];
  gemm_ring<128, 128, 4, 1, 8>(tid_, (const u16*)(p.ws + WS_Z) + (size_t)m0 * ZC + C_QC, ZC,
                             (const u16*)(p.ws + WS_WUQ) + ((size_t)l * 768 + h * 96) * 384, 384, 767 - h * 96, 12, s0, s1, s2, acc);
  u16* Q = (u16*)(p.ws + WS_Q);
  const float qscale = 0.14724576f;
#pragma unroll
  for (int mt = 0; mt < 2; ++mt) {
    const int ml = wave * 32 + mt * 16 + c16;
    const int t = m0 + ml;
    float rs;
    {
      const float* sq = (const float*)(p.ws + WS_SSQ) + (size_t)t * 8;
      rs = rsqrtf((sq[0] + sq[1] + sq[2]) * (1.f / 384.f) + 1e-6f);
    }
    float ssn = 0.f, ssr = 0.f;
#pragma unroll
    for (int nt = 0; nt < 6; ++nt) {
      acc[mt][nt] *= rs;
      float s = acc[mt][nt][0] * acc[mt][nt][0] + acc[mt][nt][1] * acc[mt][nt][1] + acc[mt][nt][2] * acc[mt][nt][2] + acc[mt][nt][3] * acc[mt][nt][3];
      if (nt < 4) ssn += s; else ssr += s;
    }
    ssn = xor_sum(ssn, 16); ssn = xor_sum(ssn, 32);
    ssr = xor_sum(ssr, 16); ssr = xor_sum(ssr, 32);
    const float rn = rsqrtf(ssn * (1.f / 64.f) + 1e-6f) * qscale;
    const float rr = rsqrtf(ssr * (1.f / 32.f) + 1e-6f) * qscale;
    u16* qrow = Q + (size_t)t * 768 + h * 96;
#pragma unroll
    for (int nt = 0; nt < 4; ++nt) {
      const int n = nt * 16 + g * 4;
      f32x4 gw = ld4(p.in[I_QNN] + l * 64 + n);
      *(u32x2*)(qrow + n) = pack4(acc[mt][nt] * gw * rn);
    }
    const int pos = tok_pos(t);
    const int j0 = g * 4;
    f32x4 g1 = ld4(p.in[I_QNR] + l * 32 + j0), g2 = ld4(p.in[I_QNR] + l * 32 + 16 + j0);
    f32x4 o1, o2;
#pragma unroll
    for (int e = 0; e < 4; ++e) {
      float c, s;
      rope_cs(pos, j0 + e, c, s);
      float x1 = acc[mt][4][e] * g1[e] * rr, x2 = acc[mt][5][e] * g2[e] * rr;
      o1[e] = x1 * c - x2 * s;
      o2[e] = x1 * s + x2 * c;
    }
    *(u32x2*)(qrow + 64 + j0) = pack4(o1);
    *(u32x2*)(qrow + 80 + j0) = pack4(o2);
  }
}

DI void kv_tile(const int tid_, const Params& p, int l, int mtile, int h, char* s0, char* s1, char* s2) {
  const int tid = tid_, lane = tid & 63, wave = tid >> 6, g = lane >> 4, c16 = lane & 15;
  f32x4 acc[2][8];
  const bool past = mtile >= 261;
  const int m0 = past ? (mtile - 261) * 128 : mtile * 128;
  if (!past) {
    gemm_ring<128, 128, 4, 1, 4>(tid_, (const u16*)(p.ws + WS_Z) + (size_t)m0 * ZC + C_CKV, ZC,
                               (const u16*)(p.ws + WS_WKVF) + ((size_t)l * 1024 + h * 128) * 256, 256, 127, 8, s0, s1, s2, acc);
  } else {
    gemm_ring<128, 128, 4, 1, 4>(tid_, (const u16*)(p.ws + WS_LATB) + (size_t)m0 * 256, 256,
                               (const u16*)(p.ws + WS_WKVP) + ((size_t)l * 1024 + h * 128) * 256, 256, 127, 8, s0, s1, s2, acc);
  }
  u16 *KN, *VT;
  int skv;
  if (!past && m0 < TP) { KN = (u16*)(p.ws + WS_KP); VT = (u16*)(p.ws + WS_VTP); skv = LP; }
  else { KN = (u16*)(p.ws + WS_KS); VT = (u16*)(p.ws + WS_VTS); skv = SK; }
#pragma unroll
  for (int mt = 0; mt < 2; ++mt) {
    {
      const int ml = wave * 32 + mt * 16 + c16;
      const int r = m0 + ml;
      float rs = 1.f;
      if (!past) { f32x4 s0 = ld4((const float*)(p.ws + WS_SSKV) + (size_t)r * 4); rs = rsqrtf((s0[0] + s0[1]) * (1.f / 256.f) + 1e-6f); }
      size_t krow;
      if (past) krow = (size_t)(r >> 11) * SK + (r & 2047);
      else if (r < TP) krow = r;
      else { int s = r - TP; krow = (size_t)(s >> 4) * SK + 2048 + (s & 15); }
      float ss = 0.f;
#pragma unroll
      for (int nt = 0; nt < 4; ++nt) {
        acc[mt][nt] *= rs;
        ss += acc[mt][nt][0] * acc[mt][nt][0] + acc[mt][nt][1] * acc[mt][nt][1] + acc[mt][nt][2] * acc[mt][nt][2] + acc[mt][nt][3] * acc[mt][nt][3];
      }
      ss = xor_sum(ss, 16); ss = xor_sum(ss, 32);
      const float rn = rsqrtf(ss * (1.f / 64.f) + 1e-6f);
#pragma unroll
      for (int nt = 0; nt < 4; ++nt) {
        const int n = nt * 16 + g * 4;
        f32x4 gw = ld4(p.in[I_KNN] + l * 64 + n);
        *(u32x2*)(KN + krow * 512 + h * 64 + n) = pack4(acc[mt][nt] * gw * rn);
      }
    }
    {
      const int mlb = wave * 32 + mt * 16 + g * 4;
      const int r = m0 + mlb;
      f32x4 rs4 = f32x4{1.f, 1.f, 1.f, 1.f};
      if (!past) {
        const float* sk = (const float*)(p.ws + WS_SSKV) + (size_t)r * 4;
#pragma unroll
        for (int e = 0; e < 4; ++e) { f32x4 s0 = ld4(sk + e * 4); rs4[e] = rsqrtf((s0[0] + s0[1]) * (1.f / 256.f) + 1e-6f); }
      }
      size_t vrow;
      if (past) vrow = ((size_t)((r >> 11) * 8 + h) * 64) * SK + (r & 2047);
      else if (r < TP) { int b = r / LP; vrow = ((size_t)(b * 8 + h) * 64) * LP + (r - b * LP); }
      else { int s = r - TP; vrow = ((size_t)((s >> 4) * 8 + h) * 64) * SK + 2048 + (s & 15); }
#pragma unroll
      for (int nt = 4; nt < 8; ++nt) {
        const int dv = (nt - 4) * 16 + c16;
        *(u32x2*)(VT + vrow + (size_t)dv * skv) = pack4(acc[mt][nt] * rs4);
      }
    }
  }
}

DI void lat_job(const int tid_, const Params& p, int l, int job) {
  const int tid = tid_, lane = tid & 63, wave = tid >> 6;
  const u16* z = (const u16*)(p.ws + WS_Z);
  for (int q = 0; q < 8; ++q) {
    const int t = job * 32 + wave * 8 + q;
    float* lat_out; float* kr_out; u16* kr_bf;
    if (t < TP) {
      int b = t / LP, i = t - b * LP;
      lat_out = p.out + O_LATP + ((size_t)(l * 8 + b) * LP + i) * 256;
      kr_out = p.out + O_KRP + ((size_t)(l * 8 + b) * LP + i) * 32;
      kr_bf = (u16*)(p.ws + WS_KRP) + (size_t)t * 32;
    } else {
      int s = t - TP, sb = s >> 4, j = s & 15;
      lat_out = p.out + O_LATN + ((size_t)(l * 32 + sb) * 16 + j) * 256;
      kr_out = p.out + O_KRN + ((size_t)(l * 32 + sb) * 16 + j) * 32;
      kr_bf = (u16*)(p.ws + WS_KRS) + ((size_t)sb * SK + 2048 + j) * 32;
    }
    f32x4 x = unpack4(*(const u32x2*)(z + (size_t)t * ZC + C_CKV + lane * 4));
    float ss = x[0] * x[0] + x[1] * x[1] + x[2] * x[2] + x[3] * x[3];
#pragma unroll
    for (int m = 1; m < 64; m <<= 1) ss = xor_sum(ss, m);
    float rs = rsqrtf(ss * (1.f / 256.f) + 1e-6f);
    f32x4 gw = ld4(p.in[I_KVNORM] + l * 256 + lane * 4);
    *(f32x4*)(lat_out + lane * 4) = x * rs * gw;
    float x1 = 0.f, x2 = 0.f;
    if (lane < 16) { x1 = bf2f(z[(size_t)t * ZC + C_KR + lane]); x2 = bf2f(z[(size_t)t * ZC + C_KR + 16 + lane]); }
    float s2 = x1 * x1 + x2 * x2;
#pragma unroll
    for (int m = 1; m < 64; m <<= 1) s2 = xor_sum(s2, m);
    float r2 = rsqrtf(s2 * (1.f / 32.f) + 1e-6f);
    if (lane < 16) {
      float y1 = x1 * r2 * p.in[I_KNR][l * 32 + lane], y2 = x2 * r2 * p.in[I_KNR][l * 32 + 16 + lane];
      float c, s;
      rope_cs(tok_pos(t), lane, c, s);
      float o1 = y1 * c - y2 * s, o2 = y1 * s + y2 * c;
      kr_out[lane] = o1; kr_out[16 + lane] = o2;
      kr_bf[lane] = (u16)(pack2(o1, 0.f) & 0xffffu);
      kr_bf[16 + lane] = (u16)(pack2(o2, 0.f) & 0xffffu);
    }
  }
}
DI void pastkr_job(const int tid_, const Params& p, int l, int job) {
  const int tid = tid_;
  const int r = job * 64 + (tid >> 2), c = (tid & 3) * 8;
  const float* src = p.in[I_CKR] + ((size_t)l * 65536 + r) * 32 + c;
  f32x4 a = ld4(src), b = ld4(src + 4);
  u32x2 pa = pack4(a), pb = pack4(b);
  u16* dst = (u16*)(p.ws + WS_KRS) + ((size_t)(r >> 11) * SK + (r & 2047)) * 32 + c;
  *(u32x4*)dst = u32x4{pa.x, pa.y, pb.x, pb.y};
}
DI void shiftrow_job(const int tid_, const Params& p, int l, int job) {
  const u16* z = (const u16*)(p.ws + WS_Z);
  int t; float* dst;
  if (job < 8) { t = job * LP + LP - 1; dst = p.out + O_SHP + (size_t)(l * 8 + job) * 2176; }
  else { int sb = job - 8; t = TP + sb * 16 + 15; dst = p.out + O_SHS + (size_t)(l * 32 + sb) * 2176; }
  for (int c = tid_; c < 2176; c += 256) dst[c] = bf2f(z[(size_t)t * ZC + c]);
}

DI void phase2(const XcdMap xm, const int wv, const Params& p0, int l, char* s0, char* s1, char* s2, int mask = 12) {
  if (mask & 4) { const int tid_ = opaque_tid(wv); const Params p = load_params(p0);
    int m_start, m_cnt; const int total = xcd_total(xm, 261, 8, m_start, m_cnt);
    for (int t = xm.rank; t < total; t += xm.nlb) { int mt_, nt_; xcd_tile(t, m_start, m_cnt, 8, mt_, nt_); rwkv_prep_tile(wv, p, l, mt_, nt_, s0, s1, s2); } }
  if (mask & 8) { const int tid_ = opaque_tid(wv); const Params p = load_params(p0);
#pragma unroll 1
    for (int job = opaque_bid(); job < 1044; job += gridDim.x) lat_job(tid_, p, l, job);
#pragma unroll 1
    for (int job = opaque_bid(); job < 1024; job += gridDim.x) pastkr_job(tid_, p, l, job);
#pragma unroll 1
    for (int job = opaque_bid(); job < 40; job += gridDim.x) shiftrow_job(tid_, p, l, job);
    if (l < 3) {
      unsigned* wq = (unsigned*)(p.ws + WS_CTR) + 24 + l;
      int* sjob = (int*)(s2 + 24576 - 16);
      while (true) {
        __syncthreads();
        if (tid_ == 0) *sjob = (int)atomicAdd(wq, 1u);
        __syncthreads();
        const int j = *sjob;
        if (j >= 2040) break;
        wprep_job(opaque_tid(wv), p, l + 1, j, s0, s1, s2);
      }
    } }
}

DI float row_allreduce(float x) {
  x += __int_as_float(__builtin_amdgcn_update_dpp(0, __float_as_int(x), 0x128, 0xf, 0xf, false));
  x += __int_as_float(__builtin_amdgcn_update_dpp(0, __float_as_int(x), 0x124, 0xf, 0xf, false));
  x += __int_as_float(__builtin_amdgcn_update_dpp(0, __float_as_int(x), 0x122, 0xf, 0xf, false));
  x += __int_as_float(__builtin_amdgcn_update_dpp(0, __float_as_int(x), 0x121, 0xf, 0xf, false));
  return x;
}

struct ScanRegs { f32x4 d; u32x4 a0, a1; u16 v; };

DI void scan_gload(const int tid_, ScanRegs& r, const Params& p, int tokc, int h, int rg) {
  const int tid = tid_;
  const float* DEC = (const float*)(p.ws + WS_DEC);
  const u16* V = (const u16*)(p.ws + WS_V);
  {
    int st = tid >> 4, c = tid & 15;
    r.d = ld4(DEC + (size_t)(tokc + st) * 512 + h * 64 + c * 4);
    r.v = V[(size_t)(tokc + st) * 512 + h * 64 + rg * 16 + c];
  }
  {
    int arr = tid >> 7, idx = tid & 127, st = idx >> 3, c8 = idx & 7;
    size_t off = (size_t)(tokc + st) * 512 + h * 64 + c8 * 8;
    const u16* s0 = (const u16*)(p.ws + (arr ? WS_KKA : WS_NKK));
    const u16* s1 = (const u16*)(p.ws + (arr ? WS_R : WS_KM));
    r.a0 = *(const u32x4*)(s0 + off);
    r.a1 = *(const u32x4*)(s1 + off);
  }
}
DI void scan_lstore(const int tid_, const ScanRegs& r, float* buf) {
  const int tid = tid_;
  {
    int st = tid >> 4, c = tid & 15;
    *(f32x4*)(buf + st * 64 + c * 4) = r.d;
    buf[5120 + st * 16 + c] = bf2f(r.v);
  }
  {
    int arr = tid >> 7, idx = tid & 127, st = idx >> 3, c8 = idx & 7;
    float* d0 = buf + 1024 + arr * 1024 + st * 64 + c8 * 8;
    float* d1 = buf + 3072 + arr * 1024 + st * 64 + c8 * 8;
    *(f32x4*)(d0) = unpack4(u32x2{r.a0.x, r.a0.y});
    *(f32x4*)(d0 + 4) = unpack4(u32x2{r.a0.z, r.a0.w});
    *(f32x4*)(d1) = unpack4(u32x2{r.a1.x, r.a1.y});
    *(f32x4*)(d1 + 4) = unpack4(u32x2{r.a1.z, r.a1.w});
  }
}

template <int CTRL> DI float dpp_get(float x) { return __int_as_float(__builtin_amdgcn_update_dpp(0, __float_as_int(x), CTRL, 0xf, 0xf, false)); }
DI void scan_chunk(const float* buf, f32x4& S, int w, int rw, int kg, float& ys) {
  float yp[16];
#pragma unroll
  for (int s = 0; s < 16; ++s) {
    const float* b = buf + s * 64 + kg * 4;
    f32x4 d = *(const f32x4*)(b), n = *(const f32x4*)(b + 1024), a = *(const f32x4*)(b + 2048), k = *(const f32x4*)(b + 3072),
          r = *(const f32x4*)(b + 4096);
    float vv = buf[5120 + s * 16 + w * 4 + rw];
    float pp = S[0] * n[0];
    pp = fmaf(S[1], n[1], pp); pp = fmaf(S[2], n[2], pp); pp = fmaf(S[3], n[3], pp);
    float sa = row_allreduce(pp);
#pragma unroll
    for (int e = 0; e < 4; ++e) S[e] = fmaf(sa, a[e], fmaf(S[e], d[e], vv * k[e]));
    float y = S[0] * r[0];
    y = fmaf(S[1], r[1], y); y = fmaf(S[2], r[2], y); y = fmaf(S[3], r[3], y);
    yp[s] = y;
  }
  const bool b3 = (kg & 8) != 0, b2 = (kg & 4) != 0, b1 = (kg & 2) != 0, b0 = (kg & 1) != 0;
  float t[8], u[4], v2[2];
#pragma unroll
  for (int j = 0; j < 8; ++j) { float keep = b3 ? yp[j + 8] : yp[j], send = b3 ? yp[j] : yp[j + 8]; t[j] = keep + dpp_get<0x140>(send); }
#pragma unroll
  for (int j = 0; j < 4; ++j) { float keep = b2 ? t[j + 4] : t[j], send = b2 ? t[j] : t[j + 4]; u[j] = keep + dpp_get<0x141>(send); }
#pragma unroll
  for (int j = 0; j < 2; ++j) { float keep = b1 ? u[j + 2] : u[j], send = b1 ? u[j] : u[j + 2]; v2[j] = keep + dpp_get<0x4E>(send); }
  { float keep = b0 ? v2[1] : v2[0], send = b0 ? v2[0] : v2[1]; ys = keep + dpp_get<0xB1>(send); }
}

DI void scan_job(const int tid_, const Params& p, int l, int job, char* s0, char* s1, char* s2) {
  const int tid = tid_, lane = tid & 63, w = tid >> 6, rw = lane >> 4, kg = lane & 15;
  int h, tok0, nchunks, rg;
  float* sout;
  f32x4 S;
  rg = job & 3;
  const int row = rg * 16 + w * 4 + rw;
  if (job < 256) {
    int seq = job >> 2, b = seq >> 3; h = seq & 7;
    tok0 = b * LP; nchunks = LP / 16;
    sout = p.out + O_SRP + ((((size_t)l * 8 + b) * 8 + h) * 64 + row) * 64 + kg * 4;
    S = f32x4{0.f, 0.f, 0.f, 0.f};
  } else {
    int seq = (job - 256) >> 2, sb = seq >> 3; h = seq & 7;
    tok0 = TP + sb * 16; nchunks = 1;
    sout = p.out + O_SRS + ((((size_t)l * 32 + sb) * 8 + h) * 64 + row) * 64 + kg * 4;
    S = ld4(p.in[I_SRWKV] + ((((size_t)l * 32 + sb) * 8 + h) * 64 + row) * 64 + kg * 4);
  }
  float* buf0 = (float*)s0;
  float* buf1 = (float*)s1;
  float* Y = p.out + O_YP;
  ScanRegs A, B;
  __syncthreads();
  __builtin_amdgcn_s_setprio(3);
  scan_gload(tid_, A, p, tok0, h, rg);
  scan_lstore(tid_, A, buf0);
  if (nchunks > 1) scan_gload(tid_, A, p, tok0 + 16, h, rg);
  __syncthreads();
  for (int c = 0; c < nchunks; c += 2) {
    if (c + 2 < nchunks) scan_gload(tid_, B, p, tok0 + (c + 2) * 16, h, rg);
    float ys = 0.f;
    scan_chunk(buf0, S, w, rw, kg, ys);
    Y[(size_t)(tok0 + c * 16 + kg) * 512 + h * 64 + row] = ys;
    if (c + 1 < nchunks) scan_lstore(tid_, A, buf1);
    __syncthreads();
    if (c + 1 < nchunks) {
      if (c + 3 < nchunks) scan_gload(tid_, A, p, tok0 + (c + 3) * 16, h, rg);
      ys = 0.f;
      scan_chunk(buf1, S, w, rw, kg, ys);
      Y[(size_t)(tok0 + (c + 1) * 16 + kg) * 512 + h * 64 + row] = ys;
      if (c + 2 < nchunks) scan_lstore(tid_, B, buf0);
      __syncthreads();
    }
  }
  *(f32x4*)sout = S;
  __builtin_amdgcn_s_setprio(0);
}

DI void attn_item(const int tid_, const Params& p, int l, int item, char* s0, char* s1, char* s2) {
  const int tid = tid_, lane = tid & 63, w = tid >> 6, g = lane >> 4, c16 = lane & 15;
  int h, qtok0, nq, ntiles, vis, kmode, skv;
  const u16 *KN, *KR, *VT;
  if (item < 256) {
    int sb = item >> 3; h = item & 7;
    qtok0 = TP + sb * 16; nq = 16; ntiles = 33; vis = (w == 0) ? 33 : 0; kmode = 1; skv = SK;
    KN = (const u16*)(p.ws + WS_KS) + (size_t)sb * SK * 512;
    KR = (const u16*)(p.ws + WS_KRS) + (size_t)sb * SK * 32;
    VT = (const u16*)(p.ws + WS_VTS) + (size_t)(sb * 8 + h) * 64 * SK;
  } else {
    int b;
    if (item < 2304) {
      int idx = item - 256, m = 31 - (idx >> 6), bh = idx & 63;
      b = bh >> 3; h = bh & 7;
      qtok0 = b * LP + 16 + 128 * m; nq = 128; ntiles = 2 * m + 3; vis = (w < 2) ? 2 * m + 2 : 2 * m + 3;
    } else {
      int bh = item - 2304;
      b = bh >> 3; h = bh & 7;
      qtok0 = b * LP; nq = 16; ntiles = 1; vis = (w == 0) ? 1 : 0;
    }
    kmode = 0; skv = LP;
    KN = (const u16*)(p.ws + WS_KP) + (size_t)b * LP * 512;
    KR = (const u16*)(p.ws + WS_KRP) + (size_t)b * LP * 32;
    VT = (const u16*)(p.ws + WS_VTP) + (size_t)(b * 8 + h) * 64 * LP;
  }
  const u16* Q = (const u16*)(p.ws + WS_Q);
  bf16x8 qf[2][3];
#pragma unroll
  for (int nt = 0; nt < 2; ++nt) {
    int ql = w * 32 + nt * 16 + c16;
    ql = ql < nq ? ql : nq - 1;
#pragma unroll
    for (int ks = 0; ks < 3; ++ks) qf[nt][ks] = *(const bf16x8*)(Q + (size_t)(qtok0 + ql) * 768 + h * 96 + ks * 32 + g * 8);
  }
  u32x4 kr[3], vr[2];
  auto tile_info = [&](int kt, int& key0, int& nvalid) {
    if (kmode == 0) { if (kt == 0) { key0 = 0; nvalid = 16; } else { key0 = 16 + 64 * (kt - 1); nvalid = 64; } }
    else { key0 = 64 * kt; nvalid = (kt == 32) ? 16 : 64; }
  };
  auto gload = [&](int kt) {
    int key0, nvalid;
    tile_info(kt, key0, nvalid);
#pragma unroll
    for (int i = 0; i < 3; ++i) {
      int idx = tid + 256 * i, row = idx / 12, ch = idx - row * 12;
      const u16* src = (ch < 8) ? KN + (size_t)(key0 + row) * 512 + h * 64 + ch * 8 : KR + (size_t)(key0 + row) * 32 + (ch - 8) * 8;
      kr[i] = (row < nvalid) ? *(const u32x4*)src : u32x4{0, 0, 0, 0};
    }
#pragma unroll
    for (int i = 0; i < 2; ++i) {
      int idx = tid + 256 * i, dv = idx >> 3, ch = idx & 7;
      vr[i] = (ch * 8 < nvalid) ? *(const u32x4*)(VT + (size_t)dv * skv + key0 + ch * 8) : u32x4{0, 0, 0, 0};
    }
  };
  auto lstore = [&](char* buf) {
#pragma unroll
    for (int i = 0; i < 3; ++i) {
      int idx = tid + 256 * i, row = idx / 12, ch = idx - row * 12;
      *(u32x4*)(buf + row * 208 + ch * 16) = kr[i];
    }
#pragma unroll
    for (int i = 0; i < 2; ++i) {
      int idx = tid + 256 * i, dv = idx >> 3, ch = idx & 7;
      *(u32x4*)(buf + 64 * 208 + dv * LDA + ch * 16) = vr[i];
    }
  };
  constexpr int BUFSZ = 64 * 208 + 64 * LDA;
  f32x4 o[4][2];
  float mrow[2], lsum[2];
#pragma unroll
  for (int nt = 0; nt < 2; ++nt) {
    mrow[nt] = -1e30f; lsum[nt] = 0.f;
#pragma unroll
    for (int dt = 0; dt < 4; ++dt) o[dt][nt] = f32x4{0, 0, 0, 0};
  }
  __syncthreads();
  gload(0);
  lstore(s0);
  if (ntiles > 1) gload(1);
  __syncthreads();
  for (int kt = 0; kt < ntiles; ++kt) {
    char* cur = (kt & 1) ? s1 : s0;
    if (kt + 1 < ntiles) {
      lstore(((kt + 1) & 1) ? s1 : s0);
      if (kt + 2 < ntiles) gload(kt + 2);
    }
    if (kt < vis) {
      int key0, nvalid;
      tile_info(kt, key0, nvalid);
      f32x4 s[4][2];
#pragma unroll
      for (int mt = 0; mt < 4; ++mt)
#pragma unroll
        for (int nt = 0; nt < 2; ++nt) s[mt][nt] = f32x4{0, 0, 0, 0};
#pragma unroll
      for (int ks = 0; ks < 3; ++ks)
#pragma unroll
        for (int mt = 0; mt < 4; ++mt) {
          bf16x8 kf = *(const bf16x8*)(cur + (mt * 16 + c16) * 208 + ks * 64 + g * 16);
#pragma unroll
          for (int nt = 0; nt < 2; ++nt) s[mt][nt] = __builtin_amdgcn_mfma_f32_16x16x32_bf16(kf, qf[nt][ks], s[mt][nt], 0, 0, 0);
        }
      if (nvalid < 64) {
#pragma unroll
        for (int mt = 0; mt < 4; ++mt)
#pragma unroll
          for (int nt = 0; nt < 2; ++nt)
#pragma unroll
            for (int e = 0; e < 4; ++e)
              if (mt * 16 + g * 4 + e >= nvalid) s[mt][nt][e] = -1e30f;
      }
      bf16x8 pf[2][2];
#pragma unroll
      for (int nt = 0; nt < 2; ++nt) {
        float mx = -1e30f;
#pragma unroll
        for (int mt = 0; mt < 4; ++mt)
#pragma unroll
          for (int e = 0; e < 4; ++e) mx = fmaxf(mx, s[mt][nt][e]);
        mx = xmax16(mx);
        mx = xmax32(mx);
        const float mnew = fmaxf(mrow[nt], mx);
        const float alpha = __builtin_amdgcn_exp2f(mrow[nt] - mnew);
        mrow[nt] = mnew;
        float ps = 0.f;
#pragma unroll
        for (int mt = 0; mt < 4; ++mt)
#pragma unroll
          for (int e = 0; e < 4; ++e) {
            float pv = __builtin_amdgcn_exp2f(s[mt][nt][e] - mnew);
            s[mt][nt][e] = pv;
            ps += pv;
          }
        lsum[nt] = lsum[nt] * alpha + ps;
        if (__builtin_amdgcn_ballot_w64(alpha != 1.f) != 0ull) {
#pragma unroll
          for (int dt = 0; dt < 4; ++dt) o[dt][nt] *= alpha;
        }
#pragma unroll
        for (int kk = 0; kk < 2; ++kk) {
          u32x2 lo = pack4(s[2 * kk][nt]), hi = pack4(s[2 * kk + 1][nt]);
          u32x4 pk = u32x4{lo.x, lo.y, hi.x, hi.y};
          pf[nt][kk] = __builtin_bit_cast(bf16x8, pk);
        }
      }
      const char* sV = cur + 64 * 208;
#pragma unroll
      for (int dt = 0; dt < 4; ++dt)
#pragma unroll
        for (int kk = 0; kk < 2; ++kk) {
          u32x2 lo = *(const u32x2*)(sV + (dt * 16 + c16) * LDA + (kk * 32 + g * 4) * 2);
          u32x2 hi = *(const u32x2*)(sV + (dt * 16 + c16) * LDA + (kk * 32 + 16 + g * 4) * 2);
          u32x4 pk = u32x4{lo.x, lo.y, hi.x, hi.y};
          bf16x8 vf = __builtin_bit_cast(bf16x8, pk);
#pragma unroll
          for (int nt = 0; nt < 2; ++nt) o[dt][nt] = __builtin_amdgcn_mfma_f32_16x16x32_bf16(vf, pf[nt][kk], o[dt][nt], 0, 0, 0);
        }
    }
    __syncthreads();
  }
  const u16* z = (const u16*)(p.ws + WS_Z);
  u16* YB = (u16*)(p.ws + WS_YB);
#pragma unroll
  for (int nt = 0; nt < 2; ++nt) {
    float lt = lsum[nt];
    lt = xsum16(lt);
    lt = xsum32(lt);
    const int ql = w * 32 + nt * 16 + c16;
    if (ql < nq && vis > 0) {
      const float il = 1.f / lt;
      const int tok = qtok0 + ql;
#pragma unroll
      for (int dt = 0; dt < 4; ++dt) {
        const int dv = dt * 16 + g * 4;
        f32x4 gt = unpack4(*(const u32x2*)(z + (size_t)tok * ZC + C_GB + h * 64 + dv));
        f32x4 ov = o[dt][nt] * il;
#pragma unroll
        for (int e = 0; e < 4; ++e) ov[e] *= siluf_(gt[e]);
        *(u32x2*)(YB + (size_t)tok * 512 + h * 64 + dv) = pack4(ov);
      }
    }
  }
}

DI void phase3(const int wv, const Params& p0, int l, char* s0, char* s1, char* s2, int coff, int mode = 0) {
  const Params p = load_params(p0);
  const int tid_ = opaque_tid(wv);
  unsigned* ctr = (unsigned*)(p.ws + WS_CTR) + l + coff;
  unsigned* done = (unsigned*)(p.ws + WS_CTR) + 8 + l + coff;
  unsigned* scanq = (unsigned*)(p.ws + WS_CTR) + 16 + l + coff;
  int* sjob = (int*)(s2 + 24576 - 16);
  __syncthreads();
  if (tid_ == 0) {
    const unsigned hw = (unsigned)__builtin_amdgcn_s_getreg((31 << 11) | 4);
    const unsigned key = ((xb_xcc_id_early() & 15u) << 8) | ((hw >> 8) & 0xffu);
    unsigned* cue = (unsigned*)(p.ws + WS_CUE) + (size_t)(l + coff) * 4096 + key;
    int j = -1;
    if (add_agent(cue, 1u) == 0u) { const unsigned q = add_agent(scanq, 1u); if (q < 256u) j = (int)q; }
    *sjob = j;
  }
  __syncthreads();
  {
    const int j = *sjob;
    if (j >= 0 && mode != 2) scan_job(opaque_tid(wv), p, l, j, s0, s1, s2);
  }
  constexpr int NQJ = 261 * 2;
  constexpr int J_Q = 773, J_AT = J_Q + NQJ, J_LS = J_AT + 2368, J_SS = J_LS + 256, NJ = J_SS + 1024;
  bool ready = false;
  while (true) {
    __syncthreads();
    if (tid_ == 0) *sjob = (int)atomicAdd(ctr, 1u);
    __syncthreads();
    const int job = *sjob;
    if (job >= NJ) break;
    const int tj = opaque_tid(wv);
    if (job < J_AT) {
      if (job < J_Q) {
#pragma unroll 1
        for (int h = 0; h < 8; ++h) kv_tile(opaque_tid(wv), p, l, job, h, s0, s1, s2);
      } else {
        const int jq = job - J_Q;
#pragma unroll 1
        for (int h = 0; h < 4; ++h) q_tile(opaque_tid(wv), p, l, jq >> 1, (jq & 1) * 4 + h, s0, s1, s2);
      }
      asm volatile("s_waitcnt vmcnt(0)" ::: "memory");
      __syncthreads();
      if (tj == 0) {
        __builtin_amdgcn_fence(__ATOMIC_RELEASE, "agent");
        asm volatile("s_waitcnt vmcnt(0)" ::: "memory");
        add_agent(done, 1u);
      }
    } else if (job < J_LS) {
      if (!ready) {
        if (tj == 0) { while (ld_agent(done) < (unsigned)(773 + NQJ)) __builtin_amdgcn_s_sleep(4); }
        __syncthreads();
        __builtin_amdgcn_fence(__ATOMIC_ACQUIRE, "agent");
        asm volatile("s_waitcnt vmcnt(0)" ::: "memory");
        ready = true;
      }
      if (mode != 1) attn_item(tj, p, l, job - J_AT, s0, s1, s2);
    } else if (job < J_SS) {
      __syncthreads();
      if (tj == 0) { const unsigned q = add_agent(scanq, 1u); *sjob = (q < 256u) ? (int)q : -1; }
      __syncthreads();
      const int j = *sjob;
      if (j >= 0 && mode != 2) scan_job(opaque_tid(wv), p, l, j, s0, s1, s2);
    } else { if (mode != 2) scan_job(tj, p, l, 256 + (job - J_SS), s0, s1, s2); }
  }
}

DI void phase3b(const int wv, const Params& p0, int l) {
  const Params p = load_params(p0);
  const int tid_ = opaque_tid(wv);
  const int tid = tid_, lane = tid & 63, wave = tid >> 6;
  const float* Y = p.out + O_YP;
  const u16* R = (const u16*)(p.ws + WS_R);
  const u16* KM = (const u16*)(p.ws + WS_KM);
  const u16* V = (const u16*)(p.ws + WS_V);
  u16* YA = (u16*)(p.ws + WS_YA);
  for (int job = opaque_bid(); job < 4176; job += gridDim.x) {
    for (int q = 0; q < 2; ++q) {
      const int t = job * 8 + wave * 2 + q;
      const int c = lane * 8;
      const size_t o = (size_t)t * 512 + c;
      f32x4 y0 = ld4(Y + o), y1 = ld4(Y + o + 4);
      float s = y0[0] + y0[1] + y0[2] + y0[3] + y1[0] + y1[1] + y1[2] + y1[3];
      s = xor_sum(s, 1); s = xor_sum(s, 2); s = xor_sum(s, 4);
      const float mu = s * (1.f / 64.f);
      f32x4 d0 = y0 - mu, d1 = y1 - mu;
      float vs = d0[0] * d0[0] + d0[1] * d0[1] + d0[2] * d0[2] + d0[3] * d0[3] + d1[0] * d1[0] + d1[1] * d1[1] + d1[2] * d1[2] + d1[3] * d1[3];
      vs = xor_sum(vs, 1); vs = xor_sum(vs, 2); vs = xor_sum(vs, 4);
      const float rstd = rsqrtf(vs * (1.f / 64.f) + 64e-5f);
      u32x4 rw = *(const u32x4*)(R + o), kw = *(const u32x4*)(KM + o), vw = *(const u32x4*)(V + o);
      f32x4 r0 = unpack4(u32x2{rw.x, rw.y}), r1 = unpack4(u32x2{rw.z, rw.w});
      f32x4 k0 = unpack4(u32x2{kw.x, kw.y}), k1 = unpack4(u32x2{kw.z, kw.w});
      f32x4 v0 = unpack4(u32x2{vw.x, vw.y}), v1 = unpack4(u32x2{vw.z, vw.w});
      f32x4 rk0 = ld4(p.in[I_RK] + l * 512 + c), rk1 = ld4(p.in[I_RK] + l * 512 + c + 4);
      f32x4 b0 = r0 * k0 * rk0, b1 = r1 * k1 * rk1;
      float bs = b0[0] + b0[1] + b0[2] + b0[3] + b1[0] + b1[1] + b1[2] + b1[3];
      bs = xor_sum(bs, 1); bs = xor_sum(bs, 2); bs = xor_sum(bs, 4);
      f32x4 lw0 = ld4(p.in[I_LNW] + l * 512 + c), lw1 = ld4(p.in[I_LNW] + l * 512 + c + 4);
      f32x4 lb0 = ld4(p.in[I_LNB] + l * 512 + c), lb1 = ld4(p.in[I_LNB] + l * 512 + c + 4);
      f32x4 g0 = shifted4(p, l, t, C_G + c), g1 = shifted4(p, l, t, C_G + c + 4);
      f32x4 o0 = d0 * rstd * lw0 + lb0 + v0 * bs;
      f32x4 o1 = d1 * rstd * lw1 + lb1 + v1 * bs;
#pragma unroll
      for (int e = 0; e < 4; ++e) { o0[e] *= siluf_(g0[e]); o1[e] *= siluf_(g1[e]); }
      u32x2 pa = pack4(o0), pb = pack4(o1);
      *(u32x4*)(YA + o) = u32x4{pa.x, pa.y, pb.x, pb.y};
    }
  }
}

DI void phase4(const XcdMap xm, const int wv, const Params& p0, int l, char* s0, char* s1, char* s2) {
  const Params p = load_params(p0);
  const int tid_ = opaque_tid(wv);
  const u16* z = (const u16*)(p.ws + WS_Z);
  u16* U = (u16*)(p.ws + WS_U);
  int m_start, m_cnt;
  const int total = xcd_total(xm, 174, 8, m_start, m_cnt);
#pragma unroll 1
  for (int t = xm.rank; t < total; t += xm.nlb) {
    int mtile, ntile;
    xcd_tile(t, m_start, m_cnt, 8, mtile, ntile);
    const int tl = opaque_tid(wv);
    const int lane = tl & 63, wave = tl >> 6, g = lane >> 4, c16 = lane & 15;
    const int m0 = mtile * 192, n0 = ntile * 128;
    f32x4 acc[6][4];
    {
      gemm_ring<192, 128, 2, 2, 4, true>(tl, (const u16*)(p.ws + WS_YA) + (size_t)m0 * 512, 512,
                                 (const u16*)(p.ws + WS_WA) + ((size_t)l * 1024 + n0) * 512, 512, 127, 16, s0, s1, s2, acc);
    }
    const int wr = wave >> 1, wc = wave & 1;
#pragma unroll
    for (int mt = 0; mt < 6; ++mt) {
      const int m = m0 + wr * 96 + mt * 16 + c16;
#pragma unroll
      for (int nt = 0; nt < 4; nt += 2) {
        const int n = n0 + wc * 64 + g * 16 + nt * 4;
        u32x4 gw = *(const u32x4*)(z + (size_t)m * ZC + C_GA1 + n);
        f32x4 ga0 = unpack4(u32x2{gw.x, gw.y}), ga1 = unpack4(u32x2{gw.z, gw.w});
        f32x4 r0 = acc[mt][nt], r1 = acc[mt][nt + 1];
#pragma unroll
        for (int e = 0; e < 4; ++e) { r0[e] *= sigmoidf_(ga0[e]); r1[e] *= sigmoidf_(ga1[e]); }
        u32x2 a = pack4(r0), b = pack4(r1);
        *(u32x4*)(U + (size_t)m * 1024 + n) = u32x4{a.x, a.y, b.x, b.y};
        __builtin_amdgcn_sched_barrier(0);
      }
    }
    {
      gemm_ring<192, 128, 2, 2, 4, true>(tl, (const u16*)(p.ws + WS_YB) + (size_t)m0 * 512, 512,
                                 (const u16*)(p.ws + WS_WB) + ((size_t)l * 1024 + n0) * 512, 512, 127, 16, s0, s1, s2, acc);
    }
#pragma unroll
    for (int mt = 0; mt < 6; ++mt) {
      const int m = m0 + wr * 96 + mt * 16 + c16;
#pragma unroll
      for (int nt = 0; nt < 4; nt += 2) {
        const int n = n0 + wc * 64 + g * 16 + nt * 4;
        u32x4 gw = *(const u32x4*)(z + (size_t)m * ZC + C_GB1 + n);
        u32x4 uw = *(const u32x4*)(U + (size_t)m * 1024 + n);
        f32x4 gb0 = unpack4(u32x2{gw.x, gw.y}), gb1 = unpack4(u32x2{gw.z, gw.w});
        f32x4 r0 = unpack4(u32x2{uw.x, uw.y}), r1 = unpack4(u32x2{uw.z, uw.w});
#pragma unroll
        for (int e = 0; e < 4; ++e) { r0[e] += acc[mt][nt][e] * sigmoidf_(gb0[e]); r1[e] += acc[mt][nt + 1][e] * sigmoidf_(gb1[e]); }
        u32x2 a = pack4(r0), b = pack4(r1);
        *(u32x4*)(U + (size_t)m * 1024 + n) = u32x4{a.x, a.y, b.x, b.y};
        __builtin_amdgcn_sched_barrier(0);
      }
    }
  }
}

DI void phase5(const XcdMap xm, const int wv, const Params& p0, int l, char* s0, char* s1, char* s2) {
  const Params p = load_params(p0);
  const int tid_ = opaque_tid(wv);
  u16* xb = (u16*)(p.ws + WS_XB);
  int m_start, m_cnt;
  const int total = xcd_total(xm, 174, 8, m_start, m_cnt);
#pragma unroll 1
  for (int t = xm.rank; t < total; t += xm.nlb) {
    int mtile, ntile;
    xcd_tile(t, m_start, m_cnt, 8, mtile, ntile);
    const int tl = opaque_tid(wv);
    const int lane = tl & 63, wave = tl >> 6, g = lane >> 4, c16 = lane & 15;
    const int m0 = mtile * 192, n0 = ntile * 128;
    f32x4 acc[6][4];
    {
      gemm_ring<192, 128, 2, 2, 4, true>(tl, (const u16*)(p.ws + WS_U) + (size_t)m0 * 1024, 1024,
                                 (const u16*)(p.ws + WS_WOUT) + ((size_t)l * 1024 + n0) * 1024, 1024, 127, 32, s0, s1, s2, acc);
    }
    const int wr = wave >> 1, wc = wave & 1;
#pragma unroll
    for (int mt = 0; mt < 6; ++mt) {
      const int m = m0 + wr * 96 + mt * 16 + c16;
      float* xd = x_dst(p, m);
      float psum = 0.f;
#pragma unroll
      for (int nt = 0; nt < 4; nt += 2) {
        const int n = n0 + wc * 64 + g * 16 + nt * 4;
        u32x4 xw = *(const u32x4*)(xb + (size_t)m * 1024 + n);
        f32x4 x0 = unpack4(u32x2{xw.x, xw.y}) + acc[mt][nt], x1 = unpack4(u32x2{xw.z, xw.w}) + acc[mt][nt + 1];
        psum += sum4sq(x0) + sum4sq(x1);
        if (l == 3) { *(f32x4*)(xd + n) = x0; *(f32x4*)(xd + n + 4) = x1; }
        else { u32x2 a = pack4(x0), b = pack4(x1); *(u32x4*)(xb + (size_t)m * 1024 + n) = u32x4{a.x, a.y, b.x, b.y}; }
      }
      psum = xor_sum(psum, 16);
      psum = xor_sum(psum, 32);
      if (g == 0) ((float*)(p.ws + WS_SSX))[(size_t)m * 16 + ntile * 2 + wc] = psum;
    }
  }
}

#define XB_TMO      128
#define XB_XCNT(j)  (256  + 64 * (j))
#define XB_XSUB(j)  (1280 + 64 * (j))
#define XB_XGEN(j)  (2304 + 64 * (j))
#define XB_TOP      3328
#define XB_TOPGEN   3392
#define XCD_BAR_WORDS 3456
#define XB_SPIN_CAP (1u << 22)
DI unsigned xb_ld(unsigned* p) { return __hip_atomic_load(p, __ATOMIC_RELAXED, __HIP_MEMORY_SCOPE_AGENT); }
DI unsigned xb_add(unsigned* p, unsigned v) { return __hip_atomic_fetch_add(p, v, __ATOMIC_RELAXED, __HIP_MEMORY_SCOPE_AGENT); }
DI unsigned xb_xcc_id() { return (unsigned)__builtin_amdgcn_s_getreg((3 << 11) | 20) & 0xFu; }
#define XB_SPIN(cond, bar) do { unsigned _sp = 0; while (cond) { __builtin_amdgcn_s_sleep(1); \
    if ((++_sp & 255u) == 0u) { if (xb_ld(&(bar)[XB_TMO])) break; if (_sp > XB_SPIN_CAP) { atomicAdd(&(bar)[XB_TMO], 1u); break; } } } } while (0)
struct XcdBarrier { unsigned* bar; unsigned x; volatile LAS unsigned* st; };
DI void xcd_barrier_complete(unsigned* bar, unsigned x, unsigned& nloc, unsigned& nx) {
  const unsigned G = gridDim.x;
  unsigned sum, cnt, mine, sp = 0u;
  for (;;) {
    sum = 0u; cnt = 0u; mine = 0u;
#pragma unroll
    for (unsigned j = 0; j < 16; ++j) { const unsigned c = xb_ld(&bar[XB_XCNT(j)]); sum += c; cnt += (c > 0u) ? 1u : 0u; mine = (j == x) ? c : mine; }
    if (sum == G) break;
    __builtin_amdgcn_s_sleep(1);
    if ((++sp & 255u) == 0u) { if (xb_ld(&bar[XB_TMO])) break; if (sp > XB_SPIN_CAP) { atomicAdd(&bar[XB_TMO], 1u); break; } }
  }
  nloc = mine > 0u ? mine : 1u; nx = cnt > 0u ? cnt : 1u;
}
DI void xcd_barrier(const XcdBarrier& b, const int tid) {
  asm volatile("s_waitcnt vmcnt(0)" ::: "memory");
  __syncthreads();
  if (tid == 0) {
    unsigned* bar = b.bar;
    __builtin_amdgcn_s_waitcnt(0);
    unsigned nloc = b.st[0], nx = b.st[1];
    if (nloc == 0u) { xcd_barrier_complete(bar, b.x, nloc, nx); b.st[0] = nloc; b.st[1] = nx; }
    const unsigned old = xb_add(&bar[XB_XSUB(b.x)], 1u);
    const unsigned gen = old / nloc;
    if (old + 1u == (gen + 1u) * nloc) {
      __builtin_amdgcn_fence(__ATOMIC_RELEASE, "agent");
      asm volatile("s_waitcnt vmcnt(0)" ::: "memory");
      const unsigned og = xb_add(&bar[XB_TOP], 1u);
      const unsigned tg = og / nx;
      if (og + 1u == (tg + 1u) * nx) xb_add(&bar[XB_TOPGEN], 1u);
      else XB_SPIN(xb_ld(&bar[XB_TOPGEN]) == tg, bar);
      __builtin_amdgcn_fence(__ATOMIC_ACQUIRE, "agent");
      xb_add(&bar[XB_XGEN(b.x)], 1u);
      asm volatile("s_waitcnt vmcnt(0)" ::: "memory");
    } else {
      XB_SPIN(xb_ld(&bar[XB_XGEN(b.x)]) == gen, bar);
      __builtin_amdgcn_fence(__ATOMIC_ACQUIRE, "agent");
      asm volatile("s_waitcnt vmcnt(0)" ::: "memory");
    }
  }
  __syncthreads();
}

__global__ void __launch_bounds__(256, 2) mega_kernel(Params p) {
  __shared__ __attribute__((aligned(1024))) char lds0[24576];
  __shared__ __attribute__((aligned(1024))) char lds1[24576];
  __shared__ __attribute__((aligned(1024))) char lds2[24576];
  __shared__ __attribute__((aligned(16))) unsigned xbw[4];
  cg::grid_group grid = cg::this_grid();
  const int wv = __builtin_amdgcn_readfirstlane((int)(threadIdx.x >> 6));
  XcdBarrier xb;
  {
    const int t0 = opaque_tid(wv);
    if (t0 == 0) { xbw[0] = 0u; xbw[1] = 0u; xbw[2] = 0u; xbw[3] = 0u; }
    __syncthreads();
    xb.bar = (unsigned*)(p.ws + WS_BAR); xb.x = xb_xcc_id(); xb.st = (volatile LAS unsigned*)xbw;
    if (t0 == 0) xbw[2] = xb_add(&xb.bar[XB_XCNT(xb.x)], 1u);
    __syncthreads();
  }
  XcdMap xm;
  xm.rank = __builtin_amdgcn_readfirstlane((int)xbw[2]);
  xm.xcc = 0; xm.nlb = 1; xm.nx = 1;
  for (int ph = 0; ph < NPH; ++ph) {
    if (ph == 1) {
      if (p.ph_hi < 0) grid.sync();
      xcd_barrier(xb, opaque_tid(wv));
      const int t0 = opaque_tid(wv);
      if (t0 == 0) {
        unsigned mine = 0u, cnt = 0u, idx = 0u;
#pragma unroll
        for (unsigned j = 0; j < 16; ++j) {
          const unsigned c = xb_ld(&xb.bar[XB_XCNT(j)]);
          cnt += (c > 0u) ? 1u : 0u;
          idx += (c > 0u && j < xb.x) ? 1u : 0u;
          mine = (j == xb.x) ? c : mine;
        }
        xbw[0] = mine; xbw[1] = cnt; xbw[3] = idx;
      }
      __syncthreads();
      xm.nlb = __builtin_amdgcn_readfirstlane((int)xbw[0]);
      xm.nx = __builtin_amdgcn_readfirstlane((int)xbw[1]);
      xm.xcc = __builtin_amdgcn_readfirstlane((int)xbw[3]);
    } else if (ph > 1) xcd_barrier(xb, opaque_tid(wv));
    if (ph == 0) phase0(wv, p, lds0, lds1, lds2);
    else {
      const int l = (ph - 1) / 6, s = (ph - 1) - l * 6;
      if (s == 0) phase1(xm, wv, p, l, lds0, lds1, lds2);
      else if (s == 1) phase2(xm, wv, p, l, lds0, lds1, lds2);
      else if (s == 2) phase3(wv, p, l, lds0, lds1, lds2, 0);
      else if (s == 3) phase3b(wv, p, l);
      else if (s == 4) phase4(xm, wv, p, l, lds0, lds1, lds2);
      else phase5(xm, wv, p, l, lds0, lds1, lds2);
#if PROBE_PHASE >= 0
      if (s == PROBE_PHASE) {
        xcd_barrier(xb, opaque_tid(wv));
        if (s == 0) phase1(xm, wv, p, l, lds0, lds1, lds2);
        else if (s == 1) phase2(xm, wv, p, l, lds0, lds1, lds2, PROBE_MODE);
        else if (s == 2) phase3(wv, p, l, lds0, lds1, lds2, 4, PROBE_MODE);
        else if (s == 3) phase3b(wv, p, l);
        else if (s == 4) phase4(xm, wv, p, l, lds0, lds1, lds2);
      }
#endif
    }
  }
}

extern "C" void kernel_launch(void* const* d_in, const int* in_sizes, int n_in, void* d_out, int out_size, void* d_ws, size_t ws_size,
                              hipStream_t stream) {
  static int grid_blocks = 0;
  if (!grid_blocks) {
    int dev = 0, cus = 0, per_cu = 0;
    hipGetDevice(&dev);
    hipDeviceGetAttribute(&cus, hipDeviceAttributeMultiprocessorCount, dev);
    hipOccupancyMaxActiveBlocksPerMultiprocessor(&per_cu, mega_kernel, 256, 0);
    if (per_cu > 2) per_cu = 2;
    if (per_cu < 1) per_cu = 1;
    grid_blocks = cus * per_cu;
  }
  if (ws_size < WS_END) { fprintf(stderr, "workspace too small: %zu < %zu\n", ws_size, (size_t)WS_END); return; }
  Params p{};
  for (int i = 0; i < 30; ++i) p.in[i] = (const float*)d_in[i];
  p.out = (float*)d_out;
  p.ws = (char*)d_ws;
  hipMemsetAsync((char*)d_ws + WS_BAR, 0, 16384, stream);
  hipMemsetAsync((char*)d_ws + WS_CUE, 0, (size_t)8 * 4096 * 4, stream);
  p.ph_lo = 0; p.ph_hi = NPH;
  void* args[] = {&p};
  hipError_t e = hipLaunchCooperativeKernel((void*)mega_kernel, dim3(grid_blocks), dim3(256), args, 0, stream);
  if (e != hipSuccess) fprintf(stderr, "cooperative launch failed: %s (grid %d)\n", hipGetErrorString(e), grid_blocks);
}
```
